# Optimizing an MI355X kernel written in HIP

```python
import jax
import jax.numpy as jnp
from jax import lax

D_MODEL = 2048
BATCH = 4
SEQ = 2048
DEPTH = 1

M_HEADS = 4
M_HEAD_DIM = D_MODEL // 8
M_WIDTH = M_HEADS * M_HEAD_DIM
M_CONV = 4
M_CHUNK = 128

A_HEADS = 16
A_KV_HEADS = 4
A_GROUP = A_HEADS // A_KV_HEADS
A_HEAD_DIM = D_MODEL // 32
A_WIDTH = A_HEADS * A_HEAD_DIM
A_KV_WIDTH = A_KV_HEADS * A_HEAD_DIM
A_CMP_BLOCK = 32
A_CMP_STRIDE = 16
A_CMP_HIDDEN = 4 * A_HEAD_DIM
A_SEL_BLOCK = 64
A_SEL_TOPK = 8
A_WINDOW = 512
Q_BLOCK = 128

RMS_EPS = 1e-6
LN_EPS = 1e-6
NEG_INF = -1e30
POS_INF = 1e30

IN_SPLITS = (
    M_WIDTH, M_WIDTH, M_WIDTH, M_WIDTH, M_HEADS, M_HEADS,
    A_WIDTH, A_KV_WIDTH, A_KV_WIDTH, A_KV_WIDTH, A_KV_WIDTH,
    A_KV_WIDTH, A_KV_WIDTH, 3 * A_HEADS, A_WIDTH,
    D_MODEL, D_MODEL,
)
D_IN = sum(IN_SPLITS)

kernel_name = 'hybrid_mlstm_nsa_gated_merge'


def split_cols(p, sizes):
    idx, acc = [], 0
    for s in sizes[:-1]:
        acc += s
        idx.append(acc)
    return jnp.split(p, idx, axis=-1)


def rms_norm(x, g):
    xf = x.astype(jnp.float32)
    y = xf * lax.rsqrt(jnp.mean(xf * xf, axis=-1, keepdims=True) + RMS_EPS)
    return (y * g.astype(jnp.float32)).astype(x.dtype)


def causal_depthwise_conv(x, w, b):
    k = w.shape[0]
    xp = jnp.pad(x, ((0, 0), (k - 1, 0), (0, 0)))
    y = lax.conv_general_dilated(xp, w[:, None, :], (1,), 'VALID',
                                 dimension_numbers=('NWC', 'WIO', 'NWC'),
                                 feature_group_count=x.shape[-1])
    return y + b


def mlstm_chunkwise(q, k, v, i_pre, f_pre):
    bsz, nh, s, d = q.shape
    nc = s // M_CHUNK
    k = k * d ** -0.5
    logf = jax.nn.log_sigmoid(f_pre)

    def to_chunks(t):
        return jnp.moveaxis(t.reshape(bsz, nh, nc, M_CHUNK, *t.shape[3:]), 2, 0)

    xs = (to_chunks(q), to_chunks(k), to_chunks(v), to_chunks(i_pre), to_chunks(logf))
    causal = jnp.tril(jnp.ones((M_CHUNK, M_CHUNK), dtype=bool))

    def step(carry, inp):
        c_st, n_st, m_st = carry
        qb, kb, vb, ib, fb = inp
        bcum = jnp.cumsum(fb, axis=-1)
        g_tot = bcum[..., -1]
        d_intra = jnp.where(causal, bcum[..., :, None] - bcum[..., None, :] + ib[..., None, :], NEG_INF)
        d_inter = bcum + m_st[..., None]
        m_t = jnp.maximum(d_inter, jnp.max(d_intra, axis=-1))
        w_intra = jnp.exp(d_intra - m_t[..., None])
        w_inter = jnp.exp(d_inter - m_t)
        sc = jnp.einsum('bhtd,bhsd->bhts', qb, kb) * w_intra
        num = jnp.einsum('bhts,bhsd->bhtd', sc, vb) + w_inter[..., None] * jnp.einsum('bhtd,bhde->bhte', qb, c_st)
        den = jnp.sum(sc, axis=-1) + w_inter * jnp.einsum('bhtd,bhd->bht', qb, n_st)
        h = num / jnp.maximum(jnp.abs(den), jnp.exp(-m_t))[..., None]
        d_state = g_tot[..., None] - bcum + ib
        m_new = jnp.maximum(g_tot + m_st, jnp.max(d_state, axis=-1))
        w_s = jnp.exp(d_state - m_new[..., None])
        decay = jnp.exp(g_tot + m_st - m_new)
        c_new = decay[..., None, None] * c_st + jnp.einsum('bhs,bhsd,bhse->bhde', w_s, kb, vb)
        n_new = decay[..., None] * n_st + jnp.einsum('bhs,bhsd->bhd', w_s, kb)
        return (c_new, n_new, m_new), h

    init = (jnp.zeros((bsz, nh, d, d), q.dtype), jnp.zeros((bsz, nh, d), q.dtype), jnp.zeros((bsz, nh), q.dtype))
    _, hs = lax.scan(step, init, xs)
    return jnp.moveaxis(hs, 0, 2).reshape(bsz, nh, s, d)


def mlstm_branch(x_m, v, o_pre, i_pre, f_pre, conv_w, conv_b, w_q, w_k, b_i, b_f, norm_g, skip):
    bsz, s, _ = x_m.shape
    x_c = jax.nn.silu(causal_depthwise_conv(x_m, conv_w, conv_b))
    xc_h = x_c.reshape(bsz, s, M_HEADS, M_HEAD_DIM)
    q = jnp.einsum('bshd,hde->bhse', xc_h, w_q)
    k = jnp.einsum('bshd,hde->bhse', xc_h, w_k)
    vh = v.reshape(bsz, s, M_HEADS, M_HEAD_DIM).transpose(0, 2, 1, 3)
    ig = jnp.swapaxes(i_pre + b_i, 1, 2)
    fg = jnp.swapaxes(f_pre + b_f, 1, 2)
    h = mlstm_chunkwise(q, k, vh, ig, fg)
    h = jnp.swapaxes(h, 1, 2) * jax.nn.sigmoid(o_pre).reshape(bsz, s, M_HEADS, M_HEAD_DIM)
    mu = jnp.mean(h, axis=-1, keepdims=True)
    var = jnp.mean(jnp.square(h - mu), axis=-1, keepdims=True)
    hn = ((h - mu) * lax.rsqrt(var + LN_EPS)).reshape(bsz, s, M_WIDTH)
    return hn * norm_g + skip * x_c


def compress_blocks(t, pe, w1, w2):
    bsz, g, s, dh = t.shape
    n_cmp = (s - A_CMP_BLOCK) // A_CMP_STRIDE + 1
    idx = jnp.arange(n_cmp)[:, None] * A_CMP_STRIDE + jnp.arange(A_CMP_BLOCK)[None, :]
    blocks = (t[:, :, idx] + pe).reshape(bsz, g, n_cmp, A_CMP_BLOCK * dh)
    return jax.nn.silu(blocks @ w1) @ w2


def selected_attention(qh, k, v, sel_idx):
    bsz, g, hpg, s, dh = qh.shape
    n_sel = s // A_SEL_BLOCK
    topk = sel_idx.shape[-1]
    n_qb = s // Q_BLOCK
    kb = k.reshape(bsz, g, n_sel, A_SEL_BLOCK, dh)
    vb = v.reshape(bsz, g, n_sel, A_SEL_BLOCK, dh)
    gather = jax.vmap(jax.vmap(lambda blocks, ix: blocks[ix]))
    q_blk = jnp.moveaxis(qh.reshape(bsz, g, hpg, n_qb, Q_BLOCK, dh), 3, 0)
    i_blk = jnp.moveaxis(sel_idx.reshape(bsz, g, n_qb, Q_BLOCK, topk), 2, 0)
    t_blk = jnp.arange(s).reshape(n_qb, Q_BLOCK)

    def one_block(args):
        qq, ii, tt = args
        kg = gather(kb, ii)
        vg = gather(vb, ii)
        pos = ii[..., None] * A_SEL_BLOCK + jnp.arange(A_SEL_BLOCK)
        valid = (pos <= tt[:, None, None])[:, :, None]
        sc = jnp.where(valid, jnp.einsum('bghqd,bgqkld->bghqkl', qq, kg), NEG_INF)
        p = jax.nn.softmax(sc.reshape(*sc.shape[:4], -1), axis=-1).reshape(sc.shape)
        return jnp.einsum('bghqkl,bgqkld->bghqd', p, vg)

    o = lax.map(one_block, (q_blk, i_blk, t_blk))
    return jnp.moveaxis(o, 0, 3).reshape(bsz, g, hpg, s, dh)


def window_attention(qh, k, v):
    bsz, g, hpg, s, dh = qh.shape
    n_qb = s // Q_BLOCK
    n_wb = -(-A_WINDOW // Q_BLOCK)
    pad = n_wb * Q_BLOCK
    band_len = pad + Q_BLOCK

    def banded(t):
        tp = jnp.pad(t, ((0, 0), (0, 0), (pad, 0), (0, 0))).reshape(bsz, g, n_qb + n_wb, Q_BLOCK, dh)
        return jnp.concatenate([tp[:, :, i:i + n_qb] for i in range(n_wb + 1)], axis=3)

    kb, vb = banded(k), banded(v)
    qb = qh.reshape(bsz, g, hpg, n_qb, Q_BLOCK, dh)
    rel = pad + jnp.arange(Q_BLOCK)[:, None] - jnp.arange(band_len)[None, :]
    in_band = (rel >= 0) & (rel < A_WINDOW)
    real = (jnp.arange(n_qb)[:, None] * Q_BLOCK + jnp.arange(band_len)[None, :]) >= pad
    valid = in_band[None] & real[:, None, :]
    sc = jnp.where(valid, jnp.einsum('bghnqd,bgnkd->bghnqk', qb, kb), NEG_INF)
    p = jax.nn.softmax(sc, axis=-1)
    return jnp.einsum('bghnqk,bgnkd->bghnqd', p, vb).reshape(bsz, g, hpg, s, dh)


def nsa_branch(q, k_c, v_c, k_s, v_s, k_w, v_w, gate_pre, pe_k, w1_k, w2_k, pe_v, w1_v, w2_v):
    bsz, s, _ = q.shape
    qh = q.reshape(bsz, s, A_KV_HEADS, A_GROUP, A_HEAD_DIM).transpose(0, 2, 3, 1, 4) * A_HEAD_DIM ** -0.5

    def kvh(t):
        return t.reshape(bsz, s, A_KV_HEADS, A_HEAD_DIM).transpose(0, 2, 1, 3)

    t_pos = jnp.arange(s)
    kc = compress_blocks(kvh(k_c), pe_k, w1_k, w2_k)
    vc = compress_blocks(kvh(v_c), pe_v, w1_v, w2_v)
    n_cmp = kc.shape[2]
    cmp_start = jnp.arange(n_cmp) * A_CMP_STRIDE
    cmp_end = cmp_start + A_CMP_BLOCK - 1
    cmp_valid = cmp_end[None, :] <= t_pos[:, None]
    s_c = jnp.where(cmp_valid, jnp.einsum('bghtd,bgnd->bghtn', qh, kc), NEG_INF)
    p_c = jax.nn.softmax(s_c, axis=-1) * cmp_valid
    o_c = jnp.einsum('bghtn,bgnd->bghtd', p_c, vc)
    n_sel = s // A_SEL_BLOCK
    sel_start = jnp.arange(n_sel) * A_SEL_BLOCK
    overlap = ((cmp_start[:, None] < sel_start[None, :] + A_SEL_BLOCK)
               & (cmp_end[:, None] >= sel_start[None, :])).astype(p_c.dtype)
    imp = jnp.einsum('bghtn,nj->bgtj', p_c, overlap)
    cur = (t_pos // A_SEL_BLOCK)[:, None]
    j = jnp.arange(n_sel)[None, :]
    forced = (j == 0) | (j == cur) | (j == cur - 1)
    score = jnp.where(forced, POS_INF, jnp.where(j <= cur, imp, NEG_INF))
    _, sel_idx = lax.top_k(score, min(A_SEL_TOPK, n_sel))
    o_s = selected_attention(qh, kvh(k_s), kvh(v_s), sel_idx)
    o_w = window_attention(qh, kvh(k_w), kvh(v_w))
    g = jax.nn.sigmoid(gate_pre).reshape(bsz, s, A_KV_HEADS, A_GROUP, 3).transpose(0, 2, 3, 1, 4)
    o = g[..., 0:1] * o_c + g[..., 1:2] * o_s + g[..., 2:3] * o_w
    return o.transpose(0, 3, 1, 2, 4).reshape(bsz, s, A_WIDTH)


def setup_inputs(seed: int = 0) -> dict:
    key = jax.random.key(seed)
    ks = jax.random.split(key, 24)

    def nrm(k, shape, scale):
        return jax.random.normal(k, shape, jnp.float32) * scale

    L = DEPTH
    cmp_in = A_CMP_BLOCK * A_HEAD_DIM
    return {
        'x': nrm(ks[0], (BATCH, SEQ, D_MODEL), 1.0),
        'pre_norm_g': 1.0 + nrm(ks[1], (L, D_MODEL), 0.02),
        'w_in': nrm(ks[2], (L, D_MODEL, D_IN), D_MODEL ** -0.5),
        'm_conv_w': nrm(ks[3], (L, M_CONV, M_WIDTH), M_CONV ** -0.5),
        'm_conv_b': nrm(ks[4], (L, M_WIDTH), 0.01),
        'm_w_q': nrm(ks[5], (L, M_HEADS, M_HEAD_DIM, M_HEAD_DIM), M_HEAD_DIM ** -0.5),
        'm_w_k': nrm(ks[6], (L, M_HEADS, M_HEAD_DIM, M_HEAD_DIM), M_HEAD_DIM ** -0.5),
        'm_b_i': nrm(ks[7], (L, M_HEADS), 0.1),
        'm_b_f': jnp.linspace(3.0, 6.0, M_HEADS, dtype=jnp.float32)[None, :] + nrm(ks[8], (L, M_HEADS), 0.1),
        'm_norm_g': 1.0 + nrm(ks[9], (L, M_WIDTH), 0.02),
        'm_skip': 1.0 + nrm(ks[10], (L, M_WIDTH), 0.02),
        'a_pe_k': nrm(ks[11], (L, A_CMP_BLOCK, A_HEAD_DIM), 0.1),
        'a_w1_k': nrm(ks[12], (L, cmp_in, A_CMP_HIDDEN), cmp_in ** -0.5),
        'a_w2_k': nrm(ks[13], (L, A_CMP_HIDDEN, A_HEAD_DIM), A_CMP_HIDDEN ** -0.5),
        'a_pe_v': nrm(ks[14], (L, A_CMP_BLOCK, A_HEAD_DIM), 0.1),
        'a_w1_v': nrm(ks[15], (L, cmp_in, A_CMP_HIDDEN), cmp_in ** -0.5),
        'a_w2_v': nrm(ks[16], (L, A_CMP_HIDDEN, A_HEAD_DIM), A_CMP_HIDDEN ** -0.5),
        'w_up_m': nrm(ks[17], (L, M_WIDTH, D_MODEL), M_WIDTH ** -0.5),
        'w_up_a': nrm(ks[18], (L, A_WIDTH, D_MODEL), A_WIDTH ** -0.5),
        'w_out': nrm(ks[19], (L, D_MODEL, D_MODEL), D_MODEL ** -0.5),
        'post_norm_g': 1.0 + nrm(ks[20], (L, D_MODEL), 0.02),
    }


def reference(x, pre_norm_g, w_in, m_conv_w, m_conv_b, m_w_q, m_w_k, m_b_i, m_b_f, m_norm_g, m_skip,
              a_pe_k, a_w1_k, a_w2_k, a_pe_v, a_w1_v, a_w2_v, w_up_m, w_up_a, w_out, post_norm_g):
    f32 = jnp.float32
    for l in range(DEPTH):
        h = rms_norm(x, pre_norm_g[l])
        (m_x, m_v, m_o, m_z, m_i, m_f,
         a_q, a_kc, a_vc, a_ks, a_vs, a_kw, a_vw, a_g, a_z,
         g_m, g_a) = split_cols((h @ w_in[l]).astype(f32), IN_SPLITS)
        y_m = mlstm_branch(m_x, m_v, m_o, m_i, m_f,
                           m_conv_w[l].astype(f32), m_conv_b[l].astype(f32),
                           m_w_q[l].astype(f32), m_w_k[l].astype(f32),
                           m_b_i[l].astype(f32), m_b_f[l].astype(f32),
                           m_norm_g[l].astype(f32), m_skip[l].astype(f32)) * jax.nn.silu(m_z)
        y_a = nsa_branch(a_q, a_kc, a_vc, a_ks, a_vs, a_kw, a_vw, a_g,
                         a_pe_k[l].astype(f32), a_w1_k[l].astype(f32), a_w2_k[l].astype(f32),
                         a_pe_v[l].astype(f32), a_w1_v[l].astype(f32), a_w2_v[l].astype(f32)) * jax.nn.silu(a_z)
        merged = (jax.nn.sigmoid(g_m) * (y_m @ w_up_m[l].astype(f32))
                  + jax.nn.sigmoid(g_a) * (y_a @ w_up_a[l].astype(f32)))
        out = merged.astype(x.dtype) @ w_out[l]
        x = x + rms_norm(out, post_norm_g[l])
    return x
```

```cpp
#include <hip/hip_runtime.h>
#include <hip/hip_cooperative_groups.h>
#include <stdint.h>
#include <cstdio>
namespace cg = cooperative_groups;

typedef unsigned short bf16_t;
typedef short bf16x8 __attribute__((ext_vector_type(8)));
typedef float f32x4 __attribute__((ext_vector_type(4)));
#define DEVI __device__ __forceinline__

constexpr int T = 8192, S = 2048, DM = 2048;
constexpr int NP = 11904, NPS = 11776, DIN = 11832;
constexpr int C_MX = 0, C_MV = 1024, C_MO = 2048, C_MZ = 3072, C_AQ = 4096, C_KC = 5120, C_VC = 5376, C_KS = 5632,
              C_VS = 5888, C_KW = 6144, C_VW = 6400, C_AZ = 6656, C_GM = 7680, C_GA = 9728, C_GATE = 11776;
constexpr size_t O_R0 = 0;
constexpr size_t O_R1 = O_R0 + 33554432;
constexpr size_t O_P = O_R1 + 50331648;
constexpr size_t O_WUM = O_P + 192937984;
constexpr size_t O_WUA = O_WUM + 4194304;
constexpr size_t O_WOUT = O_WUA + 4194304;
constexpr size_t O_WQ = O_WOUT + 8388608;
constexpr size_t O_WK = O_WQ + 524288;
constexpr size_t O_W1K = O_WK + 524288;
constexpr size_t O_W1V = O_W1K + 1048576;
constexpr size_t O_W2K = O_W1V + 1048576;
constexpr size_t O_W2V = O_W2K + 32768;
constexpr size_t O_G = O_W2V + 32768;
constexpr size_t O_VMT = O_G + 2097152;
constexpr size_t O_VST = O_VMT + 16777216;
constexpr size_t O_VWT = O_VST + 4194304;
constexpr size_t O_HC = O_VWT + 4194304;
constexpr size_t O_KCF = O_HC + 2097152;
constexpr size_t O_VCF = O_KCF + 524288;
constexpr size_t O_B1P = O_VCF + 524288;
constexpr size_t O_FA = O_B1P + 32768;
constexpr size_t O_FM = O_FA + 131072;
constexpr size_t O_FL = O_FM + 131072;
constexpr size_t O_SEL = O_FL + 131072;
constexpr size_t O_YM = O_SEL + 131072;
constexpr size_t O_END = O_YM + 16777216;
constexpr size_t O_XC = O_R1, O_QM = O_R1 + 16777216, O_KM = O_R1 + 2 * 16777216, O_YA = O_QM;
constexpr size_t O_OC = O_R0, O_OW = O_R0 + 16777216, O_MG = O_R0, O_H = O_R0, O_WINT = O_R1, O_OUT = O_P;

constexpr int LDS_MAIN = 73728;
constexpr int LDS_BYTES = LDS_MAIN + 64;
constexpr size_t O_BAR = O_END;
constexpr size_t O_END2 = O_BAR + 16384;
#ifndef DBG
#define DBG 0
#endif
#ifndef REPM
#define REPM 0
#endif
#define NREP(k) (((REPM >> (k)) & 1) ? 2 : 1)
#ifndef DSTOP
#define DSTOP 9
#endif
#ifndef PSEL
#define PSEL 0
#endif

struct Params {
    const float *x, *pre_g, *w_in, *conv_w, *conv_b, *w_q, *w_k, *b_i, *b_f, *norm_g, *skip, *pe_k, *w1_k, *w2_k, *pe_v, *w1_v,
        *w2_v, *w_up_m, *w_up_a, *w_out, *post_g;
    float* out;
    char* ws;
};

DEVI int tidx() { int t = threadIdx.x; asm volatile("" : "+v"(t)); return t; }
DEVI float bf2f(bf16_t b) { return __uint_as_float(((unsigned)b) << 16); }
typedef __bf16 bf16v2_t __attribute__((ext_vector_type(2)));
typedef float f32v2_t __attribute__((ext_vector_type(2)));
DEVI unsigned pk2(float lo, float hi) {
    f32v2_t v = {lo, hi};
    bf16v2_t b = __builtin_convertvector(v, bf16v2_t);
    return __builtin_bit_cast(unsigned, b);
}
DEVI bf16_t f2bf(float f) { return (bf16_t)(pk2(f, 0.f) & 0xffffu); }
DEVI float lo16(unsigned u) { return __uint_as_float(u << 16); }
DEVI float hi16(unsigned u) { return __uint_as_float(u & 0xffff0000u); }
DEVI float sigm(float x) { return 1.f / (1.f + __expf(-x)); }
DEVI float silu(float x) { return x / (1.f + __expf(-x)); }
DEVI f32x4 mma(bf16x8 a, bf16x8 b, f32x4 c) { return __builtin_amdgcn_mfma_f32_16x16x32_bf16(a, b, c, 0, 0, 0); }
DEVI float rdlane(float v, int l) { return __uint_as_float(__builtin_amdgcn_readlane(__float_as_uint(v), l)); }
DEVI uint4 pair16(uint2 x, uint2 y) {
    const auto r0 = __builtin_amdgcn_permlane16_swap(x.x, y.x, false, false);
    const auto r1 = __builtin_amdgcn_permlane16_swap(x.y, y.y, false, false);
    return make_uint4(r0[0], r1[0], r0[1], r1[1]);
}
typedef unsigned u32x4_t __attribute__((ext_vector_type(4)));
DEVI void store_nt16(void* ptr, uint4 v) { u32x4_t x = {v.x, v.y, v.z, v.w}; __builtin_nontemporal_store(x, (u32x4_t*)ptr); }
DEVI float wave_max(float v) {
#pragma unroll
    for (int o = 32; o > 0; o >>= 1) v = fmaxf(v, __shfl_xor(v, o));
    return v;
}
DEVI float wave_sum(float v) {
#pragma unroll
    for (int o = 32; o > 0; o >>= 1) v += __shfl_xor(v, o);
    return v;
}
DEVI bf16x8 pack8(const float* v) {
    union { unsigned u[4]; bf16x8 b; } x;
    x.u[0] = pk2(v[0], v[1]); x.u[1] = pk2(v[2], v[3]); x.u[2] = pk2(v[4], v[5]); x.u[3] = pk2(v[6], v[7]);
    return x.b;
}
DEVI bf16x8 join8(uint2 a, uint2 b) {
    union { unsigned u[4]; bf16x8 v; } x;
    x.u[0] = a.x; x.u[1] = a.y; x.u[2] = b.x; x.u[3] = b.y;
    return x.v;
}

#define XB_TMO      128
#define XB_XCNT(j)  (256  + 64 * (j))
#define XB_XSUB(j)  (1280 + 64 * (j))
#define XB_XGEN(j)  (2304 + 64 * (j))
#define XB_TOP      3328
#define XB_TOPGEN   3392
#define XCD_BAR_WORDS 3456
#define XB_SPIN_CAP (1u << 18)
#define LAS __attribute__((address_space(3)))
DEVI unsigned xb_ld(unsigned* p) { return __hip_atomic_load(p, __ATOMIC_RELAXED, __HIP_MEMORY_SCOPE_AGENT); }
DEVI unsigned xb_add(unsigned* p, unsigned v) { return __hip_atomic_fetch_add(p, v, __ATOMIC_RELAXED, __HIP_MEMORY_SCOPE_AGENT); }
DEVI unsigned xb_xcc_id() { return (unsigned)__builtin_amdgcn_s_getreg((3 << 11) | 20) & 0xFu; }
#define XB_SPIN(cond, bar) do { unsigned _sp = 0; while (cond) { __builtin_amdgcn_s_sleep(1); \
    if ((++_sp & 255u) == 0u) { if (xb_ld(&(bar)[XB_TMO])) break; if (_sp > XB_SPIN_CAP) { atomicAdd(&(bar)[XB_TMO], 1u); break; } } } } while (0)
struct XcdBarrier { unsigned* bar; unsigned x; volatile LAS unsigned* st; };
DEVI XcdBarrier xcd_barrier_post(unsigned* bar, volatile LAS unsigned* st) {
    XcdBarrier b; b.bar = bar; b.x = xb_xcc_id(); b.st = st;
    if (threadIdx.x == 0) (void)xb_add(&bar[XB_XCNT(b.x)], 1u);
    return b;
}
DEVI void xcd_barrier_complete(unsigned* bar, unsigned x, unsigned& nloc, unsigned& nx) {
    const unsigned G = gridDim.x * gridDim.y * gridDim.z;
    unsigned sum, cnt, mine, sp = 0u;
    for (;;) {
        sum = 0u; cnt = 0u; mine = 0u;
#pragma unroll
        for (unsigned j = 0; j < 16; ++j) { const unsigned c = xb_ld(&bar[XB_XCNT(j)]); sum += c; cnt += (c > 0u) ? 1u : 0u; mine = (j == x) ? c : mine; }
        if (sum == G) break;
        __builtin_amdgcn_s_sleep(1);
        if ((++sp & 255u) == 0u) { if (xb_ld(&bar[XB_TMO])) break; if (sp > XB_SPIN_CAP) { atomicAdd(&bar[XB_TMO], 1u); break; } }
    }
    nloc = mine > 0u ? mine : 1u; nx = cnt > 0u ? cnt : 1u;
}
DEVI void xcd_barrier(const XcdBarrier& b) {
    asm volatile("s_waitcnt vmcnt(0)" ::: "memory");
    __syncthreads();
    if (threadIdx.x == 0) {
        unsigned* bar = b.bar;
        __builtin_amdgcn_s_waitcnt(0);
        unsigned nloc = b.st[0], nx = b.st[1];
        if (nloc == 0u) { xcd_barrier_complete(bar, b.x, nloc, nx); b.st[0] = nloc; b.st[1] = nx; }
        const unsigned old = xb_add(&bar[XB_XSUB(b.x)], 1u);
        const unsigned gen = old / nloc;
        if (old + 1u == (gen + 1u) * nloc) {
            __builtin_amdgcn_fence(__ATOMIC_RELEASE, "agent");
            asm volatile("s_waitcnt vmcnt(0)" ::: "memory");
            const unsigned og = xb_add(&bar[XB_TOP], 1u);
            const unsigned tg = og / nx;
            if (og + 1u == (tg + 1u) * nx) xb_add(&bar[XB_TOPGEN], 1u);
            else XB_SPIN(xb_ld(&bar[XB_TOPGEN]) == tg, bar);
            __builtin_amdgcn_fence(__ATOMIC_ACQUIRE, "agent");
            xb_add(&bar[XB_XGEN(b.x)], 1u);
            asm volatile("s_waitcnt vmcnt(0)" ::: "memory");
        } else {
            XB_SPIN(xb_ld(&bar[XB_XGEN(b.x)]) == gen, bar);
            __builtin_amdgcn_fence(__ATOMIC_ACQUIRE, "agent");
            asm volatile("s_waitcnt vmcnt(0)" ::: "memory");
        }
    }
    __syncthreads();
}
template <bool TR, int NI, class RB>
DEVI void gemm_main(f32x4 (&acc)[4][NI], char* lds, RB rowbase, size_t hi, const bf16_t* Bt, int ldb, int nBmax, int m0, int n0, int K) {
    const int tid = tidx(), lane = tid & 63, wid = tid >> 6, wr = wid >> 1, wc = wid & 1, fr = lane & 15, fq = lane >> 4;
    const int c = tid & 7, r0 = tid >> 3;
    const bf16_t* ab[4];
    const bf16_t* bb[NI];
#pragma unroll
    for (int i = 0; i < 4; ++i) ab[i] = rowbase(m0 + r0 + i * 32) + c * 8;
#pragma unroll
    for (int i = 0; i < NI; ++i) {
        int nr = n0 + r0 + i * 32;
        if (nr > nBmax) nr = nBmax;
        bb[i] = Bt + (size_t)nr * ldb + c * 8;
    }
    uint4 ra[4], rb[NI];
    const int nk = K >> 6;
    const int lw = (c >> 2) * 8192 + r0 * 64 + (c & 3) * 16;
#pragma unroll
    for (int i = 0; i < 4; ++i) ra[i] = *(const uint4*)(ab[i]);
#pragma unroll
    for (int i = 0; i < NI; ++i) rb[i] = *(const uint4*)(bb[i]);
#pragma unroll
    for (int i = 0; i < 4; ++i) *(uint4*)(lds + lw + i * 2048) = ra[i];
#pragma unroll
    for (int i = 0; i < NI; ++i) *(uint4*)(lds + 16384 + lw + i * 2048) = rb[i];
    __syncthreads();
    for (int kt = 0; kt < nk; ++kt) {
        const int buf = kt & 1;
        if (kt + 1 < nk) {
            const size_t ao = (size_t)(kt + 1) * hi;
            const int bo = (kt + 1) * 64;
#pragma unroll
            for (int i = 0; i < 4; ++i) ra[i] = *(const uint4*)(ab[i] + ao);
#pragma unroll
            for (int i = 0; i < NI; ++i) rb[i] = *(const uint4*)(bb[i] + bo);
        }
        const char* la = lds + buf * 32768;
        const char* lb = la + 16384;
#pragma unroll
        for (int kp = 0; kp < 2; ++kp) {
            bf16x8 af[4], bf[NI];
#pragma unroll
            for (int i = 0; i < 4; ++i) af[i] = *(const bf16x8*)(la + kp * 8192 + (wr * 64 + i * 16 + fr) * 64 + fq * 16);
#pragma unroll
            for (int i = 0; i < NI; ++i) bf[i] = *(const bf16x8*)(lb + kp * 8192 + (wc * NI * 16 + i * 16 + fr) * 64 + fq * 16);
#pragma unroll
            for (int mi = 0; mi < 4; ++mi)
#pragma unroll
                for (int ni = 0; ni < NI; ++ni) acc[mi][ni] = TR ? mma(af[mi], bf[ni], acc[mi][ni]) : mma(bf[ni], af[mi], acc[mi][ni]);
        }
        if (kt + 1 < nk) {
            char* lwp = lds + (buf ^ 1) * 32768 + lw;
#pragma unroll
            for (int i = 0; i < 4; ++i) *(uint4*)(lwp + i * 2048) = ra[i];
#pragma unroll
            for (int i = 0; i < NI; ++i) *(uint4*)(lwp + 16384 + i * 2048) = rb[i];
        }
        __syncthreads();
    }
}
template <int NI>
DEVI void zero_acc(f32x4 (&acc)[4][NI]) {
#pragma unroll
    for (int i = 0; i < 4; ++i)
#pragma unroll
        for (int j = 0; j < NI; ++j) acc[i][j] = (f32x4){0.f, 0.f, 0.f, 0.f};
}
struct RowLin {
    const bf16_t* A; size_t lda;
    DEVI const bf16_t* operator()(int r) const { return A + (size_t)r * lda; }
};


template <bool TR>
DEVI void gemm2_main(f32x4 (&acc)[8][4], char* lds, const bf16_t* A, size_t lda, const bf16_t* Bt, int ldb, int nBmax, int m0, int n0, int K) {
    const int tid = tidx(), lane = tid & 63, wid = tid >> 6, wr = wid >> 1, wc = wid & 1, fr = lane & 15, fq = lane >> 4;
    const int c = tid & 3, r0 = tid >> 2;
    const bf16_t* ap = A + (size_t)(m0 + r0) * lda + c * 8;
    const bf16_t* bp0; const bf16_t* bp1;
    { int nr = n0 + r0; if (nr > nBmax) nr = nBmax; bp0 = Bt + (size_t)nr * ldb + c * 8; nr = n0 + r0 + 64; if (nr > nBmax) nr = nBmax; bp1 = Bt + (size_t)nr * ldb + c * 8; }
    const size_t a64 = (size_t)64 * lda;
    uint4 ra0, ra1, ra2, ra3, rb0, rb1;
    const int nk = K >> 5;
    const int lw = r0 * 64 + c * 16;
#define G2_LOAD(ko)                                                                                       \
    { ra0 = *(const uint4*)(ap + (ko)); ra1 = *(const uint4*)(ap + a64 + (ko)); ra2 = *(const uint4*)(ap + 2 * a64 + (ko)); \
      ra3 = *(const uint4*)(ap + 3 * a64 + (ko)); rb0 = *(const uint4*)(bp0 + (ko)); rb1 = *(const uint4*)(bp1 + (ko)); }
#define G2_STORE(st_)                                                                                     \
    { char* b_ = lds + (st_) * 24576 + lw; *(uint4*)(b_) = ra0; *(uint4*)(b_ + 4096) = ra1; *(uint4*)(b_ + 8192) = ra2; \
      *(uint4*)(b_ + 12288) = ra3; *(uint4*)(b_ + 16384) = rb0; *(uint4*)(b_ + 16384 + 4096) = rb1; }
    G2_LOAD(0);
    G2_STORE(0);
    __syncthreads();
    for (int kt = 0; kt < nk; ++kt) {
        const int st = kt & 1;
        if (kt + 1 < nk) G2_LOAD((kt + 1) * 32);
        const char* la = lds + st * 24576 + (wr * 128 + fr) * 64 + fq * 16;
        const char* lb = lds + st * 24576 + 16384 + (wc * 64 + fr) * 64 + fq * 16;
        bf16x8 bf[4];
#pragma unroll
        for (int i = 0; i < 4; ++i) bf[i] = *(const bf16x8*)(lb + i * 1024);
#pragma unroll
        for (int mi = 0; mi < 8; ++mi) {
            const bf16x8 af = *(const bf16x8*)(la + mi * 1024);
#pragma unroll
            for (int ni = 0; ni < 4; ++ni) acc[mi][ni] = TR ? mma(af, bf[ni], acc[mi][ni]) : mma(bf[ni], af, acc[mi][ni]);
        }
        if (kt + 1 < nk) G2_STORE(st ^ 1);
        __syncthreads();
    }
}

#define RAW_BARRIER() do { asm volatile("s_waitcnt lgkmcnt(0)" ::: "memory"); __builtin_amdgcn_s_barrier(); } while (0)
template <bool TR, int NI>
DEVI void gemm3_main(f32x4 (&acc)[8][NI], char* lds, const bf16_t* A, size_t lda, const bf16_t* Bt, int ldb, int nBmax, int m0, int n0, int K) {
    const int tid = tidx(), lane = tid & 63, wid = __builtin_amdgcn_readfirstlane(tid >> 6), wr = wid >> 1, wc = wid & 1, fr = lane & 15, fq = lane >> 4;
    const int c = tid & 3, r0 = tid >> 2;
    const bf16_t* ap = A + (size_t)(m0 + r0) * lda + c * 8;
    const bf16_t* bp0; const bf16_t* bp1;
    { int nr = n0 + r0; if (nr > nBmax) nr = nBmax; bp0 = Bt + (size_t)nr * ldb + c * 8; nr = n0 + r0 + 64; if (nr > nBmax) nr = nBmax; bp1 = Bt + (size_t)nr * ldb + c * 8; }
    const size_t a64 = (size_t)64 * lda;
    const int nk = K >> 5;
#define G3_ISSUE(kt_, st_)                                                                                                   \
    { char* d_ = lds + (st_) * 24576 + wid * 1024; const int ko_ = (kt_) * 32;                                               \
      __builtin_amdgcn_global_load_lds((const unsigned*)(ap + ko_), (unsigned*)(d_), 16, 0, 0);                               \
      __builtin_amdgcn_global_load_lds((const unsigned*)(ap + a64 + ko_), (unsigned*)(d_ + 4096), 16, 0, 0);                  \
      __builtin_amdgcn_global_load_lds((const unsigned*)(ap + 2 * a64 + ko_), (unsigned*)(d_ + 8192), 16, 0, 0);              \
      __builtin_amdgcn_global_load_lds((const unsigned*)(ap + 3 * a64 + ko_), (unsigned*)(d_ + 12288), 16, 0, 0);             \
      __builtin_amdgcn_global_load_lds((const unsigned*)(bp0 + ko_), (unsigned*)(d_ + 16384), 16, 0, 0);                      \
      if (NI == 4) __builtin_amdgcn_global_load_lds((const unsigned*)(bp1 + ko_), (unsigned*)(d_ + 20480), 16, 0, 0); }
    G3_ISSUE(0, 0);
    G3_ISSUE(1, 1);
    int st = 0;
    for (int kt = 0; kt < nk; ++kt) {
        if (kt + 1 < nk) { if (NI == 4) asm volatile("s_waitcnt vmcnt(6)" ::: "memory"); else asm volatile("s_waitcnt vmcnt(5)" ::: "memory"); }
        else asm volatile("s_waitcnt vmcnt(0)" ::: "memory");
        RAW_BARRIER();
        if (kt + 2 < nk) { const int s2 = st >= 1 ? st - 1 : 2; G3_ISSUE(kt + 2, s2); }
        const char* la = lds + st * 24576 + (wr * 128 + fr) * 64 + fq * 16;
        const char* lb = lds + st * 24576 + 16384 + (wc * NI * 16 + fr) * 64 + fq * 16;
        bf16x8 bf[NI];
#pragma unroll
        for (int i = 0; i < NI; ++i) bf[i] = *(const bf16x8*)(lb + i * 1024);
        __builtin_amdgcn_s_setprio(1);
#pragma unroll
        for (int mi = 0; mi < 8; ++mi) {
            const bf16x8 af = *(const bf16x8*)(la + mi * 1024);
#pragma unroll
            for (int ni = 0; ni < NI; ++ni) acc[mi][ni] = TR ? mma(af, bf[ni], acc[mi][ni]) : mma(bf[ni], af, acc[mi][ni]);
        }
        __builtin_amdgcn_s_setprio(0);
        st = st == 2 ? 0 : st + 1;
    }
    RAW_BARRIER();
}
DEVI void zero_acc2(f32x4 (&acc)[8][4]) {
#pragma unroll
    for (int i = 0; i < 8; ++i)
#pragma unroll
        for (int j = 0; j < 4; ++j) acc[i][j] = (f32x4){0.f, 0.f, 0.f, 0.f};
}
DEVI void rmsnorm_rows(const Params& p, int item) {
    const int thr_ = tidx();
    const int lane = thr_ & 63, wid = thr_ >> 6;
    const int row = item * 4 + wid;
    const float* xr = p.x + (size_t)row * DM;
    f32x4 v[8];
    float ss = 0.f;
#pragma unroll
    for (int i = 0; i < 8; ++i) { v[i] = *(const f32x4*)(xr + (i >> 1) * 512 + lane * 8 + (i & 1) * 4); ss += v[i][0] * v[i][0] + v[i][1] * v[i][1] + v[i][2] * v[i][2] + v[i][3] * v[i][3]; }
    ss = wave_sum(ss);
    const float rs = rsqrtf(ss * (1.f / DM) + 1e-6f);
    bf16_t* hr = (bf16_t*)(p.ws + O_H) + (size_t)row * DM;
#pragma unroll
    for (int i = 0; i < 8; i += 2) {
        const f32x4 g0 = *(const f32x4*)(p.pre_g + (i >> 1) * 512 + lane * 8), g1 = *(const f32x4*)(p.pre_g + (i >> 1) * 512 + lane * 8 + 4);
        *(uint4*)(hr + (i >> 1) * 512 + lane * 8) = make_uint4(pk2(v[i][0] * rs * g0[0], v[i][1] * rs * g0[1]), pk2(v[i][2] * rs * g0[2], v[i][3] * rs * g0[3]),
                                                            pk2(v[i + 1][0] * rs * g1[0], v[i + 1][1] * rs * g1[1]), pk2(v[i + 1][2] * rs * g1[2], v[i + 1][3] * rs * g1[3]));
    }
}
struct TJob { const float* src; bf16_t* dst; int K, ld, width; };
DEVI bool tjob(const Params& p, int j, TJob& t) {
    char* ws = p.ws;
    bf16_t* wint = (bf16_t*)(ws + O_WINT);
    switch (j) {
        case 0: t = {p.w_in, wint, 2048, DIN, 4096}; return true;
        case 1: t = {p.w_in + 4104, wint + (size_t)4096 * 2048, 2048, DIN, 2560}; return true;
        case 2: t = {p.w_in + 6712, wint + (size_t)6656 * 2048, 2048, DIN, 5120}; return true;
        case 3: t = {p.w_in + 4096, wint + (size_t)11776 * 2048, 2048, DIN, 8}; return true;
        case 4: t = {p.w_in + 6664, wint + (size_t)11784 * 2048, 2048, DIN, 48}; return true;
        case 5: t = {nullptr, wint + (size_t)11832 * 2048, 2048, DIN, 72}; return true;
        case 6: t = {p.w_up_m, (bf16_t*)(ws + O_WUM), 1024, 2048, 2048}; return true;
        case 7: t = {p.w_up_a, (bf16_t*)(ws + O_WUA), 1024, 2048, 2048}; return true;
        case 8: t = {p.w_out, (bf16_t*)(ws + O_WOUT), 2048, 2048, 2048}; return true;
        case 9: case 10: case 11: case 12: t = {p.w_q + (j - 9) * 65536, (bf16_t*)(ws + O_WQ) + (j - 9) * 65536, 256, 256, 256}; return true;
        case 13: case 14: case 15: case 16: t = {p.w_k + (j - 13) * 65536, (bf16_t*)(ws + O_WK) + (j - 13) * 65536, 256, 256, 256}; return true;
        case 17: t = {p.w1_k, (bf16_t*)(ws + O_W1K), 2048, 256, 256}; return true;
        case 18: t = {p.w1_v, (bf16_t*)(ws + O_W1V), 2048, 256, 256}; return true;
        case 19: t = {p.w2_k, (bf16_t*)(ws + O_W2K), 256, 64, 64}; return true;
        case 20: t = {p.w2_v, (bf16_t*)(ws + O_W2V), 256, 64, 64}; return true;
        default: return false;
    }
}
constexpr int N_TJOBS = 21;
constexpr int N_TTILES = 4264;
DEVI void transpose_item(const Params& p, int item, char* lds) {
    const int thr_ = tidx();
    TJob t;
    int j = 0;
    for (; j < N_TJOBS; ++j) {
        tjob(p, j, t);
        const int cnt = (t.K >> 6) * ((t.width + 127) >> 7);
        if (item < cnt) break;
        item -= cnt;
    }
    if (j >= N_TJOBS) return;
    const int tk = t.K >> 6;
    const int kt = item % tk, nt = item / tk;
    const int lane = thr_ & 63, wid = thr_ >> 6, kg = lane >> 3, nc = lane & 7;
    const int k0 = kt * 64 + kg * 8, n = nt * 128 + wid * 32 + nc * 4;
    if (n >= t.width) return;
    f32x4 v[8];
    if (t.src) {
        const float* sp = t.src + (size_t)k0 * t.ld + n;
#pragma unroll
        for (int r = 0; r < 8; ++r) v[r] = *(const f32x4*)(sp + (size_t)r * t.ld);
    } else {
#pragma unroll
        for (int r = 0; r < 8; ++r) v[r] = (f32x4){0.f, 0.f, 0.f, 0.f};
    }
    bf16_t* d = t.dst + (size_t)n * t.K + k0;
#pragma unroll
    for (int jj = 0; jj < 4; ++jj)
        *(uint4*)(d + (size_t)jj * t.K) = make_uint4(pk2(v[0][jj], v[1][jj]), pk2(v[2][jj], v[3][jj]), pk2(v[4][jj], v[5][jj]), pk2(v[6][jj], v[7][jj]));
}
DEVI void bias_item(const Params& p, int item) {
    const int thr_ = tidx();
    const int kv = item >> 4, seg = item & 15, j = thr_;
    const float* pe = kv ? p.pe_v : p.pe_k;
    const float* w1 = kv ? p.w1_v : p.w1_k;
    float a = 0.f;
#pragma unroll 8
    for (int k = seg * 128; k < seg * 128 + 128; ++k) a += pe[k] * w1[(size_t)k * 256 + j];
    ((float*)(p.ws + O_B1P))[(kv * 16 + seg) * 256 + j] = a;
}

DEVI void inproj_tile(const Params& p, int item, char* lds) {
    const int ni_ = item >> 5, mt = item & 31;
    const int nt = ni_ < 4 ? 40 + ni_ : (ni_ < 44 ? ni_ - 4 : ni_);
    const int m0 = mt * 256, n0 = nt * 128;
    const bool tr = (nt >= 8 && nt < 16) || nt == 46 || nt == 47 || nt == 50 || nt == 51;
    const int tid = tidx(), lane = tid & 63, wid = tid >> 6, wr = wid >> 1, wc = wid & 1, fr = lane & 15, fq = lane >> 4;
    f32x4 acc[8][4];
    zero_acc2(acc);
    const bf16_t* A = (const bf16_t*)(p.ws + O_H);
    const bf16_t* Bt = (const bf16_t*)(p.ws + O_WINT);
    if (tr) {
        gemm3_main<true, 4>(acc, lds, A, DM, Bt, DM, NP - 1, m0, n0, DM);
        bf16_t* base; int cb, ncol;
        if (nt < 16) { base = (bf16_t*)(p.ws + O_VMT); cb = C_MV; ncol = 1024; }
        else if (nt < 48) { base = (bf16_t*)(p.ws + O_VST); cb = C_VS; ncol = 256; }
        else { base = (bf16_t*)(p.ws + O_VWT); cb = C_VW; ncol = 256; }
#pragma unroll
        for (int mi = 0; mi < 8; mi += 2)
#pragma unroll
            for (int ni = 0; ni < 4; ++ni) {
                const int row = m0 + wr * 128 + (mi + (fq & 1)) * 16 + (fq >> 1) * 8, col = n0 + wc * 64 + ni * 16 + fr - cb;
                const int b = row >> 11, s_ = row & 2047;
                uint2 x, y;
                x.x = pk2(acc[mi][ni][0], acc[mi][ni][1]); x.y = pk2(acc[mi][ni][2], acc[mi][ni][3]);
                y.x = pk2(acc[mi + 1][ni][0], acc[mi + 1][ni][1]); y.y = pk2(acc[mi + 1][ni][2], acc[mi + 1][ni][3]);
                *(uint4*)(base + ((size_t)(b * ncol + col)) * S + s_) = pair16(x, y);
            }
    } else {
        gemm3_main<false, 4>(acc, lds, A, DM, Bt, DM, NP - 1, m0, n0, DM);
        if (n0 == C_GATE) {
            float* G = (float*)(p.ws + O_G);
#pragma unroll
            for (int mi = 0; mi < 8; ++mi)
#pragma unroll
                for (int ni = 0; ni < 4; ++ni) {
                    const int row = m0 + wr * 128 + mi * 16 + fr, cl = wc * 64 + ni * 16 + fq * 4;
                    if (cl < 56) *(f32x4*)(G + (size_t)row * 64 + cl) = acc[mi][ni];
                }
        } else {
            bf16_t* P = (bf16_t*)(p.ws + O_P);
#pragma unroll
            for (int mi = 0; mi < 8; ++mi)
#pragma unroll
                for (int ni = 0; ni < 4; ni += 2) {
                    const int row = m0 + wr * 128 + mi * 16 + fr, col = n0 + wc * 64 + (ni + (fq & 1)) * 16 + (fq >> 1) * 8;
                    uint2 x, y;
                    x.x = pk2(acc[mi][ni][0], acc[mi][ni][1]); x.y = pk2(acc[mi][ni][2], acc[mi][ni][3]);
                    y.x = pk2(acc[mi][ni + 1][0], acc[mi][ni + 1][1]); y.y = pk2(acc[mi][ni + 1][2], acc[mi][ni + 1][3]);
                    store_nt16(P + (size_t)row * NPS + col, pair16(x, y));
                }
        }
    }
    if (ni_ < 4) {
        asm volatile("s_waitcnt vmcnt(0)" ::: "memory");
        __syncthreads();
        if (threadIdx.x == 0) {
            __builtin_amdgcn_fence(__ATOMIC_RELEASE, "agent");
            asm volatile("s_waitcnt vmcnt(0)" ::: "memory");
            xb_add((unsigned*)(p.ws + O_BAR) + 0, 1u);
        }
    }
}

DEVI void conv_item(const Params& p, int item) {
    const int thr_ = tidx();
    const int tok = item * 2 + (thr_ >> 7), c = (thr_ & 127) * 8;
    const int s = tok & 2047;
    const bf16_t* P = (const bf16_t*)(p.ws + O_P);
    float acc[8];
#pragma unroll
    for (int i = 0; i < 8; ++i) acc[i] = p.conv_b[c + i];
#pragma unroll
    for (int k = 0; k < 4; ++k) {
        const int ds = k - 3;
        if (s + ds >= 0) {
            const uint4 xv = *(const uint4*)(P + (size_t)(tok + ds) * NPS + C_MX + c);
            const f32x4 w0 = *(const f32x4*)(p.conv_w + k * 1024 + c), w1 = *(const f32x4*)(p.conv_w + k * 1024 + c + 4);
            acc[0] += lo16(xv.x) * w0[0]; acc[1] += hi16(xv.x) * w0[1]; acc[2] += lo16(xv.y) * w0[2]; acc[3] += hi16(xv.y) * w0[3];
            acc[4] += lo16(xv.z) * w1[0]; acc[5] += hi16(xv.z) * w1[1]; acc[6] += lo16(xv.w) * w1[2]; acc[7] += hi16(xv.w) * w1[3];
        }
    }
    uint4 o;
    o.x = pk2(silu(acc[0]), silu(acc[1])); o.y = pk2(silu(acc[2]), silu(acc[3])); o.z = pk2(silu(acc[4]), silu(acc[5])); o.w = pk2(silu(acc[6]), silu(acc[7]));
    *(uint4*)((bf16_t*)(p.ws + O_XC) + (size_t)tok * 1024 + c) = o;
}
struct RowCmp {
    const bf16_t* Pc;
    DEVI const bf16_t* operator()(int r) const {
        if (r > 2031) r = 2031;
        const int bg = r / 127, n = r - bg * 127, b = bg >> 2, g = bg & 3;
        return Pc + (size_t)(b * S + 16 * n) * NPS + g * 64;
    }
};
DEVI void cmp1_tile(const Params& p, int item, char* lds) {
    const int kv = item >> 5, mt = (item >> 1) & 15, nt = item & 1;
    const int m0 = mt * 128, n0 = nt * 128;
    const int tid = tidx(), lane = tid & 63, wid = tid >> 6, wr = wid >> 1, wc = wid & 1, fr = lane & 15, fq = lane >> 4;
    f32x4 acc[4][4];
    zero_acc(acc);
    RowCmp rc{(const bf16_t*)(p.ws + O_P) + (kv ? C_VC : C_KC)};
    gemm_main<false, 4>(acc, lds, rc, (size_t)NPS, (const bf16_t*)(p.ws + (kv ? O_W1V : O_W1K)), 2048, 255, m0, n0, 2048);
    const float* bp = (const float*)(p.ws + O_B1P) + kv * 16 * 256;
    bf16_t* HC = (bf16_t*)(p.ws + O_HC) + (size_t)kv * 2048 * 256;
#pragma unroll
    for (int ni = 0; ni < 4; ++ni) {
        const int col = n0 + wc * 64 + ni * 16 + fq * 4;
        f32x4 bs = {0.f, 0.f, 0.f, 0.f};
        for (int sg = 0; sg < 16; ++sg) bs += *(const f32x4*)(bp + sg * 256 + col);
#pragma unroll
        for (int mi = 0; mi < 4; ++mi) {
            const int row = m0 + wr * 64 + mi * 16 + fr;
            const f32x4 v = acc[mi][ni] + bs;
            uint2 o; o.x = pk2(silu(v[0]), silu(v[1])); o.y = pk2(silu(v[2]), silu(v[3]));
            *(uint2*)(HC + (size_t)row * 256 + col) = o;
        }
    }
}
DEVI void scan_item(const Params& p, int item, char* lds) {
    const int thr_ = tidx();
    const int b = item >> 2, h = item & 3, tid = thr_;
    const float* G = (const float*)(p.ws + O_G);
    float* red = (float*)lds;
    const float bi = p.b_i[h], bfv = p.b_f[h];
    float ig[8], F[8];
    float run = 0.f;
#pragma unroll
    for (int i = 0; i < 8; ++i) {
        const size_t tok = (size_t)b * S + tid * 8 + i;
        ig[i] = G[tok * 64 + h] + bi;
        const float fg = G[tok * 64 + 4 + h] + bfv;
        const float lf = fminf(fg, 0.f) - log1pf(expf(-fabsf(fg)));
        run += lf;
        F[i] = run;
    }
    red[tid] = run;
    __syncthreads();
    float ex = 0.f;
    for (int j = 0; j < tid; ++j) ex += red[j];
    __syncthreads();
    float a[8], mx[8];
    float rm = -1e30f;
#pragma unroll
    for (int i = 0; i < 8; ++i) { F[i] += ex; a[i] = ig[i] - F[i]; rm = fmaxf(rm, a[i]); mx[i] = rm; }
    red[tid] = rm;
    __syncthreads();
    float em = -1e30f;
    for (int j = 0; j < tid; ++j) em = fmaxf(em, red[j]);
    __syncthreads();
    float* FA = (float*)(p.ws + O_FA) + item * S + tid * 8;
    float* FM = (float*)(p.ws + O_FM) + item * S + tid * 8;
    float* FL = (float*)(p.ws + O_FL) + item * S + tid * 8;
#pragma unroll
    for (int i = 0; i < 8; ++i) { const float m = fmaxf(mx[i], em); FA[i] = a[i]; FM[i] = m; FL[i] = F[i] + m; }
}

DEVI void qk_tile(const Params& p, int item, char* lds) {
    const int nt = item & 1, mt = (item >> 1) & 63, h = (item >> 7) & 3, qk = item >> 9;
    const int m0 = mt * 128, n0 = nt * 128;
    const int tid = tidx(), lane = tid & 63, wid = tid >> 6, wr = wid >> 1, wc = wid & 1, fr = lane & 15, fq = lane >> 4;
    f32x4 acc[4][4];
    zero_acc(acc);
    RowLin rl{(const bf16_t*)(p.ws + O_XC) + h * 256, (size_t)1024};
    gemm_main<false, 4>(acc, lds, rl, 64, (const bf16_t*)(p.ws + (qk ? O_WK : O_WQ)) + h * 65536, 256, 255, m0, n0, 256);
    bf16_t* O = (bf16_t*)(p.ws + (qk ? O_KM : O_QM));
    const float sc = qk ? 0.0625f : 1.f;
#pragma unroll
    for (int mi = 0; mi < 4; ++mi)
#pragma unroll
        for (int ni = 0; ni < 4; ni += 2) {
            const int row = m0 + wr * 64 + mi * 16 + fr, col = h * 256 + n0 + wc * 64 + (ni + (fq & 1)) * 16 + (fq >> 1) * 8;
            uint2 x, y;
            x.x = pk2(acc[mi][ni][0] * sc, acc[mi][ni][1] * sc); x.y = pk2(acc[mi][ni][2] * sc, acc[mi][ni][3] * sc);
            y.x = pk2(acc[mi][ni + 1][0] * sc, acc[mi][ni + 1][1] * sc); y.y = pk2(acc[mi][ni + 1][2] * sc, acc[mi][ni + 1][3] * sc);
            *(uint4*)(O + (size_t)row * 1024 + col) = pair16(x, y);
        }
}
DEVI void cmp2_tile(const Params& p, int item, char* lds) {
    const int kv = item >> 4, mt = item & 15, m0 = mt * 128;
    const int tid = tidx(), lane = tid & 63, wid = tid >> 6, wr = wid >> 1, wc = wid & 1, fr = lane & 15, fq = lane >> 4;
    f32x4 acc[4][4];
    zero_acc(acc);
    RowLin rl{(const bf16_t*)(p.ws + O_HC) + (size_t)kv * 2048 * 256, (size_t)256};
    gemm_main<false, 4>(acc, lds, rl, 64, (const bf16_t*)(p.ws + (kv ? O_W2V : O_W2K)), 256, 63, m0, 0, 256);
    float* O = (float*)(p.ws + (kv ? O_VCF : O_KCF));
    if (wc == 0) {
#pragma unroll
        for (int mi = 0; mi < 4; ++mi)
#pragma unroll
            for (int ni = 0; ni < 4; ++ni) {
                const int row = m0 + wr * 64 + mi * 16 + fr, col = ni * 16 + fq * 4;
                if (row < 2032) *(f32x4*)(O + (size_t)row * 64 + col) = acc[mi][ni];
            }
    }
}

DEVI void mlstm_item(const Params& p, int item) {
    const int thr_ = tidx();
    const int qb = 31 - (item >> 4), bh = item & 15, b = bh >> 2, h = bh & 3;
    const int lane = thr_ & 63, wid = __builtin_amdgcn_readfirstlane(thr_ >> 6), fr = lane & 15, fq = lane >> 4;
    const int t0 = qb * 64 + wid * 16, trow = t0 + fr;
    const bf16_t* Qm = (const bf16_t*)(p.ws + O_QM);
    const bf16_t* Km = (const bf16_t*)(p.ws + O_KM);
    const bf16_t* VmT = (const bf16_t*)(p.ws + O_VMT);
    const float* fa = (const float*)(p.ws + O_FA) + bh * S;
    const float mx = ((const float*)(p.ws + O_FM))[bh * S + trow];
    bf16x8 qf[8];
    {
        const bf16_t* qrow = Qm + (size_t)(b * S + trow) * 1024 + h * 256 + fq * 8;
#pragma unroll
        for (int ks = 0; ks < 8; ++ks) qf[ks] = *(const bf16x8*)(qrow + ks * 32);
    }
    f32x4 o[16];
#pragma unroll
    for (int i = 0; i < 16; ++i) o[i] = (f32x4){0.f, 0.f, 0.f, 0.f};
    float den = 0.f;
    const bf16_t* kbase = Km + (size_t)(b * S + fr) * 1024 + h * 256 + fq * 8;
    const bf16_t* vbase = VmT + ((size_t)(b * 1024 + h * 256 + fr)) * S + fq * 4;
    for (int s0 = 0; s0 < t0 + 16; s0 += 32) {
        f32x4 sa = {0.f, 0.f, 0.f, 0.f}, sb = {0.f, 0.f, 0.f, 0.f};
        const bf16_t* k0 = kbase + (size_t)s0 * 1024;
        const bf16_t* k1 = k0 + 16 * 1024;
#pragma unroll
        for (int ks = 0; ks < 8; ++ks) {
            sa = mma(*(const bf16x8*)(k0 + ks * 32), qf[ks], sa);
            sb = mma(*(const bf16x8*)(k1 + ks * 32), qf[ks], sb);
            if (ks == 3) __builtin_amdgcn_sched_barrier(0);
        }
        __builtin_amdgcn_sched_barrier(0);
        const f32x4 a0 = *(const f32x4*)(fa + s0 + fq * 4), a1 = *(const f32x4*)(fa + s0 + 16 + fq * 4);
        float pv[8];
#pragma unroll
        for (int r = 0; r < 4; ++r) {
            const int s = s0 + fq * 4 + r;
            const float w0 = (s <= trow) ? __expf(a0[r] - mx) : 0.f;
            const float w1 = (s + 16 <= trow) ? __expf(a1[r] - mx) : 0.f;
            pv[r] = sa[r] * w0; pv[4 + r] = sb[r] * w1;
            den += pv[r] + pv[4 + r];
        }
        const bf16x8 pf = pack8(pv);
#pragma unroll
        for (int dvt = 0; dvt < 16; ++dvt) {
            const bf16_t* vp = vbase + (size_t)(dvt * 16) * S + s0;
            const bf16x8 vf = join8(*(const uint2*)vp, *(const uint2*)(vp + 16));
            o[dvt] = mma(vf, pf, o[dvt]);
            if ((dvt & 3) == 3) __builtin_amdgcn_sched_barrier(0);
        }
    }
    den += __shfl_xor(den, 16);
    den += __shfl_xor(den, 32);
    const float lower = __expf(-((const float*)(p.ws + O_FL))[bh * S + trow]);
    const float inv = 1.f / fmaxf(fabsf(den), lower);
    const bf16_t* Prow = (const bf16_t*)(p.ws + O_P) + (size_t)(b * S + trow) * NPS;
    float sum = 0.f;
#pragma unroll
    for (int dvt = 0; dvt < 16; ++dvt) {
        const int c = h * 256 + dvt * 16 + fq * 4;
        const uint2 op = *(const uint2*)(Prow + C_MO + c);
        o[dvt][0] *= inv * sigm(lo16(op.x)); o[dvt][1] *= inv * sigm(hi16(op.x)); o[dvt][2] *= inv * sigm(lo16(op.y)); o[dvt][3] *= inv * sigm(hi16(op.y));
        sum += o[dvt][0] + o[dvt][1] + o[dvt][2] + o[dvt][3];
    }
    sum += __shfl_xor(sum, 16);
    sum += __shfl_xor(sum, 32);
    const float mu = sum * (1.f / 256.f);
    float vs = 0.f;
#pragma unroll
    for (int dvt = 0; dvt < 16; ++dvt)
#pragma unroll
        for (int r = 0; r < 4; ++r) { const float d = o[dvt][r] - mu; vs += d * d; }
    vs += __shfl_xor(vs, 16);
    vs += __shfl_xor(vs, 32);
    const float rstd = rsqrtf(vs * (1.f / 256.f) + 1e-6f);
    const bf16_t* xcrow = (const bf16_t*)(p.ws + O_XC) + (size_t)(b * S + trow) * 1024;
    bf16_t* ymrow = (bf16_t*)(p.ws + O_YM) + (size_t)(b * S + trow) * 1024;
#pragma unroll
    for (int dvt = 0; dvt < 16; ++dvt) {
        const int c = h * 256 + dvt * 16 + fq * 4;
        const f32x4 ng = *(const f32x4*)(p.norm_g + c), sk = *(const f32x4*)(p.skip + c);
        const uint2 xc = *(const uint2*)(xcrow + c), mz = *(const uint2*)(Prow + C_MZ + c);
        const float y0 = ((o[dvt][0] - mu) * rstd * ng[0] + sk[0] * lo16(xc.x)) * silu(lo16(mz.x));
        const float y1 = ((o[dvt][1] - mu) * rstd * ng[1] + sk[1] * hi16(xc.x)) * silu(hi16(mz.x));
        const float y2 = ((o[dvt][2] - mu) * rstd * ng[2] + sk[2] * lo16(xc.y)) * silu(lo16(mz.y));
        const float y3 = ((o[dvt][3] - mu) * rstd * ng[3] + sk[3] * hi16(xc.y)) * silu(hi16(mz.y));
        uint2 ov; ov.x = pk2(y0, y1); ov.y = pk2(y2, y3);
        *(uint2*)(ymrow + c) = ov;
    }
}

DEVI void cmp_item(const Params& p, int item, char* lds) {
    const int thr_ = tidx();
    const int tt = item & 31, bg = item >> 5, b = bg >> 2, g = bg & 3;
    const int lane = thr_ & 63, wid = __builtin_amdgcn_readfirstlane(thr_ >> 6);
    float* kcs = (float*)lds;
    float* psum = (float*)(lds + 33280) + wid * 128;
    const float* KC = (const float*)(p.ws + O_KCF) + (size_t)bg * 127 * 64;
    const float* VC = (const float*)(p.ws + O_VCF) + (size_t)bg * 127 * 64;
    for (int i = thr_; i < 127 * 64; i += 256) kcs[(i >> 6) * 65 + (i & 63)] = KC[i];
    __syncthreads();
    const bf16_t* P = (const bf16_t*)(p.ws + O_P);
    bf16_t* OC = (bf16_t*)(p.ws + O_OC);
    unsigned* SEL = (unsigned*)(p.ws + O_SEL);
#pragma unroll 1
    for (int i = 0; i < 16; ++i) {
        const int t = tt * 64 + wid * 16 + i;
        const size_t tok = (size_t)b * S + t;
        const int nvalid = t >= 31 ? ((t - 31) >> 4) + 1 : 0;
        unsigned mask = 1u;
        if (nvalid == 0) {
#pragma unroll
            for (int h = 0; h < 4; ++h) OC[tok * 1024 + (g * 4 + h) * 64 + lane] = 0;
        } else {
            float qh[4];
#pragma unroll
            for (int h = 0; h < 4; ++h) qh[h] = bf2f(P[tok * NPS + C_AQ + (g * 4 + h) * 64 + lane]) * 0.125f;
            float s0[4] = {0.f, 0.f, 0.f, 0.f}, s1[4] = {0.f, 0.f, 0.f, 0.f};
            const int n1 = lane + 64 > 126 ? 126 : lane + 64;
            const float* k0p = kcs + lane * 65;
            const float* k1p = kcs + n1 * 65;
#pragma unroll
            for (int d = 0; d < 64; ++d) {
                const float k0 = k0p[d], k1 = k1p[d];
#pragma unroll
                for (int h = 0; h < 4; ++h) { const float qd = rdlane(qh[h], d); s0[h] += qd * k0; s1[h] += qd * k1; }
            }
            const bool v0 = lane < nvalid, v1 = lane + 64 < nvalid;
            float p0[4], p1[4];
#pragma unroll
            for (int h = 0; h < 4; ++h) {
                const float mxv = wave_max(fmaxf(v0 ? s0[h] : -1e30f, v1 ? s1[h] : -1e30f));
                const float e0 = v0 ? __expf(s0[h] - mxv) : 0.f, e1 = v1 ? __expf(s1[h] - mxv) : 0.f;
                const float sm = wave_sum(e0 + e1);
                const float is = 1.f / sm;
                p0[h] = e0 * is; p1[h] = e1 * is;
            }
            float oc[4] = {0.f, 0.f, 0.f, 0.f};
            const int na = nvalid < 64 ? nvalid : 64;
            for (int n = 0; n < na; ++n) {
                const float vv = VC[n * 64 + lane];
#pragma unroll
                for (int h = 0; h < 4; ++h) oc[h] += rdlane(p0[h], n) * vv;
            }
            for (int n = 64; n < nvalid; ++n) {
                const float vv = VC[n * 64 + lane];
#pragma unroll
                for (int h = 0; h < 4; ++h) oc[h] += rdlane(p1[h], n - 64) * vv;
            }
#pragma unroll
            for (int h = 0; h < 4; ++h) OC[tok * 1024 + (g * 4 + h) * 64 + lane] = f2bf(oc[h]);
            psum[lane] = p0[0] + p0[1] + p0[2] + p0[3];
            psum[lane + 64] = (lane + 64 < 127) ? (p1[0] + p1[1] + p1[2] + p1[3]) : 0.f;
            __builtin_amdgcn_wave_barrier();
            float sc = -3e30f;
            const int cur = t >> 6;
            if (lane < 32) {
                float imp = 0.f;
#pragma unroll
                for (int k = -1; k < 4; ++k) { const int n = 4 * lane + k; if (n >= 0) imp += psum[n]; }
                const bool forced = lane == 0 || lane == cur || lane == cur - 1;
                sc = forced ? 1e30f : (lane <= cur ? imp : -1e30f);
            }
            __builtin_amdgcn_wave_barrier();
            mask = 0u;
#pragma unroll 1
            for (int it = 0; it < 8; ++it) {
                const float mv = wave_max(sc);
                const unsigned long long bal = __ballot(sc == mv);
                const int win = __ffsll((long long)bal) - 1;
                mask |= 1u << win;
                if (lane == win) sc = -4e30f;
            }
        }
        if (lane == 0) SEL[bg * S + t] = mask;
    }
    __syncthreads();
}

DEVI void attn_chunk(f32x4 (&o)[4], float& m, float& l, bf16x8 q0, bf16x8 q1, const bf16_t* kp, const bf16_t* vp, unsigned vm) {
    f32x4 sa = {0.f, 0.f, 0.f, 0.f}, sb = {0.f, 0.f, 0.f, 0.f};
    sa = mma(*(const bf16x8*)(kp), q0, sa);
    sa = mma(*(const bf16x8*)(kp + 32), q1, sa);
    sb = mma(*(const bf16x8*)(kp + (size_t)16 * NPS), q0, sb);
    sb = mma(*(const bf16x8*)(kp + (size_t)16 * NPS + 32), q1, sb);
    float v[8];
#pragma unroll
    for (int r = 0; r < 4; ++r) { v[r] = sa[r] * 0.125f; v[4 + r] = sb[r] * 0.125f; }
    float mxv = -1e30f;
#pragma unroll
    for (int e = 0; e < 8; ++e) if ((vm >> e) & 1u) mxv = fmaxf(mxv, v[e]);
    mxv = fmaxf(mxv, __shfl_xor(mxv, 16));
    mxv = fmaxf(mxv, __shfl_xor(mxv, 32));
    const float mn = fmaxf(m, mxv);
    const float alpha = __expf(m - mn);
    m = mn;
    float ps = 0.f;
#pragma unroll
    for (int e = 0; e < 8; ++e) { v[e] = ((vm >> e) & 1u) ? __expf(v[e] - mn) : 0.f; ps += v[e]; }
    l = l * alpha + ps;
    const bf16x8 pf = pack8(v);
#pragma unroll
    for (int dvt = 0; dvt < 4; ++dvt) {
        o[dvt] *= alpha;
        const bf16_t* vq = vp + (size_t)(dvt * 16) * S;
        const bf16x8 vf = join8(*(const uint2*)vq, *(const uint2*)(vq + 16));
        o[dvt] = mma(vf, pf, o[dvt]);
    }
}
template <bool SELB>
DEVI void nsa_item(const Params& p, int item) {
    const int thr_ = tidx();
    const int tile = item & 127, bg = item >> 7, b = bg >> 2, g = bg & 3;
    const int lane = thr_ & 63, wid = __builtin_amdgcn_readfirstlane(thr_ >> 6), fr = lane & 15, fq = lane >> 4;
    const int hd = g * 4 + wid, t0 = tile * 16, trow = t0 + fr;
    const bf16_t* P = (const bf16_t*)(p.ws + O_P);
    const size_t tok = (size_t)b * S + trow;
    const bf16_t* qp = P + tok * NPS + C_AQ + hd * 64 + fq * 8;
    const bf16x8 q0 = *(const bf16x8*)qp, q1 = *(const bf16x8*)(qp + 32);
    const bf16_t* kb = P + (size_t)(b * S + fr) * NPS + (SELB ? C_KS : C_KW) + g * 64 + fq * 8;
    const bf16_t* vb = (const bf16_t*)(p.ws + (SELB ? O_VST : O_VWT)) + (size_t)(b * 256 + g * 64 + fr) * S + fq * 4;
    f32x4 o[4];
#pragma unroll
    for (int i = 0; i < 4; ++i) o[i] = (f32x4){0.f, 0.f, 0.f, 0.f};
    float m = -1e30f, l = 0.f;
    if (!SELB) {
        int lo = t0 - 511;
        if (lo < 0) lo = 0;
        for (int s0 = lo & ~31; s0 < t0 + 16; s0 += 32) {
            unsigned vm = 0;
#pragma unroll
            for (int e = 0; e < 8; ++e) { const int s = s0 + (e >> 2) * 16 + fq * 4 + (e & 3); if (s <= trow && s > trow - 512) vm |= 1u << e; }
            attn_chunk(o, m, l, q0, q1, kb + (size_t)s0 * NPS, vb + s0, vm);
        }
    } else {
        const unsigned rm = ((const unsigned*)(p.ws + O_SEL))[bg * S + trow];
        unsigned un = rm;
        un |= __shfl_xor(un, 1); un |= __shfl_xor(un, 2); un |= __shfl_xor(un, 4); un |= __shfl_xor(un, 8);
        un = __builtin_amdgcn_readfirstlane(un);
        const int cur = t0 >> 6;
        for (int j = 0; j <= cur; ++j) {
            if (!((un >> j) & 1u)) continue;
            const bool rs = (rm >> j) & 1u;
#pragma unroll
            for (int hf = 0; hf < 2; ++hf) {
                const int s0 = j * 64 + hf * 32;
                unsigned vm = 0;
#pragma unroll
                for (int e = 0; e < 8; ++e) { const int s = s0 + (e >> 2) * 16 + fq * 4 + (e & 3); if (rs && s <= trow) vm |= 1u << e; }
                attn_chunk(o, m, l, q0, q1, kb + (size_t)s0 * NPS, vb + s0, vm);
            }
        }
    }
    l += __shfl_xor(l, 16);
    l += __shfl_xor(l, 32);
    const float inv = 1.f / l;
    if (!SELB) {
        bf16_t* OW = (bf16_t*)(p.ws + O_OW) + tok * 1024 + hd * 64 + fq * 4;
#pragma unroll
        for (int dvt = 0; dvt < 4; ++dvt) {
            uint2 ov; ov.x = pk2(o[dvt][0] * inv, o[dvt][1] * inv); ov.y = pk2(o[dvt][2] * inv, o[dvt][3] * inv);
            *(uint2*)(OW + dvt * 16) = ov;
        }
    } else {
        const float* G = (const float*)(p.ws + O_G) + tok * 64 + 8 + hd * 3;
        const float g0 = sigm(G[0]), g1 = sigm(G[1]) * inv, g2 = sigm(G[2]);
        const bf16_t* OC = (const bf16_t*)(p.ws + O_OC) + tok * 1024 + hd * 64 + fq * 4;
        const bf16_t* OW = (const bf16_t*)(p.ws + O_OW) + tok * 1024 + hd * 64 + fq * 4;
        const bf16_t* AZ = P + tok * NPS + C_AZ + hd * 64 + fq * 4;
        bf16_t* YA = (bf16_t*)(p.ws + O_YA) + tok * 1024 + hd * 64 + fq * 4;
#pragma unroll
        for (int dvt = 0; dvt < 4; ++dvt) {
            const uint2 oc = *(const uint2*)(OC + dvt * 16), ow = *(const uint2*)(OW + dvt * 16), az = *(const uint2*)(AZ + dvt * 16);
            const float y0 = (g0 * lo16(oc.x) + g1 * o[dvt][0] + g2 * lo16(ow.x)) * silu(lo16(az.x));
            const float y1 = (g0 * hi16(oc.x) + g1 * o[dvt][1] + g2 * hi16(ow.x)) * silu(hi16(az.x));
            const float y2 = (g0 * lo16(oc.y) + g1 * o[dvt][2] + g2 * lo16(ow.y)) * silu(lo16(az.y));
            const float y3 = (g0 * hi16(oc.y) + g1 * o[dvt][3] + g2 * hi16(ow.y)) * silu(hi16(az.y));
            uint2 ov; ov.x = pk2(y0, y1); ov.y = pk2(y2, y3);
            *(uint2*)(YA + dvt * 16) = ov;
        }
    }
}


constexpr int ML_K = 16384, ML_V = 20480, ML_STAGE = ML_K + ML_V;
DEVI void mlstm2_item(const Params& p, int item, char* lds) {
    const int thr_ = tidx();
    const int half = item >> 8, idx = item & 255;
    const int qb = half ? (idx >> 4) : 31 - (idx >> 4), bh = idx & 15, b = bh >> 2, h = bh & 3;
    const int lane = thr_ & 63, wid = __builtin_amdgcn_readfirstlane(thr_ >> 6), fr = lane & 15, fq = lane >> 4;
    const int T0 = qb * 64, t0 = T0 + wid * 16, trow = t0 + fr;
    const bf16_t* Km = (const bf16_t*)(p.ws + O_KM) + (size_t)(b * S) * 1024 + h * 256;
    const bf16_t* VmT = (const bf16_t*)(p.ws + O_VMT) + (size_t)(b * 1024 + h * 256) * S;
    const float* fa = (const float*)(p.ws + O_FA) + bh * S;
    const float mx = ((const float*)(p.ws + O_FM))[bh * S + trow];
    bf16x8 qf[8];
    {
        const bf16_t* qrow = (const bf16_t*)(p.ws + O_QM) + (size_t)(b * S + trow) * 1024 + h * 256 + fq * 8;
#pragma unroll
        for (int ks = 0; ks < 8; ++ks) qf[ks] = *(const bf16x8*)(qrow + ks * 32);
    }
    f32x4 o[16];
#pragma unroll
    for (int i = 0; i < 16; ++i) o[i] = (f32x4){0.f, 0.f, 0.f, 0.f};
    float den = 0.f;
    const int kr = thr_ >> 5, kc = thr_ & 31, vr = thr_ >> 2, vc = thr_ & 3;
    uint4 rk0, rk1, rk2, rk3, rv0, rv1, rv2, rv3;
#define ML_GLOAD(s0_)                                                                      \
    {                                                                                      \
        const bf16_t* kp_ = Km + (size_t)((s0_) + kr) * 1024 + kc * 8;                     \
        rk0 = *(const uint4*)(kp_); rk1 = *(const uint4*)(kp_ + 8 * 1024);                 \
        rk2 = *(const uint4*)(kp_ + 16 * 1024); rk3 = *(const uint4*)(kp_ + 24 * 1024);    \
        const bf16_t* vp_ = VmT + (size_t)vr * S + (s0_) + vc * 8;                         \
        rv0 = *(const uint4*)(vp_); rv1 = *(const uint4*)(vp_ + (size_t)64 * S);           \
        rv2 = *(const uint4*)(vp_ + (size_t)128 * S); rv3 = *(const uint4*)(vp_ + (size_t)192 * S); \
    }
#define ML_LSTORE(st_)                                                                     \
    {                                                                                      \
        char* kb_ = lds + (st_) * ML_STAGE + (kc >> 2) * 2048 + kr * 64 + (kc & 3) * 16;   \
        *(uint4*)(kb_) = rk0; *(uint4*)(kb_ + 8 * 64) = rk1; *(uint4*)(kb_ + 16 * 64) = rk2; *(uint4*)(kb_ + 24 * 64) = rk3; \
        char* vb_ = lds + (st_) * ML_STAGE + ML_K + vr * 80 + vc * 16;                     \
        *(uint4*)(vb_) = rv0; *(uint4*)(vb_ + 64 * 80) = rv1; *(uint4*)(vb_ + 128 * 80) = rv2; *(uint4*)(vb_ + 192 * 80) = rv3; \
    }
    const int nch = 2 * qb + 2;
    ML_GLOAD(0);
    ML_LSTORE(0);
    __syncthreads();
    for (int ci = 0; ci < nch; ++ci) {
        const int s0 = ci * 32, st = ci & 1;
        if (ci + 1 < nch) ML_GLOAD(s0 + 32);
        if (s0 < t0 + 16) {
            __builtin_amdgcn_s_setprio(1);
            const char* kb = lds + st * ML_STAGE;
            const char* vb = kb + ML_K;
            const f32x4 a0 = *(const f32x4*)(fa + s0 + fq * 4), a1 = *(const f32x4*)(fa + s0 + 16 + fq * 4);
            f32x4 sa = {0.f, 0.f, 0.f, 0.f}, sb = {0.f, 0.f, 0.f, 0.f};
#pragma unroll
            for (int ks = 0; ks < 8; ++ks) {
                sa = mma(*(const bf16x8*)(kb + ks * 2048 + fr * 64 + fq * 16), qf[ks], sa);
                sb = mma(*(const bf16x8*)(kb + ks * 2048 + (16 + fr) * 64 + fq * 16), qf[ks], sb);
            }
            float pv[8];
#pragma unroll
            for (int r = 0; r < 4; ++r) {
                const int s = s0 + fq * 4 + r;
                const float w0 = (s <= trow) ? __expf(a0[r] - mx) : 0.f;
                const float w1 = (s + 16 <= trow) ? __expf(a1[r] - mx) : 0.f;
                pv[r] = sa[r] * w0; pv[4 + r] = sb[r] * w1;
                den += pv[r] + pv[4 + r];
            }
            const bf16x8 pf = pack8(pv);
#pragma unroll
            for (int dvt = 0; dvt < 16; ++dvt) {
                const char* vp = vb + (dvt * 16 + fr) * 80 + fq * 8;
                const bf16x8 vf = join8(*(const uint2*)vp, *(const uint2*)(vp + 32));
                o[dvt] = mma(vf, pf, o[dvt]);
            }
            __builtin_amdgcn_s_setprio(0);
        }
        if (ci + 1 < nch) ML_LSTORE(st ^ 1);
        __syncthreads();
    }
    den += __shfl_xor(den, 16);
    den += __shfl_xor(den, 32);
    const float lower = __expf(-((const float*)(p.ws + O_FL))[bh * S + trow]);
    const float inv = 1.f / fmaxf(fabsf(den), lower);
    const bf16_t* Prow = (const bf16_t*)(p.ws + O_P) + (size_t)(b * S + trow) * NPS;
    float sum = 0.f;
#pragma unroll
    for (int dvt = 0; dvt < 16; ++dvt) {
        const int c = h * 256 + dvt * 16 + fq * 4;
        const uint2 op = *(const uint2*)(Prow + C_MO + c);
        o[dvt][0] *= inv * sigm(lo16(op.x)); o[dvt][1] *= inv * sigm(hi16(op.x)); o[dvt][2] *= inv * sigm(lo16(op.y)); o[dvt][3] *= inv * sigm(hi16(op.y));
        sum += o[dvt][0] + o[dvt][1] + o[dvt][2] + o[dvt][3];
    }
    sum += __shfl_xor(sum, 16);
    sum += __shfl_xor(sum, 32);
    const float mu = sum * (1.f / 256.f);
    float vs = 0.f;
#pragma unroll
    for (int dvt = 0; dvt < 16; ++dvt)
#pragma unroll
        for (int r = 0; r < 4; ++r) { const float d = o[dvt][r] - mu; vs += d * d; }
    vs += __shfl_xor(vs, 16);
    vs += __shfl_xor(vs, 32);
    const float rstd = rsqrtf(vs * (1.f / 256.f) + 1e-6f);
    const bf16_t* xcrow = (const bf16_t*)(p.ws + O_XC) + (size_t)(b * S + trow) * 1024;
    bf16_t* ymrow = (bf16_t*)(p.ws + O_YM) + (size_t)(b * S + trow) * 1024;
#pragma unroll
    for (int dv2 = 0; dv2 < 16; dv2 += 2) {
        uint2 ov[2];
#pragma unroll
        for (int q = 0; q < 2; ++q) {
            const int dvt = dv2 + q, c = h * 256 + dvt * 16 + fq * 4;
            const f32x4 ng = *(const f32x4*)(p.norm_g + c), sk = *(const f32x4*)(p.skip + c);
            const uint2 xc = *(const uint2*)(xcrow + c), mz = *(const uint2*)(Prow + C_MZ + c);
            const float y0 = ((o[dvt][0] - mu) * rstd * ng[0] + sk[0] * lo16(xc.x)) * silu(lo16(mz.x));
            const float y1 = ((o[dvt][1] - mu) * rstd * ng[1] + sk[1] * hi16(xc.x)) * silu(hi16(mz.x));
            const float y2 = ((o[dvt][2] - mu) * rstd * ng[2] + sk[2] * lo16(xc.y)) * silu(lo16(mz.y));
            const float y3 = ((o[dvt][3] - mu) * rstd * ng[3] + sk[3] * hi16(xc.y)) * silu(hi16(mz.y));
            ov[q].x = pk2(y0, y1); ov[q].y = pk2(y2, y3);
        }
        *(uint4*)(ymrow + h * 256 + (dv2 + (fq & 1)) * 16 + (fq >> 1) * 8) = pair16(ov[0], ov[1]);
    }
}


constexpr int CM_K = 16384, CM_VS = 272;
DEVI void cmp3_item(const Params& p, int item, char* lds) {
    const int thr_ = tidx();
    const int tile = item & 31, bg = item >> 5, b = bg >> 2, g = bg & 3;
    const int lane = thr_ & 63, wid = __builtin_amdgcn_readfirstlane(thr_ >> 6), fr = lane & 15, fq = lane >> 4;
    const int T0 = tile * 64, t0 = T0 + wid * 16, trow = t0 + fr, cur = tile;
    const float* KC = (const float*)(p.ws + O_KCF) + (size_t)bg * 127 * 64;
    const float* VC = (const float*)(p.ws + O_VCF) + (size_t)bg * 127 * 64;
    for (int i = 0; i < 32; ++i) {
        const int n = i * 4 + (thr_ >> 6), d = thr_ & 63;
        const float kv = n < 127 ? KC[n * 64 + d] : 0.f, vv = n < 127 ? VC[n * 64 + d] : 0.f;
        *(bf16_t*)(lds + (d >> 5) * 8192 + n * 64 + (d & 31) * 2) = f2bf(kv);
        *(bf16_t*)(lds + CM_K + d * CM_VS + n * 2) = f2bf(vv);
    }
    __syncthreads();
    const bf16_t* P = (const bf16_t*)(p.ws + O_P);
    const size_t tok = (size_t)b * S + trow;
    bf16x8 qf[4][2];
#pragma unroll
    for (int h = 0; h < 4; ++h) {
        const bf16_t* qp = P + tok * NPS + C_AQ + (g * 4 + h) * 64 + fq * 8;
        qf[h][0] = *(const bf16x8*)qp; qf[h][1] = *(const bf16x8*)(qp + 32);
    }
    const int nv = trow >= 31 ? ((trow - 31) >> 4) + 1 : 0;
    const int nvw = t0 + 15 >= 31 ? ((t0 + 15 - 31) >> 4) + 1 : 0;
    const int nchunk = (nvw + 31) >> 5;
    float m[4], l[4];
#pragma unroll
    for (int h = 0; h < 4; ++h) { m[h] = -1e30f; l[h] = 0.f; }
    for (int c = 0; c < nchunk; ++c) {
        bf16x8 kf[2][2];
#pragma unroll
        for (int stl = 0; stl < 2; ++stl)
#pragma unroll
            for (int ks = 0; ks < 2; ++ks) kf[stl][ks] = *(const bf16x8*)(lds + ks * 8192 + (c * 32 + stl * 16 + fr) * 64 + fq * 16);
        unsigned vm = 0;
#pragma unroll
        for (int e = 0; e < 8; ++e) { const int n = c * 32 + (e >> 2) * 16 + fq * 4 + (e & 3); if (n < nv) vm |= 1u << e; }
#pragma unroll
        for (int h = 0; h < 4; ++h) {
            f32x4 sa = {0.f, 0.f, 0.f, 0.f}, sb = {0.f, 0.f, 0.f, 0.f};
            sa = mma(kf[0][0], qf[h][0], sa); sa = mma(kf[0][1], qf[h][1], sa);
            sb = mma(kf[1][0], qf[h][0], sb); sb = mma(kf[1][1], qf[h][1], sb);
            float v[8];
#pragma unroll
            for (int r = 0; r < 4; ++r) { v[r] = sa[r] * 0.125f; v[4 + r] = sb[r] * 0.125f; }
            float mxv = -1e30f;
#pragma unroll
            for (int e = 0; e < 8; ++e) if ((vm >> e) & 1u) mxv = fmaxf(mxv, v[e]);
            mxv = fmaxf(mxv, __shfl_xor(mxv, 16));
            mxv = fmaxf(mxv, __shfl_xor(mxv, 32));
            const float mn = fmaxf(m[h], mxv);
            float ps = 0.f;
#pragma unroll
            for (int e = 0; e < 8; ++e) ps += ((vm >> e) & 1u) ? __expf(v[e] - mn) : 0.f;
            l[h] = l[h] * __expf(m[h] - mn) + ps;
            m[h] = mn;
        }
    }
    float linv[4];
#pragma unroll
    for (int h = 0; h < 4; ++h) {
        float lt = l[h];
        lt += __shfl_xor(lt, 16);
        lt += __shfl_xor(lt, 32);
        linv[h] = lt > 0.f ? 1.f / lt : 0.f;
    }
    f32x4 o[4][4];
#pragma unroll
    for (int h = 0; h < 4; ++h)
#pragma unroll
        for (int i = 0; i < 4; ++i) o[h][i] = (f32x4){0.f, 0.f, 0.f, 0.f};
    float own4[8], last[8];
#pragma unroll
    for (int k = 0; k < 8; ++k) { own4[k] = 0.f; last[k] = 0.f; }
#pragma unroll
    for (int c = 0; c < 4; ++c) {
        if (c < nchunk) {
            bf16x8 kf[2][2];
#pragma unroll
            for (int stl = 0; stl < 2; ++stl)
#pragma unroll
                for (int ks = 0; ks < 2; ++ks) kf[stl][ks] = *(const bf16x8*)(lds + ks * 8192 + (c * 32 + stl * 16 + fr) * 64 + fq * 16);
            bf16x8 vf[4];
#pragma unroll
            for (int dvt = 0; dvt < 4; ++dvt) {
                const char* vp = lds + CM_K + (dvt * 16 + fr) * CM_VS + c * 64 + fq * 8;
                vf[dvt] = join8(*(const uint2*)vp, *(const uint2*)(vp + 32));
            }
            unsigned vm = 0;
#pragma unroll
            for (int e = 0; e < 8; ++e) { const int n = c * 32 + (e >> 2) * 16 + fq * 4 + (e & 3); if (n < nv) vm |= 1u << e; }
#pragma unroll
            for (int h = 0; h < 4; ++h) {
                f32x4 sa = {0.f, 0.f, 0.f, 0.f}, sb = {0.f, 0.f, 0.f, 0.f};
                sa = mma(kf[0][0], qf[h][0], sa); sa = mma(kf[0][1], qf[h][1], sa);
                sb = mma(kf[1][0], qf[h][0], sb); sb = mma(kf[1][1], qf[h][1], sb);
                float v[8];
#pragma unroll
                for (int r = 0; r < 4; ++r) { v[r] = sa[r] * 0.125f; v[4 + r] = sb[r] * 0.125f; }
#pragma unroll
                for (int e = 0; e < 8; ++e) v[e] = ((vm >> e) & 1u) ? __expf(v[e] - m[h]) * linv[h] : 0.f;
                own4[2 * c] += (v[0] + v[1]) + (v[2] + v[3]); last[2 * c] += v[3];
                own4[2 * c + 1] += (v[4] + v[5]) + (v[6] + v[7]); last[2 * c + 1] += v[7];
                const bf16x8 pf = pack8(v);
#pragma unroll
                for (int dvt = 0; dvt < 4; ++dvt) o[h][dvt] = mma(vf[dvt], pf, o[h][dvt]);
            }
        }
    }
    bf16_t* OC = (bf16_t*)(p.ws + O_OC) + tok * 1024 + g * 256;
#pragma unroll
    for (int h = 0; h < 4; ++h)
#pragma unroll
        for (int dvt = 0; dvt < 4; dvt += 2) {
            uint2 x, y;
            x.x = pk2(o[h][dvt][0], o[h][dvt][1]); x.y = pk2(o[h][dvt][2], o[h][dvt][3]);
            y.x = pk2(o[h][dvt + 1][0], o[h][dvt + 1][1]); y.y = pk2(o[h][dvt + 1][2], o[h][dvt + 1][3]);
            *(uint4*)(OC + h * 64 + (dvt + (fq & 1)) * 16 + (fq >> 1) * 8) = pair16(x, y);
        }
    float sc[8];
    float prev = 0.f;
#pragma unroll
    for (int k = 0; k < 8; ++k) {
        const float rcv = __shfl(last[k], (lane + 48) & 63);
        const float carry = fq > 0 ? rcv : prev;
        prev = rcv;
        const int j = 4 * k + fq;
        const bool forced = j == 0 || j == cur || j == cur - 1;
        sc[k] = forced ? 1e30f : (j <= cur ? own4[k] + carry : -1e30f);
    }
    unsigned mask = 0u;
#pragma unroll 1
    for (int it = 0; it < 8; ++it) {
        float bv = sc[0];
        int bj = fq;
#pragma unroll
        for (int k = 1; k < 8; ++k) if (sc[k] > bv) { bv = sc[k]; bj = 4 * k + fq; }
#pragma unroll
        for (int off = 16; off <= 32; off <<= 1) {
            const float ov = __shfl_xor(bv, off);
            const int oj = __shfl_xor(bj, off);
            if (ov > bv || (ov == bv && oj < bj)) { bv = ov; bj = oj; }
        }
        mask |= 1u << bj;
#pragma unroll
        for (int k = 0; k < 8; ++k) if (4 * k + fq == bj) sc[k] = -4e30f;
    }
    if (fq == 0) ((unsigned*)(p.ws + O_SEL))[bg * S + trow] = mask & ((2u << cur) - 1u);
    __syncthreads();
}

constexpr int AT_K = 8192, AT_V = 9216, AT_STAGE = AT_K + AT_V;
template <bool SELB, int NH>
DEVI void nsa2_item(const Params& p, int tile, int bg, int h0, char* lds) {
    const int thr_ = tidx();
    const int b = bg >> 2, g = bg & 3;
    const int lane = thr_ & 63, wid = __builtin_amdgcn_readfirstlane(thr_ >> 6), fr = lane & 15, fq = lane >> 4;
    const int T0 = tile * 64, t0 = T0 + wid * 16, trow = t0 + fr, cur = tile;
    const bf16_t* P = (const bf16_t*)(p.ws + O_P);
    const size_t tok = (size_t)b * S + trow;
    bf16x8 qf[NH][2];
#pragma unroll
    for (int h = 0; h < NH; ++h) {
        const bf16_t* qp = P + tok * NPS + C_AQ + (g * 4 + h0 + h) * 64 + fq * 8;
        qf[h][0] = *(const bf16x8*)qp; qf[h][1] = *(const bf16x8*)(qp + 32);
    }
    unsigned rm = 0xffffffffu, wmask, gmask;
    if (SELB) {
        rm = ((const unsigned*)(p.ws + O_SEL))[bg * S + trow];
        unsigned un = rm;
        un |= __shfl_xor(un, 1); un |= __shfl_xor(un, 2); un |= __shfl_xor(un, 4); un |= __shfl_xor(un, 8);
        wmask = __builtin_amdgcn_readfirstlane(un) & ((2u << cur) - 1u);
        unsigned* lu = (unsigned*)(lds + 2 * AT_STAGE);
        if (lane == 0) lu[wid] = wmask;
        __syncthreads();
        gmask = lu[0] | lu[1] | lu[2] | lu[3];
        gmask = __builtin_amdgcn_readfirstlane(gmask);
    } else {
        const int lo = cur >= 8 ? cur - 8 : 0;
        gmask = ((2u << cur) - 1u) & ~((1u << lo) - 1u);
        const int wl = t0 - 511 > 0 ? (t0 - 511) >> 6 : 0;
        wmask = gmask & ~((1u << wl) - 1u);
    }
    const bf16_t* kg = P + (size_t)(b * S) * NPS + (SELB ? C_KS : C_KW) + g * 64;
    const bf16_t* vg = (const bf16_t*)(p.ws + (SELB ? O_VST : O_VWT)) + (size_t)(b * 256 + g * 64) * S;
    const int sc = thr_ & 7, sr = thr_ >> 3;
    uint4 rk0, rk1, rv0, rv1;
#define AT_GLOAD(jj)                                                                                   \
    {                                                                                                  \
        rk0 = *(const uint4*)(kg + (size_t)((jj) * 64 + sr) * NPS + sc * 8);                           \
        rk1 = *(const uint4*)(kg + (size_t)((jj) * 64 + sr + 32) * NPS + sc * 8);                      \
        rv0 = *(const uint4*)(vg + (size_t)(sr) * S + (jj) * 64 + sc * 8);                             \
        rv1 = *(const uint4*)(vg + (size_t)(sr + 32) * S + (jj) * 64 + sc * 8);                        \
    }
#define AT_LSTORE(stt)                                                                                 \
    {                                                                                                  \
        char* base_ = lds + (stt) * AT_STAGE;                                                          \
        *(uint4*)(base_ + (sc >> 2) * 4096 + (sr) * 64 + (sc & 3) * 16) = rk0;                         \
        *(uint4*)(base_ + (sc >> 2) * 4096 + (sr + 32) * 64 + (sc & 3) * 16) = rk1;                    \
        *(uint4*)(base_ + AT_K + (sr) * 144 + sc * 16) = rv0;                                          \
        *(uint4*)(base_ + AT_K + (sr + 32) * 144 + sc * 16) = rv1;                                     \
    }
    f32x4 o[NH][4];
    float m[NH], l[NH];
#pragma unroll
    for (int h = 0; h < NH; ++h) {
        m[h] = -1e30f; l[h] = 0.f;
#pragma unroll
        for (int i = 0; i < 4; ++i) o[h][i] = (f32x4){0.f, 0.f, 0.f, 0.f};
    }
    unsigned rem = gmask;
    int j = __ffs(rem) - 1;
    rem &= rem - 1;
    AT_GLOAD(j);
    AT_LSTORE(0);
    __syncthreads();
    int st = 0;
    while (true) {
        const int jn = rem ? __ffs(rem) - 1 : -1;
        rem &= rem - 1;
        if (jn >= 0) AT_GLOAD(jn);
        if ((wmask >> j) & 1u) {
            __builtin_amdgcn_s_setprio(1);
            const char* kb = lds + st * AT_STAGE;
            const char* vb = kb + AT_K;
            const bool rs = (rm >> j) & 1u;
#pragma unroll
            for (int c = 0; c < 2; ++c) {
                const int s0 = j * 64 + c * 32;
                bf16x8 kf[2][2];
#pragma unroll
                for (int stl = 0; stl < 2; ++stl)
#pragma unroll
                    for (int ks = 0; ks < 2; ++ks) kf[stl][ks] = *(const bf16x8*)(kb + ks * 4096 + (c * 32 + stl * 16 + fr) * 64 + fq * 16);
                bf16x8 vf[4];
#pragma unroll
                for (int dvt = 0; dvt < 4; ++dvt) {
                    const char* vp = vb + (dvt * 16 + fr) * 144 + c * 64 + fq * 8;
                    vf[dvt] = join8(*(const uint2*)vp, *(const uint2*)(vp + 32));
                }
                unsigned vm = 0;
#pragma unroll
                for (int e = 0; e < 8; ++e) {
                    const int s = s0 + (e >> 2) * 16 + fq * 4 + (e & 3);
                    if (rs && s <= trow && (SELB || s > trow - 512)) vm |= 1u << e;
                }
#pragma unroll
                for (int h = 0; h < NH; ++h) {
                    f32x4 sa = {0.f, 0.f, 0.f, 0.f}, sb = {0.f, 0.f, 0.f, 0.f};
                    sa = mma(kf[0][0], qf[h][0], sa); sa = mma(kf[0][1], qf[h][1], sa);
                    sb = mma(kf[1][0], qf[h][0], sb); sb = mma(kf[1][1], qf[h][1], sb);
                    constexpr float SC = 0.125f * 1.44269504f;
                    float v[8];
#pragma unroll
                    for (int r = 0; r < 4; ++r) { v[r] = sa[r]; v[4 + r] = sb[r]; }
                    float mxv = -1e30f;
#pragma unroll
                    for (int e = 0; e < 8; ++e) if ((vm >> e) & 1u) mxv = fmaxf(mxv, v[e]);
                    mxv = fmaxf(mxv, __shfl_xor(mxv, 16));
                    mxv = fmaxf(mxv, __shfl_xor(mxv, 32));
                    const float mn = fmaxf(m[h], mxv);
                    const float alpha = __builtin_amdgcn_exp2f((m[h] - mn) * SC);
                    m[h] = mn;
                    const float mb = -mn * SC;
                    float ps = 0.f;
#pragma unroll
                    for (int e = 0; e < 8; ++e) { v[e] = ((vm >> e) & 1u) ? __builtin_amdgcn_exp2f(fmaf(v[e], SC, mb)) : 0.f; ps += v[e]; }
                    l[h] = l[h] * alpha + ps;
                    const bf16x8 pf = pack8(v);
#pragma unroll
                    for (int dvt = 0; dvt < 4; ++dvt) { o[h][dvt] *= alpha; o[h][dvt] = mma(vf[dvt], pf, o[h][dvt]); }
                }
            }
            __builtin_amdgcn_s_setprio(0);
        }
        if (jn < 0) break;
        AT_LSTORE(st ^ 1);
        __syncthreads();
        st ^= 1;
        j = jn;
    }
    __syncthreads();
#pragma unroll
    for (int h = 0; h < NH; ++h) {
        const int hd = g * 4 + h0 + h;
        float lt = l[h];
        lt += __shfl_xor(lt, 16);
        lt += __shfl_xor(lt, 32);
        const float inv = 1.f / lt;
        if (!SELB) {
            bf16_t* OW = (bf16_t*)(p.ws + O_OW) + tok * 1024 + hd * 64;
#pragma unroll
            for (int dvt = 0; dvt < 4; dvt += 2) {
                uint2 x, y;
                x.x = pk2(o[h][dvt][0] * inv, o[h][dvt][1] * inv); x.y = pk2(o[h][dvt][2] * inv, o[h][dvt][3] * inv);
                y.x = pk2(o[h][dvt + 1][0] * inv, o[h][dvt + 1][1] * inv); y.y = pk2(o[h][dvt + 1][2] * inv, o[h][dvt + 1][3] * inv);
                *(uint4*)(OW + (dvt + (fq & 1)) * 16 + (fq >> 1) * 8) = pair16(x, y);
            }
        } else {
            const float* G = (const float*)(p.ws + O_G) + tok * 64 + 8 + hd * 3;
            const float g0 = sigm(G[0]), g1 = sigm(G[1]) * inv, g2 = sigm(G[2]);
            const bf16_t* OC = (const bf16_t*)(p.ws + O_OC) + tok * 1024 + hd * 64 + fq * 4;
            const bf16_t* OW = (const bf16_t*)(p.ws + O_OW) + tok * 1024 + hd * 64 + fq * 4;
            const bf16_t* AZ = P + tok * NPS + C_AZ + hd * 64 + fq * 4;
            bf16_t* YA = (bf16_t*)(p.ws + O_YA) + tok * 1024 + hd * 64 + fq * 4;
#pragma unroll
            for (int dv2 = 0; dv2 < 4; dv2 += 2) {
                uint2 ov[2];
#pragma unroll
                for (int q = 0; q < 2; ++q) {
                    const int dvt = dv2 + q;
                    const uint2 oc = *(const uint2*)(OC + dvt * 16), ow = *(const uint2*)(OW + dvt * 16), az = *(const uint2*)(AZ + dvt * 16);
                    const float y0 = (g0 * lo16(oc.x) + g1 * o[h][dvt][0] + g2 * lo16(ow.x)) * silu(lo16(az.x));
                    const float y1 = (g0 * hi16(oc.x) + g1 * o[h][dvt][1] + g2 * hi16(ow.x)) * silu(hi16(az.x));
                    const float y2 = (g0 * lo16(oc.y) + g1 * o[h][dvt][2] + g2 * lo16(ow.y)) * silu(lo16(az.y));
                    const float y3 = (g0 * hi16(oc.y) + g1 * o[h][dvt][3] + g2 * hi16(ow.y)) * silu(hi16(az.y));
                    ov[q].x = pk2(y0, y1); ov[q].y = pk2(y2, y3);
                }
                *(uint4*)(YA - fq * 4 + (dv2 + (fq & 1)) * 16 + (fq >> 1) * 8) = pair16(ov[0], ov[1]);
            }
        }
    }
}

DEVI void up_tile(const Params& p, int item, char* lds) {
    const int nt = item >> 5, mt = item & 31, m0 = mt * 256, n0 = nt * 64;
    const int tid = tidx(), lane = tid & 63, wid = tid >> 6, wr = wid >> 1, wc = wid & 1, fr = lane & 15, fq = lane >> 4;
    const bf16_t* P = (const bf16_t*)(p.ws + O_P);
    f32x4 acc[8][2], acc2[8][2];
#pragma unroll
    for (int i = 0; i < 8; ++i) { acc[i][0] = acc[i][1] = acc2[i][0] = acc2[i][1] = (f32x4){0.f, 0.f, 0.f, 0.f}; }
    gemm3_main<false, 2>(acc, lds, (const bf16_t*)(p.ws + O_YM), 1024, (const bf16_t*)(p.ws + O_WUM), 1024, 2047, m0, n0, 1024);
    gemm3_main<false, 2>(acc2, lds, (const bf16_t*)(p.ws + O_YA), 1024, (const bf16_t*)(p.ws + O_WUA), 1024, 2047, m0, n0, 1024);
    bf16_t* MG = (bf16_t*)(p.ws + O_MG);
#pragma unroll
    for (int mi = 0; mi < 8; ++mi) {
        const int row = m0 + wr * 128 + mi * 16 + fr;
        uint2 ov[2];
        const int pc = n0 + wc * 32 + (fq & 1) * 16 + (fq >> 1) * 8;
        const uint4 gm16 = *(const uint4*)(P + (size_t)row * NPS + C_GM + pc), ga16 = *(const uint4*)(P + (size_t)row * NPS + C_GA + pc);
        uint2 ta, tb;
        ta.x = gm16.x; ta.y = gm16.y; tb.x = gm16.z; tb.y = gm16.w;
        const uint4 gmu = pair16(ta, tb);
        ta.x = ga16.x; ta.y = ga16.y; tb.x = ga16.z; tb.y = ga16.w;
        const uint4 gau = pair16(ta, tb);
#pragma unroll
        for (int ni = 0; ni < 2; ++ni) {
            uint2 gm, ga;
            gm.x = ni ? gmu.z : gmu.x; gm.y = ni ? gmu.w : gmu.y; ga.x = ni ? gau.z : gau.x; ga.y = ni ? gau.w : gau.y;
            const float y0 = acc[mi][ni][0] * sigm(lo16(gm.x)) + acc2[mi][ni][0] * sigm(lo16(ga.x)), y1 = acc[mi][ni][1] * sigm(hi16(gm.x)) + acc2[mi][ni][1] * sigm(hi16(ga.x));
            const float y2 = acc[mi][ni][2] * sigm(lo16(gm.y)) + acc2[mi][ni][2] * sigm(lo16(ga.y)), y3 = acc[mi][ni][3] * sigm(hi16(gm.y)) + acc2[mi][ni][3] * sigm(hi16(ga.y));
            ov[ni].x = pk2(y0, y1); ov[ni].y = pk2(y2, y3);
        }
        *(uint4*)(MG + (size_t)row * DM + n0 + wc * 32 + (fq & 1) * 16 + (fq >> 1) * 8) = pair16(ov[0], ov[1]);
    }
}
DEVI void out_tile(const Params& p, int item, char* lds) {
    const int nt = item >> 5, mt = item & 31, m0 = mt * 256, n0 = nt * 128;
    const int tid = tidx(), lane = tid & 63, wid = tid >> 6, wr = wid >> 1, wc = wid & 1, fr = lane & 15, fq = lane >> 4;
    f32x4 acc[8][4];
    zero_acc2(acc);
    gemm3_main<false, 4>(acc, lds, (const bf16_t*)(p.ws + O_MG), DM, (const bf16_t*)(p.ws + O_WOUT), DM, 2047, m0, n0, DM);
    bf16_t* O = (bf16_t*)(p.ws + O_OUT);
#pragma unroll
    for (int mi = 0; mi < 8; ++mi)
#pragma unroll
        for (int ni = 0; ni < 4; ni += 2) {
            const int row = m0 + wr * 128 + mi * 16 + fr, col = n0 + wc * 64 + (ni + (fq & 1)) * 16 + (fq >> 1) * 8;
            uint2 x, y;
            x.x = pk2(acc[mi][ni][0], acc[mi][ni][1]); x.y = pk2(acc[mi][ni][2], acc[mi][ni][3]);
            y.x = pk2(acc[mi][ni + 1][0], acc[mi][ni + 1][1]); y.y = pk2(acc[mi][ni + 1][2], acc[mi][ni + 1][3]);
            *(uint4*)(O + (size_t)row * DM + col) = pair16(x, y);
        }
}
DEVI void final_rows(const Params& p, int item) {
    const int thr_ = tidx();
    const int lane = thr_ & 63, wid = thr_ >> 6;
    const int row = item * 4 + wid;
    const bf16_t* orow = (const bf16_t*)(p.ws + O_OUT) + (size_t)row * DM;
    const float* xr = p.x + (size_t)row * DM;
    f32x4 v[8];
    float ss = 0.f;
#pragma unroll
    for (int i = 0; i < 8; ++i) { const uint2 u = *(const uint2*)(orow + i * 256 + lane * 4); v[i] = (f32x4){lo16(u.x), hi16(u.x), lo16(u.y), hi16(u.y)}; ss += v[i][0] * v[i][0] + v[i][1] * v[i][1] + v[i][2] * v[i][2] + v[i][3] * v[i][3]; }
    ss = wave_sum(ss);
    const float rs = rsqrtf(ss * (1.f / DM) + 1e-6f);
    float* dr = p.out + (size_t)row * DM;
#pragma unroll
    for (int i = 0; i < 8; ++i) {
        const f32x4 g = *(const f32x4*)(p.post_g + i * 256 + lane * 4);
        const f32x4 xv = *(const f32x4*)(xr + i * 256 + lane * 4);
#if DBG == 0
        *(f32x4*)(dr + i * 256 + lane * 4) = xv + v[i] * rs * g;
#elif DBG == 1
        *(f32x4*)(dr + i * 256 + lane * 4) = xv;
#elif DBG == 9
        {
            const int cc = (i * 256 + lane * 4) & 1023;
            const uint2 u0 = *(const uint2*)((const bf16_t*)(p.ws + O_XC) + (size_t)row * 1024 + cc);
            const uint2 u1 = *(const uint2*)((const bf16_t*)(p.ws + O_QM) + (size_t)row * 1024 + cc);
            const uint2 u2 = *(const uint2*)((const bf16_t*)(p.ws + O_KM) + (size_t)row * 1024 + cc);
            const uint2 u3 = *(const uint2*)((const bf16_t*)(p.ws + O_VMT) + (size_t)row * 1024 + cc);
            const int fi = (row & 15) * 2048 + i * 256 + lane * 4;
            const f32x4 f0 = *(const f32x4*)((const float*)(p.ws + O_FA) + fi), f1 = *(const f32x4*)((const float*)(p.ws + O_FM) + fi), f2 = *(const f32x4*)((const float*)(p.ws + O_FL) + fi);
            f32x4 d = {lo16(u0.x) + lo16(u1.x) + lo16(u2.x) + lo16(u3.x), hi16(u0.x) + hi16(u1.x) + hi16(u2.x) + hi16(u3.x), lo16(u0.y) + lo16(u1.y) + lo16(u2.y) + lo16(u3.y), hi16(u0.y) + hi16(u1.y) + hi16(u2.y) + hi16(u3.y)};
            #if PSEL == 0
            d = (f32x4){lo16(u3.x), hi16(u3.x), lo16(u3.y), hi16(u3.y)};
            *(f32x4*)(dr + i * 256 + lane * 4) = xv + d;
#elif PSEL == 1
            d = (f32x4){lo16(u0.x), hi16(u0.x), lo16(u0.y), hi16(u0.y)};
            *(f32x4*)(dr + i * 256 + lane * 4) = xv + d;
#elif PSEL == 2
            *(f32x4*)(dr + i * 256 + lane * 4) = xv + f0 + f1 + f2;
#else
            *(f32x4*)(dr + i * 256 + lane * 4) = xv + d + f0 + f1 + f2;
#endif
        }
#else
        {
            const bf16_t* src = DBG == 2 ? (const bf16_t*)(p.ws + O_MG) + (size_t)row * DM : DBG == 3 ? (const bf16_t*)(p.ws + O_P) + (size_t)row * NPS + 2048
                              : DBG == 4 ? (const bf16_t*)(p.ws + O_YM) + (size_t)row * 1024 : DBG == 5 ? (const bf16_t*)(p.ws + O_YA) + (size_t)row * 1024
                              : DBG == 6 ? (const bf16_t*)(p.ws + O_P) + (size_t)row * NPS + 4096 : (const bf16_t*)(p.ws + O_P) + (size_t)row * NPS + 7680;
            const int cc = (i * 256 + lane * 4) & ((DBG == 4 || DBG == 5) ? 1023 : 2047);
            const uint2 u = *(const uint2*)(src + cc);
            f32x4 d = {lo16(u.x), hi16(u.x), lo16(u.y), hi16(u.y)};
            *(f32x4*)(dr + i * 256 + lane * 4) = xv + d;
        }
#endif
    }
}


__global__ void __launch_bounds__(256, 2) fwd_megakernel(Params p) {
    extern __shared__ __attribute__((aligned(16))) char lds[];
    const int G = gridDim.x, bid = blockIdx.x;
    if (threadIdx.x == 0) *(uint4*)(lds + LDS_MAIN) = make_uint4(0u, 0u, 0u, 0u);
    __syncthreads();
    XcdBarrier xb = xcd_barrier_post((unsigned*)(p.ws + O_BAR), (volatile LAS unsigned*)(lds + LDS_MAIN));
    if (p.ws == nullptr) cg::this_grid().sync();
    for (int rep = 0; rep < NREP(0); ++rep)
    for (int it = bid; it < 2048 + N_TTILES + 32; it += G) {
        if (it < N_TTILES) transpose_item(p, it, lds);
        else if (it < N_TTILES + 2048) rmsnorm_rows(p, it - N_TTILES);
        else bias_item(p, it - N_TTILES - 2048);
    }
    xcd_barrier(xb);
    for (int rep = 0; rep < NREP(1); ++rep)
    for (int it = bid; it < 32 * 93; it += G) inproj_tile(p, it, lds);
    if (G >= 128 && bid >= G - 64) {
        if (threadIdx.x == 0) {
            unsigned* cnt = (unsigned*)(p.ws + O_BAR);
            XB_SPIN(xb_ld(cnt) < 128u * NREP(1), cnt);
            __builtin_amdgcn_fence(__ATOMIC_ACQUIRE, "agent");
            asm volatile("s_waitcnt vmcnt(0)" ::: "memory");
        }
        __syncthreads();
        __builtin_amdgcn_fence(__ATOMIC_ACQUIRE, "agent");
        cmp1_tile(p, bid - (G - 64), lds);
    } else if (G < 128) {
        xcd_barrier(xb);
        for (int it = bid; it < 64; it += G) cmp1_tile(p, it, lds);
    }
    xcd_barrier(xb);
    for (int rep = 0; rep < NREP(2); ++rep)
    for (int it = bid; it < 16 + 4096; it += G) {
        if (it < 16) scan_item(p, it, lds);
        else conv_item(p, it - 16);
    }
    xcd_barrier(xb);
    for (int rep = 0; rep < NREP(3); ++rep)
    for (int it = bid; it < 1024 + 32; it += G) {
        if (it < 32) cmp2_tile(p, it, lds);
        else qk_tile(p, it - 32, lds);
    }
    xcd_barrier(xb);
    for (int rep = 0; rep < NREP(4); ++rep) {
        for (int r2 = 0; r2 < NREP(8); ++r2)
        for (int it = bid; it < 512; it += G) mlstm2_item(p, it, lds);
        for (int r2 = 0; r2 < NREP(9); ++r2)
        if (bid >= (G >> 1)) for (int it = bid - (G >> 1); it < 512; it += G - (G >> 1)) cmp3_item(p, it, lds);
        for (int r2 = 0; r2 < NREP(10); ++r2)
        for (int it = bid; it < 512; it += G) nsa2_item<false, 4>(p, it & 31, it >> 5, 0, lds);
    }
    xcd_barrier(xb);
    for (int rep = 0; rep < NREP(5); ++rep)
    for (int it = bid; it < 1024; it += G) {
        const int idx = it & 511, hp = it >> 9;
        nsa2_item<true, 2>(p, hp ? (idx >> 4) : 31 - (idx >> 4), idx & 15, hp * 2, lds);
    }
    xcd_barrier(xb);
    for (int rep = 0; rep < NREP(6); ++rep)
    for (int it = bid; it < 1024; it += G) up_tile(p, it, lds);
    xcd_barrier(xb);
    for (int rep = 0; rep < NREP(7); ++rep)
    for (int it = bid; it < 512; it += G) out_tile(p, it, lds);
    xcd_barrier(xb);
    for (int rep = 0; rep < NREP(11); ++rep)
    for (int it = bid; it < 2048; it += G) final_rows(p, it);
}

extern "C" void kernel_launch(void* const* d_in, const int* in_sizes, int n_in, void* d_out, int out_size, void* d_ws, size_t ws_size,
                              hipStream_t stream) {
    static int grid_blocks = 0;
    if (!grid_blocks) {
        int dev = 0, cus = 0, per_cu = 0;
        hipGetDevice(&dev);
        hipDeviceGetAttribute(&cus, hipDeviceAttributeMultiprocessorCount, dev);
        hipFuncSetAttribute((const void*)fwd_megakernel, hipFuncAttributeMaxDynamicSharedMemorySize, LDS_BYTES);
        hipOccupancyMaxActiveBlocksPerMultiprocessor(&per_cu, fwd_megakernel, 256, LDS_BYTES);
        if (per_cu < 1) per_cu = 1;
        if (per_cu > 2) per_cu = 2;
        grid_blocks = cus * per_cu;
    }
    if (ws_size < O_END2) { fprintf(stderr, "workspace too small: %zu < %zu\n", ws_size, (size_t)O_END); return; }
    Params p{};
    const float** f = (const float**)&p;
    for (int i = 0; i < 21; ++i) f[i] = (const float*)d_in[i];
    p.out = (float*)d_out;
    p.ws = (char*)d_ws;
    hipMemsetAsync((char*)d_ws + O_BAR, 0, XCD_BAR_WORDS * 4, stream);
    void* args[] = {&p};
    hipError_t e = hipLaunchCooperativeKernel((void*)fwd_megakernel, dim3(grid_blocks), dim3(256), args, LDS_BYTES, stream);
    if (e != hipSuccess) fprintf(stderr, "cooperative launch failed: %s (grid %d)\n", hipGetErrorString(e), grid_blocks);
}
```

```cpp
#include <hip/hip_runtime.h>
#include <hip/hip_cooperative_groups.h>
#include <stdint.h>
#include <cstdio>
namespace cg = cooperative_groups;

typedef unsigned short bf16_t;
typedef short bf16x8 __attribute__((ext_vector_type(8)));
typedef float f32x4 __attribute__((ext_vector_type(4)));
#define DEVI __device__ __forceinline__

constexpr int T = 8192, S = 2048, DM = 2048;
constexpr int NP = 11904, NPS = 11776, DIN = 11832;
constexpr int C_MX = 0, C_MV = 1024, C_MO = 2048, C_MZ = 3072, C_AQ = 4096, C_KC = 5120, C_VC = 5376, C_KS = 5632,
              C_VS = 5888, C_KW = 6144, C_VW = 6400, C_AZ = 6656, C_GM = 7680, C_GA = 9728, C_GATE = 11776;
constexpr size_t O_R0 = 0;
constexpr size_t O_R1 = O_R0 + 33554432;
constexpr size_t O_P = O_R1 + 50331648;
constexpr size_t O_WUM = O_P + 192937984;
constexpr size_t O_WUA = O_WUM + 4194304;
constexpr size_t O_WOUT = O_WUA + 4194304;
constexpr size_t O_WQ = O_WOUT + 8388608;
constexpr size_t O_WK = O_WQ + 524288;
constexpr size_t O_W1K = O_WK + 524288;
constexpr size_t O_W1V = O_W1K + 1048576;
constexpr size_t O_W2K = O_W1V + 1048576;
constexpr size_t O_W2V = O_W2K + 32768;
constexpr size_t O_G = O_W2V + 32768;
constexpr size_t O_VMT = O_G + 2097152;
constexpr size_t O_VST = O_VMT + 16777216;
constexpr size_t O_VWT = O_VST + 4194304;
constexpr size_t O_HC = O_VWT + 4194304;
constexpr size_t O_KCF = O_HC + 2097152;
constexpr size_t O_VCF = O_KCF + 524288;
constexpr size_t O_B1P = O_VCF + 524288;
constexpr size_t O_FA = O_B1P + 32768;
constexpr size_t O_FM = O_FA + 131072;
constexpr size_t O_FL = O_FM + 131072;
constexpr size_t O_SEL = O_FL + 131072;
constexpr size_t O_YM = O_SEL + 131072;
constexpr size_t O_END = O_YM + 16777216;
constexpr size_t O_XC = O_R1, O_QM = O_R1 + 16777216, O_KM = O_R1 + 2 * 16777216, O_YA = O_QM;
constexpr size_t O_OC = O_R0, O_OW = O_R0 + 16777216, O_MG = O_R0, O_H = O_R0, O_WINT = O_R1, O_OUT = O_P;

constexpr int LDS_MAIN = 73728;
constexpr int LDS_BYTES = LDS_MAIN + 64;
constexpr size_t O_BAR = O_END;
constexpr size_t O_END2 = O_BAR + 16384;
#ifndef DBG
#define DBG 0
#endif
#ifndef REPM
#define REPM 0
#endif
#define NREP(k) (((REPM >> (k)) & 1) ? 2 : 1)
#ifndef DSTOP
#define DSTOP 9
#endif
#ifndef PSEL
#define PSEL 0
#endif

struct Params {
    const float *x, *pre_g, *w_in, *conv_w, *conv_b, *w_q, *w_k, *b_i, *b_f, *norm_g, *skip, *pe_k, *w1_k, *w2_k, *pe_v, *w1_v,
        *w2_v, *w_up_m, *w_up_a, *w_out, *post_g;
    float* out;
    char* ws;
};

DEVI int tidx() { int t = threadIdx.x; asm volatile("" : "+v"(t)); return t; }
DEVI float bf2f(bf16_t b) { return __uint_as_float(((unsigned)b) << 16); }
typedef __bf16 bf16v2_t __attribute__((ext_vector_type(2)));
typedef float f32v2_t __attribute__((ext_vector_type(2)));
DEVI unsigned pk2(float lo, float hi) {
    f32v2_t v = {lo, hi};
    bf16v2_t b = __builtin_convertvector(v, bf16v2_t);
    return __builtin_bit_cast(unsigned, b);
}
DEVI bf16_t f2bf(float f) { return (bf16_t)(pk2(f, 0.f) & 0xffffu); }
DEVI float lo16(unsigned u) { return __uint_as_float(u << 16); }
DEVI float hi16(unsigned u) { return __uint_as_float(u & 0xffff0000u); }
DEVI float sigm(float x) { return 1.f / (1.f + __expf(-x)); }
DEVI float silu(float x) { return x / (1.f + __expf(-x)); }
DEVI f32x4 mma(bf16x8 a, bf16x8 b, f32x4 c) { return __builtin_amdgcn_mfma_f32_16x16x32_bf16(a, b, c, 0, 0, 0); }
DEVI float rdlane(float v, int l) { return __uint_as_float(__builtin_amdgcn_readlane(__float_as_uint(v), l)); }
DEVI uint4 pair16(uint2 x, uint2 y) {
    const auto r0 = __builtin_amdgcn_permlane16_swap(x.x, y.x, false, false);
    const auto r1 = __builtin_amdgcn_permlane16_swap(x.y, y.y, false, false);
    return make_uint4(r0[0], r1[0], r0[1], r1[1]);
}
typedef unsigned u32x4_t __attribute__((ext_vector_type(4)));
DEVI void store_nt16(void* ptr, uint4 v) { u32x4_t x = {v.x, v.y, v.z, v.w}; __builtin_nontemporal_store(x, (u32x4_t*)ptr); }
DEVI float wave_max(float v) {
#pragma unroll
    for (int o = 32; o > 0; o >>= 1) v = fmaxf(v, __shfl_xor(v, o));
    return v;
}
DEVI float wave_sum(float v) {
#pragma unroll
    for (int o = 32; o > 0; o >>= 1) v += __shfl_xor(v, o);
    return v;
}
DEVI bf16x8 pack8(const float* v) {
    union { unsigned u[4]; bf16x8 b; } x;
    x.u[0] = pk2(v[0], v[1]); x.u[1] = pk2(v[2], v[3]); x.u[2] = pk2(v[4], v[5]); x.u[3] = pk2(v[6], v[7]);
    return x.b;
}
DEVI bf16x8 join8(uint2 a, uint2 b) {
    union { unsigned u[4]; bf16x8 v; } x;
    x.u[0] = a.x; x.u[1] = a.y; x.u[2] = b.x; x.u[3] = b.y;
    return x.v;
}

#define XB_TMO      128
#define XB_XCNT(j)  (256  + 64 * (j))
#define XB_XSUB(j)  (1280 + 64 * (j))
#define XB_XGEN(j)  (2304 + 64 * (j))
#define XB_TOP      3328
#define XB_TOPGEN   3392
#define XCD_BAR_WORDS 3456
#define XB_SPIN_CAP (1u << 18)
#define LAS __attribute__((address_space(3)))
DEVI unsigned xb_ld(unsigned* p) { return __hip_atomic_load(p, __ATOMIC_RELAXED, __HIP_MEMORY_SCOPE_AGENT); }
DEVI unsigned xb_add(unsigned* p, unsigned v) { return __hip_atomic_fetch_add(p, v, __ATOMIC_RELAXED, __HIP_MEMORY_SCOPE_AGENT); }
DEVI unsigned xb_xcc_id() { return (unsigned)__builtin_amdgcn_s_getreg((3 << 11) | 20) & 0xFu; }
#define XB_SPIN(cond, bar) do { unsigned _sp = 0; while (cond) { __builtin_amdgcn_s_sleep(1); \
    if ((++_sp & 255u) == 0u) { if (xb_ld(&(bar)[XB_TMO])) break; if (_sp > XB_SPIN_CAP) { atomicAdd(&(bar)[XB_TMO], 1u); break; } } } } while (0)
struct XcdBarrier { unsigned* bar; unsigned x; volatile LAS unsigned* st; };
DEVI XcdBarrier xcd_barrier_post(unsigned* bar, volatile LAS unsigned* st) {
    XcdBarrier b; b.bar = bar; b.x = xb_xcc_id(); b.st = st;
    if (threadIdx.x == 0) (void)xb_add(&bar[XB_XCNT(b.x)], 1u);
    return b;
}
DEVI void xcd_barrier_complete(unsigned* bar, unsigned x, unsigned& nloc, unsigned& nx) {
    const unsigned G = gridDim.x * gridDim.y * gridDim.z;
    unsigned sum, cnt, mine, sp = 0u;
    for (;;) {
        sum = 0u; cnt = 0u; mine = 0u;
#pragma unroll
        for (unsigned j = 0; j < 16; ++j) { const unsigned c = xb_ld(&bar[XB_XCNT(j)]); sum += c; cnt += (c > 0u) ? 1u : 0u; mine = (j == x) ? c : mine; }
        if (sum == G) break;
        __builtin_amdgcn_s_sleep(1);
        if ((++sp & 255u) == 0u) { if (xb_ld(&bar[XB_TMO])) break; if (sp > XB_SPIN_CAP) { atomicAdd(&bar[XB_TMO], 1u); break; } }
    }
    nloc = mine > 0u ? mine : 1u; nx = cnt > 0u ? cnt : 1u;
}
DEVI void xcd_barrier(const XcdBarrier& b) {
    asm volatile("s_waitcnt vmcnt(0)" ::: "memory");
    __syncthreads();
    if (threadIdx.x == 0) {
        unsigned* bar = b.bar;
        __builtin_amdgcn_s_waitcnt(0);
        unsigned nloc = b.st[0], nx = b.st[1];
        if (nloc == 0u) { xcd_barrier_complete(bar, b.x, nloc, nx); b.st[0] = nloc; b.st[1] = nx; }
        const unsigned old = xb_add(&bar[XB_XSUB(b.x)], 1u);
        const unsigned gen = old / nloc;
        if (old + 1u == (gen + 1u) * nloc) {
            __builtin_amdgcn_fence(__ATOMIC_RELEASE, "agent");
            asm volatile("s_waitcnt vmcnt(0)" ::: "memory");
            const unsigned og = xb_add(&bar[XB_TOP], 1u);
            const unsigned tg = og / nx;
            if (og + 1u == (tg + 1u) * nx) xb_add(&bar[XB_TOPGEN], 1u);
            else XB_SPIN(xb_ld(&bar[XB_TOPGEN]) == tg, bar);
            __builtin_amdgcn_fence(__ATOMIC_ACQUIRE, "agent");
            xb_add(&bar[XB_XGEN(b.x)], 1u);
            asm volatile("s_waitcnt vmcnt(0)" ::: "memory");
        } else {
            XB_SPIN(xb_ld(&bar[XB_XGEN(b.x)]) == gen, bar);
            __builtin_amdgcn_fence(__ATOMIC_ACQUIRE, "agent");
            asm volatile("s_waitcnt vmcnt(0)" ::: "memory");
        }
    }
    __syncthreads();
}
template <bool TR, int NI, class RB>
DEVI void gemm_main(f32x4 (&acc)[4][NI], char* lds, RB rowbase, size_t hi, const bf16_t* Bt, int ldb, int nBmax, int m0, int n0, int K) {
    const int tid = tidx(), lane = tid & 63, wid = tid >> 6, wr = wid >> 1, wc = wid & 1, fr = lane & 15, fq = lane >> 4;
    const int c = tid & 7, r0 = tid >> 3;
    const bf16_t* ab[4];
    const bf16_t* bb[NI];
#pragma unroll
    for (int i = 0; i < 4; ++i) ab[i] = rowbase(m0 + r0 + i * 32) + c * 8;
#pragma unroll
    for (int i = 0; i < NI; ++i) {
        int nr = n0 + r0 + i * 32;
        if (nr > nBmax) nr = nBmax;
        bb[i] = Bt + (size_t)nr * ldb + c * 8;
    }
    uint4 ra[4], rb[NI];
    const int nk = K >> 6;
    const int lw = (c >> 2) * 8192 + r0 * 64 + (c & 3) * 16;
#pragma unroll
    for (int i = 0; i < 4; ++i) ra[i] = *(const uint4*)(ab[i]);
#pragma unroll
    for (int i = 0; i < NI; ++i) rb[i] = *(const uint4*)(bb[i]);
#pragma unroll
    for (int i = 0; i < 4; ++i) *(uint4*)(lds + lw + i * 2048) = ra[i];
#pragma unroll
    for (int i = 0; i < NI; ++i) *(uint4*)(lds + 16384 + lw + i * 2048) = rb[i];
    __syncthreads();
    for (int kt = 0; kt < nk; ++kt) {
        const int buf = kt & 1;
        if (kt + 1 < nk) {
            const size_t ao = (size_t)(kt + 1) * hi;
            const int bo = (kt + 1) * 64;
#pragma unroll
            for (int i = 0; i < 4; ++i) ra[i] = *(const uint4*)(ab[i] + ao);
#pragma unroll
            for (int i = 0; i < NI; ++i) rb[i] = *(const uint4*)(bb[i] + bo);
        }
        const char* la = lds + buf * 32768;
        const char* lb = la + 16384;
#pragma unroll
        for (int kp = 0; kp < 2; ++kp) {
            bf16x8 af[4], bf[NI];
#pragma unroll
            for (int i = 0; i < 4; ++i) af[i] = *(const bf16x8*)(la + kp * 8192 + (wr * 64 + i * 16 + fr) * 64 + fq * 16);
#pragma unroll
            for (int i = 0; i < NI; ++i) bf[i] = *(const bf16x8*)(lb + kp * 8192 + (wc * NI * 16 + i * 16 + fr) * 64 + fq * 16);
#pragma unroll
            for (int mi = 0; mi < 4; ++mi)
#pragma unroll
                for (int ni = 0; ni < NI; ++ni) acc[mi][ni] = TR ? mma(af[mi], bf[ni], acc[mi][ni]) : mma(bf[ni], af[mi], acc[mi][ni]);
        }
        if (kt + 1 < nk) {
            char* lwp = lds + (buf ^ 1) * 32768 + lw;
#pragma unroll
            for (int i = 0; i < 4; ++i) *(uint4*)(lwp + i * 2048) = ra[i];
#pragma unroll
            for (int i = 0; i < NI; ++i) *(uint4*)(lwp + 16384 + i * 2048) = rb[i];
        }
        __syncthreads();
    }
}
template <int NI>
DEVI void zero_acc(f32x4 (&acc)[4][NI]) {
#pragma unroll
    for (int i = 0; i < 4; ++i)
#pragma unroll
        for (int j = 0; j < NI; ++j) acc[i][j] = (f32x4){0.f, 0.f, 0.f, 0.f};
}
struct RowLin {
    const bf16_t* A; size_t lda;
    DEVI const bf16_t* operator()(int r) const { return A + (size_t)r * lda; }
};


template <bool TR>
DEVI void gemm2_main(f32x4 (&acc)[8][4], char* lds, const bf16_t* A, size_t lda, const bf16_t* Bt, int ldb, int nBmax, int m0, int n0, int K) {
    const int tid = tidx(), lane = tid & 63, wid = tid >> 6, wr = wid >> 1, wc = wid & 1, fr = lane & 15, fq = lane >> 4;
    const int c = tid & 3, r0 = tid >> 2;
    const bf16_t* ap = A + (size_t)(m0 + r0) * lda + c * 8;
    const bf16_t* bp0; const bf16_t* bp1;
    { int nr = n0 + r0; if (nr > nBmax) nr = nBmax; bp0 = Bt + (size_t)nr * ldb + c * 8; nr = n0 + r0 + 64; if (nr > nBmax) nr = nBmax; bp1 = Bt + (size_t)nr * ldb + c * 8; }
    const size_t a64 = (size_t)64 * lda;
    uint4 ra0, ra1, ra2, ra3, rb0, rb1;
    const int nk = K >> 5;
    const int lw = r0 * 64 + c * 16;
#define G2_LOAD(ko)                                                                                       \
    { ra0 = *(const uint4*)(ap + (ko)); ra1 = *(const uint4*)(ap + a64 + (ko)); ra2 = *(const uint4*)(ap + 2 * a64 + (ko)); \
      ra3 = *(const uint4*)(ap + 3 * a64 + (ko)); rb0 = *(const uint4*)(bp0 + (ko)); rb1 = *(const uint4*)(bp1 + (ko)); }
#define G2_STORE(st_)                                                                                     \
    { char* b_ = lds + (st_) * 24576 + lw; *(uint4*)(b_) = ra0; *(uint4*)(b_ + 4096) = ra1; *(uint4*)(b_ + 8192) = ra2; \
      *(uint4*)(b_ + 12288) = ra3; *(uint4*)(b_ + 16384) = rb0; *(uint4*)(b_ + 16384 + 4096) = rb1; }
    G2_LOAD(0);
    G2_STORE(0);
    __syncthreads();
    for (int kt = 0; kt < nk; ++kt) {
        const int st = kt & 1;
        if (kt + 1 < nk) G2_LOAD((kt + 1) * 32);
        const char* la = lds + st * 24576 + (wr * 128 + fr) * 64 + fq * 16;
        const char* lb = lds + st * 24576 + 16384 + (wc * 64 + fr) * 64 + fq * 16;
        bf16x8 bf[4];
#pragma unroll
        for (int i = 0; i < 4; ++i) bf[i] = *(const bf16x8*)(lb + i * 1024);
#pragma unroll
        for (int mi = 0; mi < 8; ++mi) {
            const bf16x8 af = *(const bf16x8*)(la + mi * 1024);
#pragma unroll
            for (int ni = 0; ni < 4; ++ni) acc[mi][ni] = TR ? mma(af, bf[ni], acc[mi][ni]) : mma(bf[ni], af, acc[mi][ni]);
        }
        if (kt + 1 < nk) G2_STORE(st ^ 1);
        __syncthreads();
    }
}

#define RAW_BARRIER() do { asm volatile("s_waitcnt lgkmcnt(0)" ::: "memory"); __builtin_amdgcn_s_barrier(); } while (0)
template <bool TR, int NI>
DEVI void gemm3_main(f32x4 (&acc)[8][NI], char* lds, const bf16_t* A, size_t lda, const bf16_t* Bt, int ldb, int nBmax, int m0, int n0, int K) {
    const int tid = tidx(), lane = tid & 63, wid = __builtin_amdgcn_readfirstlane(tid >> 6), wr = wid >> 1, wc = wid & 1, fr = lane & 15, fq = lane >> 4;
    const int c = tid & 3, r0 = tid >> 2;
    const bf16_t* ap = A + (size_t)(m0 + r0) * lda + c * 8;
    const bf16_t* bp0; const bf16_t* bp1;
    { int nr = n0 + r0; if (nr > nBmax) nr = nBmax; bp0 = Bt + (size_t)nr * ldb + c * 8; nr = n0 + r0 + 64; if (nr > nBmax) nr = nBmax; bp1 = Bt + (size_t)nr * ldb + c * 8; }
    const size_t a64 = (size_t)64 * lda;
    const int nk = K >> 5;
#define G3_ISSUE(kt_, st_)                                                                                                   \
    { char* d_ = lds + (st_) * 24576 + wid * 1024; const int ko_ = (kt_) * 32;                                               \
      __builtin_amdgcn_global_load_lds((const unsigned*)(ap + ko_), (unsigned*)(d_), 16, 0, 0);                               \
      __builtin_amdgcn_global_load_lds((const unsigned*)(ap + a64 + ko_), (unsigned*)(d_ + 4096), 16, 0, 0);                  \
      __builtin_amdgcn_global_load_lds((const unsigned*)(ap + 2 * a64 + ko_), (unsigned*)(d_ + 8192), 16, 0, 0);              \
      __builtin_amdgcn_global_load_lds((const unsigned*)(ap + 3 * a64 + ko_), (unsigned*)(d_ + 12288), 16, 0, 0);             \
      __builtin_amdgcn_global_load_lds((const unsigned*)(bp0 + ko_), (unsigned*)(d_ + 16384), 16, 0, 0);                      \
      if (NI == 4) __builtin_amdgcn_global_load_lds((const unsigned*)(bp1 + ko_), (unsigned*)(d_ + 20480), 16, 0, 0); }
    G3_ISSUE(0, 0);
    G3_ISSUE(1, 1);
    int st = 0;
    for (int kt = 0; kt < nk; ++kt) {
        if (kt + 1 < nk) { if (NI == 4) asm volatile("s_waitcnt vmcnt(6)" ::: "memory"); else asm volatile("s_waitcnt vmcnt(5)" ::: "memory"); }
        else asm volatile("s_waitcnt vmcnt(0)" ::: "memory");
        RAW_BARRIER();
        if (kt + 2 < nk) { const int s2 = st >= 1 ? st - 1 : 2; G3_ISSUE(kt + 2, s2); }
        const char* la = lds + st * 24576 + (wr * 128 + fr) * 64 + fq * 16;
        const char* lb = lds + st * 24576 + 16384 + (wc * NI * 16 + fr) * 64 + fq * 16;
        bf16x8 bf[NI];
#pragma unroll
        for (int i = 0; i < NI; ++i) bf[i] = *(const bf16x8*)(lb + i * 1024);
        __builtin_amdgcn_s_setprio(1);
#pragma unroll
        for (int mi = 0; mi < 8; ++mi) {
            const bf16x8 af = *(const bf16x8*)(la + mi * 1024);
#pragma unroll
            for (int ni = 0; ni < NI; ++ni) acc[mi][ni] = TR ? mma(af, bf[ni], acc[mi][ni]) : mma(bf[ni], af, acc[mi][ni]);
        }
        __builtin_amdgcn_s_setprio(0);
        st = st == 2 ? 0 : st + 1;
    }
    RAW_BARRIER();
}
DEVI void zero_acc2(f32x4 (&acc)[8][4]) {
#pragma unroll
    for (int i = 0; i < 8; ++i)
#pragma unroll
        for (int j = 0; j < 4; ++j) acc[i][j] = (f32x4){0.f, 0.f, 0.f, 0.f};
}
DEVI void rmsnorm_rows(const Params& p, int item) {
    const int thr_ = tidx();
    const int lane = thr_ & 63, wid = thr_ >> 6;
    const int row = item * 4 + wid;
    const float* xr = p.x + (size_t)row * DM;
    f32x4 v[8];
    float ss = 0.f;
#pragma unroll
    for (int i = 0; i < 8; ++i) { v[i] = *(const f32x4*)(xr + (i >> 1) * 512 + lane * 8 + (i & 1) * 4); ss += v[i][0] * v[i][0] + v[i][1] * v[i][1] + v[i][2] * v[i][2] + v[i][3] * v[i][3]; }
    ss = wave_sum(ss);
    const float rs = rsqrtf(ss * (1.f / DM) + 1e-6f);
    bf16_t* hr = (bf16_t*)(p.ws + O_H) + (size_t)row * DM;
#pragma unroll
    for (int i = 0; i < 8; i += 2) {
        const f32x4 g0 = *(const f32x4*)(p.pre_g + (i >> 1) * 512 + lane * 8), g1 = *(const f32x4*)(p.pre_g + (i >> 1) * 512 + lane * 8 + 4);
        *(uint4*)(hr + (i >> 1) * 512 + lane * 8) = make_uint4(pk2(v[i][0] * rs * g0[0], v[i][1] * rs * g0[1]), pk2(v[i][2] * rs * g0[2], v[i][3] * rs * g0[3]),
                                                            pk2(v[i + 1][0] * rs * g1[0], v[i + 1][1] * rs * g1[1]), pk2(v[i + 1][2] * rs * g1[2], v[i + 1][3] * rs * g1[3]));
    }
}
struct TJob { const float* src; bf16_t* dst; int K, ld, width; };
DEVI bool tjob(const Params& p, int j, TJob& t) {
    char* ws = p.ws;
    bf16_t* wint = (bf16_t*)(ws + O_WINT);
    switch (j) {
        case 0: t = {p.w_in, wint, 2048, DIN, 4096}; return true;
        case 1: t = {p.w_in + 4104, wint + (size_t)4096 * 2048, 2048, DIN, 2560}; return true;
        case 2: t = {p.w_in + 6712, wint + (size_t)6656 * 2048, 2048, DIN, 5120}; return true;
        case 3: t = {p.w_in + 4096, wint + (size_t)11776 * 2048, 2048, DIN, 8}; return true;
        case 4: t = {p.w_in + 6664, wint + (size_t)11784 * 2048, 2048, DIN, 48}; return true;
        case 5: t = {nullptr, wint + (size_t)11832 * 2048, 2048, DIN, 72}; return true;
        case 6: t = {p.w_up_m, (bf16_t*)(ws + O_WUM), 1024, 2048, 2048}; return true;
        case 7: t = {p.w_up_a, (bf16_t*)(ws + O_WUA), 1024, 2048, 2048}; return true;
        case 8: t = {p.w_out, (bf16_t*)(ws + O_WOUT), 2048, 2048, 2048}; return true;
        case 9: case 10: case 11: case 12: t = {p.w_q + (j - 9) * 65536, (bf16_t*)(ws + O_WQ) + (j - 9) * 65536, 256, 256, 256}; return true;
        case 13: case 14: case 15: case 16: t = {p.w_k + (j - 13) * 65536, (bf16_t*)(ws + O_WK) + (j - 13) * 65536, 256, 256, 256}; return true;
        case 17: t = {p.w1_k, (bf16_t*)(ws + O_W1K), 2048, 256, 256}; return true;
        case 18: t = {p.w1_v, (bf16_t*)(ws + O_W1V), 2048, 256, 256}; return true;
        case 19: t = {p.w2_k, (bf16_t*)(ws + O_W2K), 256, 64, 64}; return true;
        case 20: t = {p.w2_v, (bf16_t*)(ws + O_W2V), 256, 64, 64}; return true;
        default: return false;
    }
}
constexpr int N_TJOBS = 21;
constexpr int N_TTILES = 4264;
DEVI void transpose_item(const Params& p, int item, char* lds) {
    const int thr_ = tidx();
    TJob t;
    int j = 0;
    for (; j < N_TJOBS; ++j) {
        tjob(p, j, t);
        const int cnt = (t.K >> 6) * ((t.width + 127) >> 7);
        if (item < cnt) break;
        item -= cnt;
    }
    if (j >= N_TJOBS) return;
    const int tk = t.K >> 6;
    const int kt = item % tk, nt = item / tk;
    const int lane = thr_ & 63, wid = thr_ >> 6, kg = lane >> 3, nc = lane & 7;
    const int k0 = kt * 64 + kg * 8, n = nt * 128 + wid * 32 + nc * 4;
    if (n >= t.width) return;
    f32x4 v[8];
    if (t.src) {
        const float* sp = t.src + (size_t)k0 * t.ld + n;
#pragma unroll
        for (int r = 0; r < 8; ++r) v[r] = *(const f32x4*)(sp + (size_t)r * t.ld);
    } else {
#pragma unroll
        for (int r = 0; r < 8; ++r) v[r] = (f32x4){0.f, 0.f, 0.f, 0.f};
    }
    bf16_t* d = t.dst + (size_t)n * t.K + k0;
#pragma unroll
    for (int jj = 0; jj < 4; ++jj)
        *(uint4*)(d + (size_t)jj * t.K) = make_uint4(pk2(v[0][jj], v[1][jj]), pk2(v[2][jj], v[3][jj]), pk2(v[4][jj], v[5][jj]), pk2(v[6][jj], v[7][jj]));
}
DEVI void bias_item(const Params& p, int item) {
    const int thr_ = tidx();
    const int kv = item >> 4, seg = item & 15, j = thr_;
    const float* pe = kv ? p.pe_v : p.pe_k;
    const float* w1 = kv ? p.w1_v : p.w1_k;
    float a = 0.f;
#pragma unroll 8
    for (int k = seg * 128; k < seg * 128 + 128; ++k) a += pe[k] * w1[(size_t)k * 256 + j];
    ((float*)(p.ws + O_B1P))[(kv * 16 + seg) * 256 + j] = a;
}

DEVI void inproj_tile(const Params& p, int item, char* lds) {
    const int ni_ = item >> 5, mt = item & 31;
    const int nt = ni_ < 4 ? 40 + ni_ : (ni_ < 44 ? ni_ - 4 : ni_);
    const int m0 = mt * 256, n0 = nt * 128;
    const bool tr = (nt >= 8 && nt < 16) || nt == 46 || nt == 47 || nt == 50 || nt == 51;
    const int tid = tidx(), lane = tid & 63, wid = tid >> 6, wr = wid >> 1, wc = wid & 1, fr = lane & 15, fq = lane >> 4;
    f32x4 acc[8][4];
    zero_acc2(acc);
    const bf16_t* A = (const bf16_t*)(p.ws + O_H);
    const bf16_t* Bt = (const bf16_t*)(p.ws + O_WINT);
    if (tr) {
        gemm3_main<true, 4>(acc, lds, A, DM, Bt, DM, NP - 1, m0, n0, DM);
        bf16_t* base; int cb, ncol;
        if (nt < 16) { base = (bf16_t*)(p.ws + O_VMT); cb = C_MV; ncol = 1024; }
        else if (nt < 48) { base = (bf16_t*)(p.ws + O_VST); cb = C_VS; ncol = 256; }
        else { base = (bf16_t*)(p.ws + O_VWT); cb = C_VW; ncol = 256; }
#pragma unroll
        for (int mi = 0; mi < 8; mi += 2)
#pragma unroll
            for (int ni = 0; ni < 4; ++ni) {
                const int row = m0 + wr * 128 + (mi + (fq & 1)) * 16 + (fq >> 1) * 8, col = n0 + wc * 64 + ni * 16 + fr - cb;
                const int b = row >> 11, s_ = row & 2047;
                uint2 x, y;
                x.x = pk2(acc[mi][ni][0], acc[mi][ni][1]); x.y = pk2(acc[mi][ni][2], acc[mi][ni][3]);
                y.x = pk2(acc[mi + 1][ni][0], acc[mi + 1][ni][1]); y.y = pk2(acc[mi + 1][ni][2], acc[mi + 1][ni][3]);
                store_nt16(base + ((size_t)(b * ncol + col)) * S + s_, pair16(x, y));
            }
    } else {
        gemm3_main<false, 4>(acc, lds, A, DM, Bt, DM, NP - 1, m0, n0, DM);
        if (n0 == C_GATE) {
            float* G = (float*)(p.ws + O_G);
#pragma unroll
            for (int mi = 0; mi < 8; ++mi)
#pragma unroll
                for (int ni = 0; ni < 4; ++ni) {
                    const int row = m0 + wr * 128 + mi * 16 + fr, cl = wc * 64 + ni * 16 + fq * 4;
                    if (cl < 56) *(f32x4*)(G + (size_t)row * 64 + cl) = acc[mi][ni];
                }
        } else {
            bf16_t* P = (bf16_t*)(p.ws + O_P);
#pragma unroll
            for (int mi = 0; mi < 8; ++mi)
#pragma unroll
                for (int ni = 0; ni < 4; ni += 2) {
                    const int row = m0 + wr * 128 + mi * 16 + fr, col = n0 + wc * 64 + (ni + (fq & 1)) * 16 + (fq >> 1) * 8;
                    uint2 x, y;
                    x.x = pk2(acc[mi][ni][0], acc[mi][ni][1]); x.y = pk2(acc[mi][ni][2], acc[mi][ni][3]);
                    y.x = pk2(acc[mi][ni + 1][0], acc[mi][ni + 1][1]); y.y = pk2(acc[mi][ni + 1][2], acc[mi][ni + 1][3]);
                    store_nt16(P + (size_t)row * NPS + col, pair16(x, y));
                }
        }
    }
    if (ni_ < 4) {
        asm volatile("s_waitcnt vmcnt(0)" ::: "memory");
        __syncthreads();
        if (threadIdx.x == 0) {
            __builtin_amdgcn_fence(__ATOMIC_RELEASE, "agent");
            asm volatile("s_waitcnt vmcnt(0)" ::: "memory");
            xb_add((unsigned*)(p.ws + O_BAR) + 0, 1u);
        }
    }
}

DEVI void conv_item(const Params& p, int item) {
    const int thr_ = tidx();
    const int tok = item * 2 + (thr_ >> 7), c = (thr_ & 127) * 8;
    const int s = tok & 2047;
    const bf16_t* P = (const bf16_t*)(p.ws + O_P);
    float acc[8];
#pragma unroll
    for (int i = 0; i < 8; ++i) acc[i] = p.conv_b[c + i];
#pragma unroll
    for (int k = 0; k < 4; ++k) {
        const int ds = k - 3;
        if (s + ds >= 0) {
            const uint4 xv = *(const uint4*)(P + (size_t)(tok + ds) * NPS + C_MX + c);
            const f32x4 w0 = *(const f32x4*)(p.conv_w + k * 1024 + c), w1 = *(const f32x4*)(p.conv_w + k * 1024 + c + 4);
            acc[0] += lo16(xv.x) * w0[0]; acc[1] += hi16(xv.x) * w0[1]; acc[2] += lo16(xv.y) * w0[2]; acc[3] += hi16(xv.y) * w0[3];
            acc[4] += lo16(xv.z) * w1[0]; acc[5] += hi16(xv.z) * w1[1]; acc[6] += lo16(xv.w) * w1[2]; acc[7] += hi16(xv.w) * w1[3];
        }
    }
    uint4 o;
    o.x = pk2(silu(acc[0]), silu(acc[1])); o.y = pk2(silu(acc[2]), silu(acc[3])); o.z = pk2(silu(acc[4]), silu(acc[5])); o.w = pk2(silu(acc[6]), silu(acc[7]));
    *(uint4*)((bf16_t*)(p.ws + O_XC) + (size_t)tok * 1024 + c) = o;
}
struct RowCmp {
    const bf16_t* Pc;
    DEVI const bf16_t* operator()(int r) const {
        if (r > 2031) r = 2031;
        const int bg = r / 127, n = r - bg * 127, b = bg >> 2, g = bg & 3;
        return Pc + (size_t)(b * S + 16 * n) * NPS + g * 64;
    }
};
DEVI void cmp1_tile(const Params& p, int item, char* lds) {
    const int kv = item >> 5, mt = (item >> 1) & 15, nt = item & 1;
    const int m0 = mt * 128, n0 = nt * 128;
    const int tid = tidx(), lane = tid & 63, wid = tid >> 6, wr = wid >> 1, wc = wid & 1, fr = lane & 15, fq = lane >> 4;
    f32x4 acc[4][4];
    zero_acc(acc);
    RowCmp rc{(const bf16_t*)(p.ws + O_P) + (kv ? C_VC : C_KC)};
    gemm_main<false, 4>(acc, lds, rc, (size_t)NPS, (const bf16_t*)(p.ws + (kv ? O_W1V : O_W1K)), 2048, 255, m0, n0, 2048);
    const float* bp = (const float*)(p.ws + O_B1P) + kv * 16 * 256;
    bf16_t* HC = (bf16_t*)(p.ws + O_HC) + (size_t)kv * 2048 * 256;
#pragma unroll
    for (int ni = 0; ni < 4; ++ni) {
        const int col = n0 + wc * 64 + ni * 16 + fq * 4;
        f32x4 bs = {0.f, 0.f, 0.f, 0.f};
        for (int sg = 0; sg < 16; ++sg) bs += *(const f32x4*)(bp + sg * 256 + col);
#pragma unroll
        for (int mi = 0; mi < 4; ++mi) {
            const int row = m0 + wr * 64 + mi * 16 + fr;
            const f32x4 v = acc[mi][ni] + bs;
            uint2 o; o.x = pk2(silu(v[0]), silu(v[1])); o.y = pk2(silu(v[2]), silu(v[3]));
            *(uint2*)(HC + (size_t)row * 256 + col) = o;
        }
    }
}
DEVI void scan_item(const Params& p, int item, char* lds) {
    const int thr_ = tidx();
    const int b = item >> 2, h = item & 3, tid = thr_;
    const float* G = (const float*)(p.ws + O_G);
    float* red = (float*)lds;
    const float bi = p.b_i[h], bfv = p.b_f[h];
    float ig[8], F[8];
    float run = 0.f;
#pragma unroll
    for (int i = 0; i < 8; ++i) {
        const size_t tok = (size_t)b * S + tid * 8 + i;
        ig[i] = G[tok * 64 + h] + bi;
        const float fg = G[tok * 64 + 4 + h] + bfv;
        const float lf = fminf(fg, 0.f) - log1pf(expf(-fabsf(fg)));
        run += lf;
        F[i] = run;
    }
    red[tid] = run;
    __syncthreads();
    float ex = 0.f;
    for (int j = 0; j < tid; ++j) ex += red[j];
    __syncthreads();
    float a[8], mx[8];
    float rm = -1e30f;
#pragma unroll
    for (int i = 0; i < 8; ++i) { F[i] += ex; a[i] = ig[i] - F[i]; rm = fmaxf(rm, a[i]); mx[i] = rm; }
    red[tid] = rm;
    __syncthreads();
    float em = -1e30f;
    for (int j = 0; j < tid; ++j) em = fmaxf(em, red[j]);
    __syncthreads();
    float* FA = (float*)(p.ws + O_FA) + item * S + tid * 8;
    float* FM = (float*)(p.ws + O_FM) + item * S + tid * 8;
    float* FL = (float*)(p.ws + O_FL) + item * S + tid * 8;
#pragma unroll
    for (int i = 0; i < 8; ++i) { const float m = fmaxf(mx[i], em); FA[i] = a[i]; FM[i] = m; FL[i] = F[i] + m; }
}

DEVI void qk_tile(const Params& p, int item, char* lds) {
    const int nt = item & 1, mt = (item >> 1) & 63, h = (item >> 7) & 3, qk = item >> 9;
    const int m0 = mt * 128, n0 = nt * 128;
    const int tid = tidx(), lane = tid & 63, wid = tid >> 6, wr = wid >> 1, wc = wid & 1, fr = lane & 15, fq = lane >> 4;
    f32x4 acc[4][4];
    zero_acc(acc);
    RowLin rl{(const bf16_t*)(p.ws + O_XC) + h * 256, (size_t)1024};
    gemm_main<false, 4>(acc, lds, rl, 64, (const bf16_t*)(p.ws + (qk ? O_WK : O_WQ)) + h * 65536, 256, 255, m0, n0, 256);
    bf16_t* O = (bf16_t*)(p.ws + (qk ? O_KM : O_QM));
    const float sc = qk ? 0.0625f : 1.f;
#pragma unroll
    for (int mi = 0; mi < 4; ++mi)
#pragma unroll
        for (int ni = 0; ni < 4; ni += 2) {
            const int row = m0 + wr * 64 + mi * 16 + fr, col = h * 256 + n0 + wc * 64 + (ni + (fq & 1)) * 16 + (fq >> 1) * 8;
            uint2 x, y;
            x.x = pk2(acc[mi][ni][0] * sc, acc[mi][ni][1] * sc); x.y = pk2(acc[mi][ni][2] * sc, acc[mi][ni][3] * sc);
            y.x = pk2(acc[mi][ni + 1][0] * sc, acc[mi][ni + 1][1] * sc); y.y = pk2(acc[mi][ni + 1][2] * sc, acc[mi][ni + 1][3] * sc);
            *(uint4*)(O + (size_t)row * 1024 + col) = pair16(x, y);
        }
}
DEVI void cmp2_tile(const Params& p, int item, char* lds) {
    const int kv = item >> 4, mt = item & 15, m0 = mt * 128;
    const int tid = tidx(), lane = tid & 63, wid = tid >> 6, wr = wid >> 1, wc = wid & 1, fr = lane & 15, fq = lane >> 4;
    f32x4 acc[4][4];
    zero_acc(acc);
    RowLin rl{(const bf16_t*)(p.ws + O_HC) + (size_t)kv * 2048 * 256, (size_t)256};
    gemm_main<false, 4>(acc, lds, rl, 64, (const bf16_t*)(p.ws + (kv ? O_W2V : O_W2K)), 256, 63, m0, 0, 256);
    float* O = (float*)(p.ws + (kv ? O_VCF : O_KCF));
    if (wc == 0) {
#pragma unroll
        for (int mi = 0; mi < 4; ++mi)
#pragma unroll
            for (int ni = 0; ni < 4; ++ni) {
                const int row = m0 + wr * 64 + mi * 16 + fr, col = ni * 16 + fq * 4;
                if (row < 2032) *(f32x4*)(O + (size_t)row * 64 + col) = acc[mi][ni];
            }
    }
}

DEVI void mlstm_item(const Params& p, int item) {
    const int thr_ = tidx();
    const int qb = 31 - (item >> 4), bh = item & 15, b = bh >> 2, h = bh & 3;
    const int lane = thr_ & 63, wid = __builtin_amdgcn_readfirstlane(thr_ >> 6), fr = lane & 15, fq = lane >> 4;
    const int t0 = qb * 64 + wid * 16, trow = t0 + fr;
    const bf16_t* Qm = (const bf16_t*)(p.ws + O_QM);
    const bf16_t* Km = (const bf16_t*)(p.ws + O_KM);
    const bf16_t* VmT = (const bf16_t*)(p.ws + O_VMT);
    const float* fa = (const float*)(p.ws + O_FA) + bh * S;
    const float mx = ((const float*)(p.ws + O_FM))[bh * S + trow];
    bf16x8 qf[8];
    {
        const bf16_t* qrow = Qm + (size_t)(b * S + trow) * 1024 + h * 256 + fq * 8;
#pragma unroll
        for (int ks = 0; ks < 8; ++ks) qf[ks] = *(const bf16x8*)(qrow + ks * 32);
    }
    f32x4 o[16];
#pragma unroll
    for (int i = 0; i < 16; ++i) o[i] = (f32x4){0.f, 0.f, 0.f, 0.f};
    float den = 0.f;
    const bf16_t* kbase = Km + (size_t)(b * S + fr) * 1024 + h * 256 + fq * 8;
    const bf16_t* vbase = VmT + ((size_t)(b * 1024 + h * 256 + fr)) * S + fq * 4;
    for (int s0 = 0; s0 < t0 + 16; s0 += 32) {
        f32x4 sa = {0.f, 0.f, 0.f, 0.f}, sb = {0.f, 0.f, 0.f, 0.f};
        const bf16_t* k0 = kbase + (size_t)s0 * 1024;
        const bf16_t* k1 = k0 + 16 * 1024;
#pragma unroll
        for (int ks = 0; ks < 8; ++ks) {
            sa = mma(*(const bf16x8*)(k0 + ks * 32), qf[ks], sa);
            sb = mma(*(const bf16x8*)(k1 + ks * 32), qf[ks], sb);
            if (ks == 3) __builtin_amdgcn_sched_barrier(0);
        }
        __builtin_amdgcn_sched_barrier(0);
        const f32x4 a0 = *(const f32x4*)(fa + s0 + fq * 4), a1 = *(const f32x4*)(fa + s0 + 16 + fq * 4);
        float pv[8];
#pragma unroll
        for (int r = 0; r < 4; ++r) {
            const int s = s0 + fq * 4 + r;
            const float w0 = (s <= trow) ? __expf(a0[r] - mx) : 0.f;
            const float w1 = (s + 16 <= trow) ? __expf(a1[r] - mx) : 0.f;
            pv[r] = sa[r] * w0; pv[4 + r] = sb[r] * w1;
            den += pv[r] + pv[4 + r];
        }
        const bf16x8 pf = pack8(pv);
#pragma unroll
        for (int dvt = 0; dvt < 16; ++dvt) {
            const bf16_t* vp = vbase + (size_t)(dvt * 16) * S + s0;
            const bf16x8 vf = join8(*(const uint2*)vp, *(const uint2*)(vp + 16));
            o[dvt] = mma(vf, pf, o[dvt]);
            if ((dvt & 3) == 3) __builtin_amdgcn_sched_barrier(0);
        }
    }
    den += __shfl_xor(den, 16);
    den += __shfl_xor(den, 32);
    const float lower = __expf(-((const float*)(p.ws + O_FL))[bh * S + trow]);
    const float inv = 1.f / fmaxf(fabsf(den), lower);
    const bf16_t* Prow = (const bf16_t*)(p.ws + O_P) + (size_t)(b * S + trow) * NPS;
    float sum = 0.f;
#pragma unroll
    for (int dvt = 0; dvt < 16; ++dvt) {
        const int c = h * 256 + dvt * 16 + fq * 4;
        const uint2 op = *(const uint2*)(Prow + C_MO + c);
        o[dvt][0] *= inv * sigm(lo16(op.x)); o[dvt][1] *= inv * sigm(hi16(op.x)); o[dvt][2] *= inv * sigm(lo16(op.y)); o[dvt][3] *= inv * sigm(hi16(op.y));
        sum += o[dvt][0] + o[dvt][1] + o[dvt][2] + o[dvt][3];
    }
    sum += __shfl_xor(sum, 16);
    sum += __shfl_xor(sum, 32);
    const float mu = sum * (1.f / 256.f);
    float vs = 0.f;
#pragma unroll
    for (int dvt = 0; dvt < 16; ++dvt)
#pragma unroll
        for (int r = 0; r < 4; ++r) { const float d = o[dvt][r] - mu; vs += d * d; }
    vs += __shfl_xor(vs, 16);
    vs += __shfl_xor(vs, 32);
    const float rstd = rsqrtf(vs * (1.f / 256.f) + 1e-6f);
    const bf16_t* xcrow = (const bf16_t*)(p.ws + O_XC) + (size_t)(b * S + trow) * 1024;
    bf16_t* ymrow = (bf16_t*)(p.ws + O_YM) + (size_t)(b * S + trow) * 1024;
#pragma unroll
    for (int dvt = 0; dvt < 16; ++dvt) {
        const int c = h * 256 + dvt * 16 + fq * 4;
        const f32x4 ng = *(const f32x4*)(p.norm_g + c), sk = *(const f32x4*)(p.skip + c);
        const uint2 xc = *(const uint2*)(xcrow + c), mz = *(const uint2*)(Prow + C_MZ + c);
        const float y0 = ((o[dvt][0] - mu) * rstd * ng[0] + sk[0] * lo16(xc.x)) * silu(lo16(mz.x));
        const float y1 = ((o[dvt][1] - mu) * rstd * ng[1] + sk[1] * hi16(xc.x)) * silu(hi16(mz.x));
        const float y2 = ((o[dvt][2] - mu) * rstd * ng[2] + sk[2] * lo16(xc.y)) * silu(lo16(mz.y));
        const float y3 = ((o[dvt][3] - mu) * rstd * ng[3] + sk[3] * hi16(xc.y)) * silu(hi16(mz.y));
        uint2 ov; ov.x = pk2(y0, y1); ov.y = pk2(y2, y3);
        *(uint2*)(ymrow + c) = ov;
    }
}

DEVI void cmp_item(const Params& p, int item, char* lds) {
    const int thr_ = tidx();
    const int tt = item & 31, bg = item >> 5, b = bg >> 2, g = bg & 3;
    const int lane = thr_ & 63, wid = __builtin_amdgcn_readfirstlane(thr_ >> 6);
    float* kcs = (float*)lds;
    float* psum = (float*)(lds + 33280) + wid * 128;
    const float* KC = (const float*)(p.ws + O_KCF) + (size_t)bg * 127 * 64;
    const float* VC = (const float*)(p.ws + O_VCF) + (size_t)bg * 127 * 64;
    for (int i = thr_; i < 127 * 64; i += 256) kcs[(i >> 6) * 65 + (i & 63)] = KC[i];
    __syncthreads();
    const bf16_t* P = (const bf16_t*)(p.ws + O_P);
    bf16_t* OC = (bf16_t*)(p.ws + O_OC);
    unsigned* SEL = (unsigned*)(p.ws + O_SEL);
#pragma unroll 1
    for (int i = 0; i < 16; ++i) {
        const int t = tt * 64 + wid * 16 + i;
        const size_t tok = (size_t)b * S + t;
        const int nvalid = t >= 31 ? ((t - 31) >> 4) + 1 : 0;
        unsigned mask = 1u;
        if (nvalid == 0) {
#pragma unroll
            for (int h = 0; h < 4; ++h) OC[tok * 1024 + (g * 4 + h) * 64 + lane] = 0;
        } else {
            float qh[4];
#pragma unroll
            for (int h = 0; h < 4; ++h) qh[h] = bf2f(P[tok * NPS + C_AQ + (g * 4 + h) * 64 + lane]) * 0.125f;
            float s0[4] = {0.f, 0.f, 0.f, 0.f}, s1[4] = {0.f, 0.f, 0.f, 0.f};
            const int n1 = lane + 64 > 126 ? 126 : lane + 64;
            const float* k0p = kcs + lane * 65;
            const float* k1p = kcs + n1 * 65;
#pragma unroll
            for (int d = 0; d < 64; ++d) {
                const float k0 = k0p[d], k1 = k1p[d];
#pragma unroll
                for (int h = 0; h < 4; ++h) { const float qd = rdlane(qh[h], d); s0[h] += qd * k0; s1[h] += qd * k1; }
            }
            const bool v0 = lane < nvalid, v1 = lane + 64 < nvalid;
            float p0[4], p1[4];
#pragma unroll
            for (int h = 0; h < 4; ++h) {
                const float mxv = wave_max(fmaxf(v0 ? s0[h] : -1e30f, v1 ? s1[h] : -1e30f));
                const float e0 = v0 ? __expf(s0[h] - mxv) : 0.f, e1 = v1 ? __expf(s1[h] - mxv) : 0.f;
                const float sm = wave_sum(e0 + e1);
                const float is = 1.f / sm;
                p0[h] = e0 * is; p1[h] = e1 * is;
            }
            float oc[4] = {0.f, 0.f, 0.f, 0.f};
            const int na = nvalid < 64 ? nvalid : 64;
            for (int n = 0; n < na; ++n) {
                const float vv = VC[n * 64 + lane];
#pragma unroll
                for (int h = 0; h < 4; ++h) oc[h] += rdlane(p0[h], n) * vv;
            }
            for (int n = 64; n < nvalid; ++n) {
                const float vv = VC[n * 64 + lane];
#pragma unroll
                for (int h = 0; h < 4; ++h) oc[h] += rdlane(p1[h], n - 64) * vv;
            }
#pragma unroll
            for (int h = 0; h < 4; ++h) OC[tok * 1024 + (g * 4 + h) * 64 + lane] = f2bf(oc[h]);
            psum[lane] = p0[0] + p0[1] + p0[2] + p0[3];
            psum[lane + 64] = (lane + 64 < 127) ? (p1[0] + p1[1] + p1[2] + p1[3]) : 0.f;
            __builtin_amdgcn_wave_barrier();
            float sc = -3e30f;
            const int cur = t >> 6;
            if (lane < 32) {
                float imp = 0.f;
#pragma unroll
                for (int k = -1; k < 4; ++k) { const int n = 4 * lane + k; if (n >= 0) imp += psum[n]; }
                const bool forced = lane == 0 || lane == cur || lane == cur - 1;
                sc = forced ? 1e30f : (lane <= cur ? imp : -1e30f);
            }
            __builtin_amdgcn_wave_barrier();
            mask = 0u;
#pragma unroll 1
            for (int it = 0; it < 8; ++it) {
                const float mv = wave_max(sc);
                const unsigned long long bal = __ballot(sc == mv);
                const int win = __ffsll((long long)bal) - 1;
                mask |= 1u << win;
                if (lane == win) sc = -4e30f;
            }
        }
        if (lane == 0) SEL[bg * S + t] = mask;
    }
    __syncthreads();
}

DEVI void attn_chunk(f32x4 (&o)[4], float& m, float& l, bf16x8 q0, bf16x8 q1, const bf16_t* kp, const bf16_t* vp, unsigned vm) {
    f32x4 sa = {0.f, 0.f, 0.f, 0.f}, sb = {0.f, 0.f, 0.f, 0.f};
    sa = mma(*(const bf16x8*)(kp), q0, sa);
    sa = mma(*(const bf16x8*)(kp + 32), q1, sa);
    sb = mma(*(const bf16x8*)(kp + (size_t)16 * NPS), q0, sb);
    sb = mma(*(const bf16x8*)(kp + (size_t)16 * NPS + 32), q1, sb);
    float v[8];
#pragma unroll
    for (int r = 0; r < 4; ++r) { v[r] = sa[r] * 0.125f; v[4 + r] = sb[r] * 0.125f; }
    float mxv = -1e30f;
#pragma unroll
    for (int e = 0; e < 8; ++e) if ((vm >> e) & 1u) mxv = fmaxf(mxv, v[e]);
    mxv = fmaxf(mxv, __shfl_xor(mxv, 16));
    mxv = fmaxf(mxv, __shfl_xor(mxv, 32));
    const float mn = fmaxf(m, mxv);
    const float alpha = __expf(m - mn);
    m = mn;
    float ps = 0.f;
#pragma unroll
    for (int e = 0; e < 8; ++e) { v[e] = ((vm >> e) & 1u) ? __expf(v[e] - mn) : 0.f; ps += v[e]; }
    l = l * alpha + ps;
    const bf16x8 pf = pack8(v);
#pragma unroll
    for (int dvt = 0; dvt < 4; ++dvt) {
        o[dvt] *= alpha;
        const bf16_t* vq = vp + (size_t)(dvt * 16) * S;
        const bf16x8 vf = join8(*(const uint2*)vq, *(const uint2*)(vq + 16));
        o[dvt] = mma(vf, pf, o[dvt]);
    }
}
template <bool SELB>
DEVI void nsa_item(const Params& p, int item) {
    const int thr_ = tidx();
    const int tile = item & 127, bg = item >> 7, b = bg >> 2, g = bg & 3;
    const int lane = thr_ & 63, wid = __builtin_amdgcn_readfirstlane(thr_ >> 6), fr = lane & 15, fq = lane >> 4;
    const int hd = g * 4 + wid, t0 = tile * 16, trow = t0 + fr;
    const bf16_t* P = (const bf16_t*)(p.ws + O_P);
    const size_t tok = (size_t)b * S + trow;
    const bf16_t* qp = P + tok * NPS + C_AQ + hd * 64 + fq * 8;
    const bf16x8 q0 = *(const bf16x8*)qp, q1 = *(const bf16x8*)(qp + 32);
    const bf16_t* kb = P + (size_t)(b * S + fr) * NPS + (SELB ? C_KS : C_KW) + g * 64 + fq * 8;
    const bf16_t* vb = (const bf16_t*)(p.ws + (SELB ? O_VST : O_VWT)) + (size_t)(b * 256 + g * 64 + fr) * S + fq * 4;
    f32x4 o[4];
#pragma unroll
    for (int i = 0; i < 4; ++i) o[i] = (f32x4){0.f, 0.f, 0.f, 0.f};
    float m = -1e30f, l = 0.f;
    if (!SELB) {
        int lo = t0 - 511;
        if (lo < 0) lo = 0;
        for (int s0 = lo & ~31; s0 < t0 + 16; s0 += 32) {
            unsigned vm = 0;
#pragma unroll
            for (int e = 0; e < 8; ++e) { const int s = s0 + (e >> 2) * 16 + fq * 4 + (e & 3); if (s <= trow && s > trow - 512) vm |= 1u << e; }
            attn_chunk(o, m, l, q0, q1, kb + (size_t)s0 * NPS, vb + s0, vm);
        }
    } else {
        const unsigned rm = ((const unsigned*)(p.ws + O_SEL))[bg * S + trow];
        unsigned un = rm;
        un |= __shfl_xor(un, 1); un |= __shfl_xor(un, 2); un |= __shfl_xor(un, 4); un |= __shfl_xor(un, 8);
        un = __builtin_amdgcn_readfirstlane(un);
        const int cur = t0 >> 6;
        for (int j = 0; j <= cur; ++j) {
            if (!((un >> j) & 1u)) continue;
            const bool rs = (rm >> j) & 1u;
#pragma unroll
            for (int hf = 0; hf < 2; ++hf) {
                const int s0 = j * 64 + hf * 32;
                unsigned vm = 0;
#pragma unroll
                for (int e = 0; e < 8; ++e) { const int s = s0 + (e >> 2) * 16 + fq * 4 + (e & 3); if (rs && s <= trow) vm |= 1u << e; }
                attn_chunk(o, m, l, q0, q1, kb + (size_t)s0 * NPS, vb + s0, vm);
            }
        }
    }
    l += __shfl_xor(l, 16);
    l += __shfl_xor(l, 32);
    const float inv = 1.f / l;
    if (!SELB) {
        bf16_t* OW = (bf16_t*)(p.ws + O_OW) + tok * 1024 + hd * 64 + fq * 4;
#pragma unroll
        for (int dvt = 0; dvt < 4; ++dvt) {
            uint2 ov; ov.x = pk2(o[dvt][0] * inv, o[dvt][1] * inv); ov.y = pk2(o[dvt][2] * inv, o[dvt][3] * inv);
            *(uint2*)(OW + dvt * 16) = ov;
        }
    } else {
        const float* G = (const float*)(p.ws + O_G) + tok * 64 + 8 + hd * 3;
        const float g0 = sigm(G[0]), g1 = sigm(G[1]) * inv, g2 = sigm(G[2]);
        const bf16_t* OC = (const bf16_t*)(p.ws + O_OC) + tok * 1024 + hd * 64 + fq * 4;
        const bf16_t* OW = (const bf16_t*)(p.ws + O_OW) + tok * 1024 + hd * 64 + fq * 4;
        const bf16_t* AZ = P + tok * NPS + C_AZ + hd * 64 + fq * 4;
        bf16_t* YA = (bf16_t*)(p.ws + O_YA) + tok * 1024 + hd * 64 + fq * 4;
#pragma unroll
        for (int dvt = 0; dvt < 4; ++dvt) {
            const uint2 oc = *(const uint2*)(OC + dvt * 16), ow = *(const uint2*)(OW + dvt * 16), az = *(const uint2*)(AZ + dvt * 16);
            const float y0 = (g0 * lo16(oc.x) + g1 * o[dvt][0] + g2 * lo16(ow.x)) * silu(lo16(az.x));
            const float y1 = (g0 * hi16(oc.x) + g1 * o[dvt][1] + g2 * hi16(ow.x)) * silu(hi16(az.x));
            const float y2 = (g0 * lo16(oc.y) + g1 * o[dvt][2] + g2 * lo16(ow.y)) * silu(lo16(az.y));
            const float y3 = (g0 * hi16(oc.y) + g1 * o[dvt][3] + g2 * hi16(ow.y)) * silu(hi16(az.y));
            uint2 ov; ov.x = pk2(y0, y1); ov.y = pk2(y2, y3);
            *(uint2*)(YA + dvt * 16) = ov;
        }
    }
}


constexpr int ML_K = 16384, ML_V = 20480, ML_STAGE = ML_K + ML_V;
DEVI void mlstm2_item(const Params& p, int item, char* lds) {
    const int thr_ = tidx();
    const int half = item >> 8, idx = item & 255;
    const int qb = half ? (idx >> 4) : 31 - (idx >> 4), bh = idx & 15, b = bh >> 2, h = bh & 3;
    const int lane = thr_ & 63, wid = __builtin_amdgcn_readfirstlane(thr_ >> 6), fr = lane & 15, fq = lane >> 4;
    const int T0 = qb * 64, t0 = T0 + wid * 16, trow = t0 + fr;
    const bf16_t* Km = (const bf16_t*)(p.ws + O_KM) + (size_t)(b * S) * 1024 + h * 256;
    const bf16_t* VmT = (const bf16_t*)(p.ws + O_VMT) + (size_t)(b * 1024 + h * 256) * S;
    const float* fa = (const float*)(p.ws + O_FA) + bh * S;
    const float mx = ((const float*)(p.ws + O_FM))[bh * S + trow];
    bf16x8 qf[8];
    {
        const bf16_t* qrow = (const bf16_t*)(p.ws + O_QM) + (size_t)(b * S + trow) * 1024 + h * 256 + fq * 8;
#pragma unroll
        for (int ks = 0; ks < 8; ++ks) qf[ks] = *(const bf16x8*)(qrow + ks * 32);
    }
    f32x4 o[16];
#pragma unroll
    for (int i = 0; i < 16; ++i) o[i] = (f32x4){0.f, 0.f, 0.f, 0.f};
    float den = 0.f;
    const int kr = thr_ >> 5, kc = thr_ & 31, vr = thr_ >> 2, vc = thr_ & 3;
    uint4 rk0, rk1, rk2, rk3, rv0, rv1, rv2, rv3;
#define ML_GLOAD(s0_)                                                                      \
    {                                                                                      \
        const bf16_t* kp_ = Km + (size_t)((s0_) + kr) * 1024 + kc * 8;                     \
        rk0 = *(const uint4*)(kp_); rk1 = *(const uint4*)(kp_ + 8 * 1024);                 \
        rk2 = *(const uint4*)(kp_ + 16 * 1024); rk3 = *(const uint4*)(kp_ + 24 * 1024);    \
        const bf16_t* vp_ = VmT + (size_t)vr * S + (s0_) + vc * 8;                         \
        rv0 = *(const uint4*)(vp_); rv1 = *(const uint4*)(vp_ + (size_t)64 * S);           \
        rv2 = *(const uint4*)(vp_ + (size_t)128 * S); rv3 = *(const uint4*)(vp_ + (size_t)192 * S); \
    }
#define ML_LSTORE(st_)                                                                     \
    {                                                                                      \
        char* kb_ = lds + (st_) * ML_STAGE + (kc >> 2) * 2048 + kr * 64 + (kc & 3) * 16;   \
        *(uint4*)(kb_) = rk0; *(uint4*)(kb_ + 8 * 64) = rk1; *(uint4*)(kb_ + 16 * 64) = rk2; *(uint4*)(kb_ + 24 * 64) = rk3; \
        char* vb_ = lds + (st_) * ML_STAGE + ML_K + vr * 80 + vc * 16;                     \
        *(uint4*)(vb_) = rv0; *(uint4*)(vb_ + 64 * 80) = rv1; *(uint4*)(vb_ + 128 * 80) = rv2; *(uint4*)(vb_ + 192 * 80) = rv3; \
    }
    const int nch = 2 * qb + 2;
    ML_GLOAD(0);
    ML_LSTORE(0);
    __syncthreads();
    for (int ci = 0; ci < nch; ++ci) {
        const int s0 = ci * 32, st = ci & 1;
        if (ci + 1 < nch) ML_GLOAD(s0 + 32);
        if (s0 < t0 + 16) {
            __builtin_amdgcn_s_setprio(1);
            const char* kb = lds + st * ML_STAGE;
            const char* vb = kb + ML_K;
            const f32x4 a0 = *(const f32x4*)(fa + s0 + fq * 4), a1 = *(const f32x4*)(fa + s0 + 16 + fq * 4);
            f32x4 sa = {0.f, 0.f, 0.f, 0.f}, sb = {0.f, 0.f, 0.f, 0.f};
#pragma unroll
            for (int ks = 0; ks < 8; ++ks) {
                sa = mma(*(const bf16x8*)(kb + ks * 2048 + fr * 64 + fq * 16), qf[ks], sa);
                sb = mma(*(const bf16x8*)(kb + ks * 2048 + (16 + fr) * 64 + fq * 16), qf[ks], sb);
            }
            float pv[8];
#pragma unroll
            for (int r = 0; r < 4; ++r) {
                const int s = s0 + fq * 4 + r;
                const float w0 = (s <= trow) ? __expf(a0[r] - mx) : 0.f;
                const float w1 = (s + 16 <= trow) ? __expf(a1[r] - mx) : 0.f;
                pv[r] = sa[r] * w0; pv[4 + r] = sb[r] * w1;
                den += pv[r] + pv[4 + r];
            }
            const bf16x8 pf = pack8(pv);
#pragma unroll
            for (int dvt = 0; dvt < 16; ++dvt) {
                const char* vp = vb + (dvt * 16 + fr) * 80 + fq * 8;
                const bf16x8 vf = join8(*(const uint2*)vp, *(const uint2*)(vp + 32));
                o[dvt] = mma(vf, pf, o[dvt]);
            }
            __builtin_amdgcn_s_setprio(0);
        }
        if (ci + 1 < nch) ML_LSTORE(st ^ 1);
        __syncthreads();
    }
    den += __shfl_xor(den, 16);
    den += __shfl_xor(den, 32);
    const float lower = __expf(-((const float*)(p.ws + O_FL))[bh * S + trow]);
    const float inv = 1.f / fmaxf(fabsf(den), lower);
    const bf16_t* Prow = (const bf16_t*)(p.ws + O_P) + (size_t)(b * S + trow) * NPS;
    float sum = 0.f;
#pragma unroll
    for (int dvt = 0; dvt < 16; ++dvt) {
        const int c = h * 256 + dvt * 16 + fq * 4;
        const uint2 op = *(const uint2*)(Prow + C_MO + c);
        o[dvt][0] *= inv * sigm(lo16(op.x)); o[dvt][1] *= inv * sigm(hi16(op.x)); o[dvt][2] *= inv * sigm(lo16(op.y)); o[dvt][3] *= inv * sigm(hi16(op.y));
        sum += o[dvt][0] + o[dvt][1] + o[dvt][2] + o[dvt][3];
    }
    sum += __shfl_xor(sum, 16);
    sum += __shfl_xor(sum, 32);
    const float mu = sum * (1.f / 256.f);
    float vs = 0.f;
#pragma unroll
    for (int dvt = 0; dvt < 16; ++dvt)
#pragma unroll
        for (int r = 0; r < 4; ++r) { const float d = o[dvt][r] - mu; vs += d * d; }
    vs += __shfl_xor(vs, 16);
    vs += __shfl_xor(vs, 32);
    const float rstd = rsqrtf(vs * (1.f / 256.f) + 1e-6f);
    const bf16_t* xcrow = (const bf16_t*)(p.ws + O_XC) + (size_t)(b * S + trow) * 1024;
    bf16_t* ymrow = (bf16_t*)(p.ws + O_YM) + (size_t)(b * S + trow) * 1024;
#pragma unroll
    for (int dv2 = 0; dv2 < 16; dv2 += 2) {
        uint2 ov[2];
#pragma unroll
        for (int q = 0; q < 2; ++q) {
            const int dvt = dv2 + q, c = h * 256 + dvt * 16 + fq * 4;
            const f32x4 ng = *(const f32x4*)(p.norm_g + c), sk = *(const f32x4*)(p.skip + c);
            const uint2 xc = *(const uint2*)(xcrow + c), mz = *(const uint2*)(Prow + C_MZ + c);
            const float y0 = ((o[dvt][0] - mu) * rstd * ng[0] + sk[0] * lo16(xc.x)) * silu(lo16(mz.x));
            const float y1 = ((o[dvt][1] - mu) * rstd * ng[1] + sk[1] * hi16(xc.x)) * silu(hi16(mz.x));
            const float y2 = ((o[dvt][2] - mu) * rstd * ng[2] + sk[2] * lo16(xc.y)) * silu(lo16(mz.y));
            const float y3 = ((o[dvt][3] - mu) * rstd * ng[3] + sk[3] * hi16(xc.y)) * silu(hi16(mz.y));
            ov[q].x = pk2(y0, y1); ov[q].y = pk2(y2, y3);
        }
        *(uint4*)(ymrow + h * 256 + (dv2 + (fq & 1)) * 16 + (fq >> 1) * 8) = pair16(ov[0], ov[1]);
    }
}


constexpr int CM_K = 16384, CM_VS = 272;
DEVI void cmp3_item(const Params& p, int item, char* lds) {
    const int thr_ = tidx();
    const int tile = item & 31, bg = item >> 5, b = bg >> 2, g = bg & 3;
    const int lane = thr_ & 63, wid = __builtin_amdgcn_readfirstlane(thr_ >> 6), fr = lane & 15, fq = lane >> 4;
    const int T0 = tile * 64, t0 = T0 + wid * 16, trow = t0 + fr, cur = tile;
    const float* KC = (const float*)(p.ws + O_KCF) + (size_t)bg * 127 * 64;
    const float* VC = (const float*)(p.ws + O_VCF) + (size_t)bg * 127 * 64;
    for (int i = 0; i < 32; ++i) {
        const int n = i * 4 + (thr_ >> 6), d = thr_ & 63;
        const float kv = n < 127 ? KC[n * 64 + d] : 0.f, vv = n < 127 ? VC[n * 64 + d] : 0.f;
        *(bf16_t*)(lds + (d >> 5) * 8192 + n * 64 + (d & 31) * 2) = f2bf(kv);
        *(bf16_t*)(lds + CM_K + d * CM_VS + n * 2) = f2bf(vv);
    }
    __syncthreads();
    const bf16_t* P = (const bf16_t*)(p.ws + O_P);
    const size_t tok = (size_t)b * S + trow;
    bf16x8 qf[4][2];
#pragma unroll
    for (int h = 0; h < 4; ++h) {
        const bf16_t* qp = P + tok * NPS + C_AQ + (g * 4 + h) * 64 + fq * 8;
        qf[h][0] = *(const bf16x8*)qp; qf[h][1] = *(const bf16x8*)(qp + 32);
    }
    const int nv = trow >= 31 ? ((trow - 31) >> 4) + 1 : 0;
    const int nvw = t0 + 15 >= 31 ? ((t0 + 15 - 31) >> 4) + 1 : 0;
    const int nchunk = (nvw + 31) >> 5;
    float m[4], l[4];
#pragma unroll
    for (int h = 0; h < 4; ++h) { m[h] = -1e30f; l[h] = 0.f; }
    for (int c = 0; c < nchunk; ++c) {
        bf16x8 kf[2][2];
#pragma unroll
        for (int stl = 0; stl < 2; ++stl)
#pragma unroll
            for (int ks = 0; ks < 2; ++ks) kf[stl][ks] = *(const bf16x8*)(lds + ks * 8192 + (c * 32 + stl * 16 + fr) * 64 + fq * 16);
        unsigned vm = 0;
#pragma unroll
        for (int e = 0; e < 8; ++e) { const int n = c * 32 + (e >> 2) * 16 + fq * 4 + (e & 3); if (n < nv) vm |= 1u << e; }
#pragma unroll
        for (int h = 0; h < 4; ++h) {
            f32x4 sa = {0.f, 0.f, 0.f, 0.f}, sb = {0.f, 0.f, 0.f, 0.f};
            sa = mma(kf[0][0], qf[h][0], sa); sa = mma(kf[0][1], qf[h][1], sa);
            sb = mma(kf[1][0], qf[h][0], sb); sb = mma(kf[1][1], qf[h][1], sb);
            float v[8];
#pragma unroll
            for (int r = 0; r < 4; ++r) { v[r] = sa[r] * 0.125f; v[4 + r] = sb[r] * 0.125f; }
            float mxv = -1e30f;
#pragma unroll
            for (int e = 0; e < 8; ++e) if ((vm >> e) & 1u) mxv = fmaxf(mxv, v[e]);
            mxv = fmaxf(mxv, __shfl_xor(mxv, 16));
            mxv = fmaxf(mxv, __shfl_xor(mxv, 32));
            const float mn = fmaxf(m[h], mxv);
            float ps = 0.f;
#pragma unroll
            for (int e = 0; e < 8; ++e) ps += ((vm >> e) & 1u) ? __expf(v[e] - mn) : 0.f;
            l[h] = l[h] * __expf(m[h] - mn) + ps;
            m[h] = mn;
        }
    }
    float linv[4];
#pragma unroll
    for (int h = 0; h < 4; ++h) {
        float lt = l[h];
        lt += __shfl_xor(lt, 16);
        lt += __shfl_xor(lt, 32);
        linv[h] = lt > 0.f ? 1.f / lt : 0.f;
    }
    f32x4 o[4][4];
#pragma unroll
    for (int h = 0; h < 4; ++h)
#pragma unroll
        for (int i = 0; i < 4; ++i) o[h][i] = (f32x4){0.f, 0.f, 0.f, 0.f};
    float own4[8], last[8];
#pragma unroll
    for (int k = 0; k < 8; ++k) { own4[k] = 0.f; last[k] = 0.f; }
#pragma unroll
    for (int c = 0; c < 4; ++c) {
        if (c < nchunk) {
            bf16x8 kf[2][2];
#pragma unroll
            for (int stl = 0; stl < 2; ++stl)
#pragma unroll
                for (int ks = 0; ks < 2; ++ks) kf[stl][ks] = *(const bf16x8*)(lds + ks * 8192 + (c * 32 + stl * 16 + fr) * 64 + fq * 16);
            bf16x8 vf[4];
#pragma unroll
            for (int dvt = 0; dvt < 4; ++dvt) {
                const char* vp = lds + CM_K + (dvt * 16 + fr) * CM_VS + c * 64 + fq * 8;
                vf[dvt] = join8(*(const uint2*)vp, *(const uint2*)(vp + 32));
            }
            unsigned vm = 0;
#pragma unroll
            for (int e = 0; e < 8; ++e) { const int n = c * 32 + (e >> 2) * 16 + fq * 4 + (e & 3); if (n < nv) vm |= 1u << e; }
#pragma unroll
            for (int h = 0; h < 4; ++h) {
                f32x4 sa = {0.f, 0.f, 0.f, 0.f}, sb = {0.f, 0.f, 0.f, 0.f};
                sa = mma(kf[0][0], qf[h][0], sa); sa = mma(kf[0][1], qf[h][1], sa);
                sb = mma(kf[1][0], qf[h][0], sb); sb = mma(kf[1][1], qf[h][1], sb);
                float v[8];
#pragma unroll
                for (int r = 0; r < 4; ++r) { v[r] = sa[r] * 0.125f; v[4 + r] = sb[r] * 0.125f; }
#pragma unroll
                for (int e = 0; e < 8; ++e) v[e] = ((vm >> e) & 1u) ? __expf(v[e] - m[h]) * linv[h] : 0.f;
                own4[2 * c] += (v[0] + v[1]) + (v[2] + v[3]); last[2 * c] += v[3];
                own4[2 * c + 1] += (v[4] + v[5]) + (v[6] + v[7]); last[2 * c + 1] += v[7];
                const bf16x8 pf = pack8(v);
#pragma unroll
                for (int dvt = 0; dvt < 4; ++dvt) o[h][dvt] = mma(vf[dvt], pf, o[h][dvt]);
            }
        }
    }
    bf16_t* OC = (bf16_t*)(p.ws + O_OC) + tok * 1024 + g * 256;
#pragma unroll
    for (int h = 0; h < 4; ++h)
#pragma unroll
        for (int dvt = 0; dvt < 4; dvt += 2) {
            uint2 x, y;
            x.x = pk2(o[h][dvt][0], o[h][dvt][1]); x.y = pk2(o[h][dvt][2], o[h][dvt][3]);
            y.x = pk2(o[h][dvt + 1][0], o[h][dvt + 1][1]); y.y = pk2(o[h][dvt + 1][2], o[h][dvt + 1][3]);
            *(uint4*)(OC + h * 64 + (dvt + (fq & 1)) * 16 + (fq >> 1) * 8) = pair16(x, y);
        }
    float sc[8];
    float prev = 0.f;
#pragma unroll
    for (int k = 0; k < 8; ++k) {
        const float rcv = __shfl(last[k], (lane + 48) & 63);
        const float carry = fq > 0 ? rcv : prev;
        prev = rcv;
        const int j = 4 * k + fq;
        const bool forced = j == 0 || j == cur || j == cur - 1;
        sc[k] = forced ? 1e30f : (j <= cur ? own4[k] + carry : -1e30f);
    }
    unsigned mask = 0u;
#pragma unroll 1
    for (int it = 0; it < 8; ++it) {
        float bv = sc[0];
        int bj = fq;
#pragma unroll
        for (int k = 1; k < 8; ++k) if (sc[k] > bv) { bv = sc[k]; bj = 4 * k + fq; }
#pragma unroll
        for (int off = 16; off <= 32; off <<= 1) {
            const float ov = __shfl_xor(bv, off);
            const int oj = __shfl_xor(bj, off);
            if (ov > bv || (ov == bv && oj < bj)) { bv = ov; bj = oj; }
        }
        mask |= 1u << bj;
#pragma unroll
        for (int k = 0; k < 8; ++k) if (4 * k + fq == bj) sc[k] = -4e30f;
    }
    if (fq == 0) ((unsigned*)(p.ws + O_SEL))[bg * S + trow] = mask & ((2u << cur) - 1u);
    __syncthreads();
}

constexpr int AT_K = 8192, AT_V = 9216, AT_STAGE = AT_K + AT_V;
template <bool SELB, int NH>
DEVI void nsa2_item(const Params& p, int tile, int bg, int h0, char* lds) {
    const int thr_ = tidx();
    const int b = bg >> 2, g = bg & 3;
    const int lane = thr_ & 63, wid = __builtin_amdgcn_readfirstlane(thr_ >> 6), fr = lane & 15, fq = lane >> 4;
    const int T0 = tile * 64, t0 = T0 + wid * 16, trow = t0 + fr, cur = tile;
    const bf16_t* P = (const bf16_t*)(p.ws + O_P);
    const size_t tok = (size_t)b * S + trow;
    bf16x8 qf[NH][2];
#pragma unroll
    for (int h = 0; h < NH; ++h) {
        const bf16_t* qp = P + tok * NPS + C_AQ + (g * 4 + h0 + h) * 64 + fq * 8;
        qf[h][0] = *(const bf16x8*)qp; qf[h][1] = *(const bf16x8*)(qp + 32);
    }
    unsigned rm = 0xffffffffu, wmask, gmask;
    if (SELB) {
        rm = ((const unsigned*)(p.ws + O_SEL))[bg * S + trow];
        unsigned un = rm;
        un |= __shfl_xor(un, 1); un |= __shfl_xor(un, 2); un |= __shfl_xor(un, 4); un |= __shfl_xor(un, 8);
        wmask = __builtin_amdgcn_readfirstlane(un) & ((2u << cur) - 1u);
        unsigned* lu = (unsigned*)(lds + 2 * AT_STAGE);
        if (lane == 0) lu[wid] = wmask;
        __syncthreads();
        gmask = lu[0] | lu[1] | lu[2] | lu[3];
        gmask = __builtin_amdgcn_readfirstlane(gmask);
    } else {
        const int lo = cur >= 8 ? cur - 8 : 0;
        gmask = ((2u << cur) - 1u) & ~((1u << lo) - 1u);
        const int wl = t0 - 511 > 0 ? (t0 - 511) >> 6 : 0;
        wmask = gmask & ~((1u << wl) - 1u);
    }
    const bf16_t* kg = P + (size_t)(b * S) * NPS + (SELB ? C_KS : C_KW) + g * 64;
    const bf16_t* vg = (const bf16_t*)(p.ws + (SELB ? O_VST : O_VWT)) + (size_t)(b * 256 + g * 64) * S;
    const int sc = thr_ & 7, sr = thr_ >> 3;
    uint4 rk0, rk1, rv0, rv1;
#define AT_GLOAD(jj)                                                                                   \
    {                                                                                                  \
        rk0 = *(const uint4*)(kg + (size_t)((jj) * 64 + sr) * NPS + sc * 8);                           \
        rk1 = *(const uint4*)(kg + (size_t)((jj) * 64 + sr + 32) * NPS + sc * 8);                      \
        rv0 = *(const uint4*)(vg + (size_t)(sr) * S + (jj) * 64 + sc * 8);                             \
        rv1 = *(const uint4*)(vg + (size_t)(sr + 32) * S + (jj) * 64 + sc * 8);                        \
    }
#define AT_LSTORE(stt)                                                                                 \
    {                                                                                                  \
        char* base_ = lds + (stt) * AT_STAGE;                                                          \
        *(uint4*)(base_ + (sc >> 2) * 4096 + (sr) * 64 + (sc & 3) * 16) = rk0;                         \
        *(uint4*)(base_ + (sc >> 2) * 4096 + (sr + 32) * 64 + (sc & 3) * 16) = rk1;                    \
        *(uint4*)(base_ + AT_K + (sr) * 144 + sc * 16) = rv0;                                          \
        *(uint4*)(base_ + AT_K + (sr + 32) * 144 + sc * 16) = rv1;                                     \
    }
    f32x4 o[NH][4];
    float m[NH], l[NH];
#pragma unroll
    for (int h = 0; h < NH; ++h) {
        m[h] = -1e30f; l[h] = 0.f;
#pragma unroll
        for (int i = 0; i < 4; ++i) o[h][i] = (f32x4){0.f, 0.f, 0.f, 0.f};
    }
    unsigned rem = gmask;
    int j = __ffs(rem) - 1;
    rem &= rem - 1;
    AT_GLOAD(j);
    AT_LSTORE(0);
    __syncthreads();
    int st = 0;
    while (true) {
        const int jn = rem ? __ffs(rem) - 1 : -1;
        rem &= rem - 1;
        if (jn >= 0) AT_GLOAD(jn);
        if ((wmask >> j) & 1u) {
            __builtin_amdgcn_s_setprio(1);
            const char* kb = lds + st * AT_STAGE;
            const char* vb = kb + AT_K;
            const bool rs = (rm >> j) & 1u;
#pragma unroll
            for (int c = 0; c < 2; ++c) {
                const int s0 = j * 64 + c * 32;
                bf16x8 kf[2][2];
#pragma unroll
                for (int stl = 0; stl < 2; ++stl)
#pragma unroll
                    for (int ks = 0; ks < 2; ++ks) kf[stl][ks] = *(const bf16x8*)(kb + ks * 4096 + (c * 32 + stl * 16 + fr) * 64 + fq * 16);
                bf16x8 vf[4];
#pragma unroll
                for (int dvt = 0; dvt < 4; ++dvt) {
                    const char* vp = vb + (dvt * 16 + fr) * 144 + c * 64 + fq * 8;
                    vf[dvt] = join8(*(const uint2*)vp, *(const uint2*)(vp + 32));
                }
                unsigned vm = 0;
#pragma unroll
                for (int e = 0; e < 8; ++e) {
                    const int s = s0 + (e >> 2) * 16 + fq * 4 + (e & 3);
                    if (rs && s <= trow && (SELB || s > trow - 512)) vm |= 1u << e;
                }
#pragma unroll
                for (int h = 0; h < NH; ++h) {
                    f32x4 sa = {0.f, 0.f, 0.f, 0.f}, sb = {0.f, 0.f, 0.f, 0.f};
                    sa = mma(kf[0][0], qf[h][0], sa); sa = mma(kf[0][1], qf[h][1], sa);
                    sb = mma(kf[1][0], qf[h][0], sb); sb = mma(kf[1][1], qf[h][1], sb);
                    constexpr float SC = 0.125f * 1.44269504f;
                    float v[8];
#pragma unroll
                    for (int r = 0; r < 4; ++r) { v[r] = sa[r]; v[4 + r] = sb[r]; }
                    float mxv = -1e30f;
#pragma unroll
                    for (int e = 0; e < 8; ++e) if ((vm >> e) & 1u) mxv = fmaxf(mxv, v[e]);
                    mxv = fmaxf(mxv, __shfl_xor(mxv, 16));
                    mxv = fmaxf(mxv, __shfl_xor(mxv, 32));
                    const float mn = fmaxf(m[h], mxv);
                    const float alpha = __builtin_amdgcn_exp2f((m[h] - mn) * SC);
                    m[h] = mn;
                    const float mb = -mn * SC;
                    float ps = 0.f;
#pragma unroll
                    for (int e = 0; e < 8; ++e) { v[e] = ((vm >> e) & 1u) ? __builtin_amdgcn_exp2f(fmaf(v[e], SC, mb)) : 0.f; ps += v[e]; }
                    l[h] = l[h] * alpha + ps;
                    const bf16x8 pf = pack8(v);
#pragma unroll
                    for (int dvt = 0; dvt < 4; ++dvt) { o[h][dvt] *= alpha; o[h][dvt] = mma(vf[dvt], pf, o[h][dvt]); }
                }
            }
            __builtin_amdgcn_s_setprio(0);
        }
        if (jn < 0) break;
        AT_LSTORE(st ^ 1);
        __syncthreads();
        st ^= 1;
        j = jn;
    }
    __syncthreads();
#pragma unroll
    for (int h = 0; h < NH; ++h) {
        const int hd = g * 4 + h0 + h;
        float lt = l[h];
        lt += __shfl_xor(lt, 16);
        lt += __shfl_xor(lt, 32);
        const float inv = 1.f / lt;
        if (!SELB) {
            bf16_t* OW = (bf16_t*)(p.ws + O_OW) + tok * 1024 + hd * 64;
#pragma unroll
            for (int dvt = 0; dvt < 4; dvt += 2) {
                uint2 x, y;
                x.x = pk2(o[h][dvt][0] * inv, o[h][dvt][1] * inv); x.y = pk2(o[h][dvt][2] * inv, o[h][dvt][3] * inv);
                y.x = pk2(o[h][dvt + 1][0] * inv, o[h][dvt + 1][1] * inv); y.y = pk2(o[h][dvt + 1][2] * inv, o[h][dvt + 1][3] * inv);
                *(uint4*)(OW + (dvt + (fq & 1)) * 16 + (fq >> 1) * 8) = pair16(x, y);
            }
        } else {
            const float* G = (const float*)(p.ws + O_G) + tok * 64 + 8 + hd * 3;
            const float g0 = sigm(G[0]), g1 = sigm(G[1]) * inv, g2 = sigm(G[2]);
            const bf16_t* OC = (const bf16_t*)(p.ws + O_OC) + tok * 1024 + hd * 64 + fq * 4;
            const bf16_t* OW = (const bf16_t*)(p.ws + O_OW) + tok * 1024 + hd * 64 + fq * 4;
            const bf16_t* AZ = P + tok * NPS + C_AZ + hd * 64 + fq * 4;
            bf16_t* YA = (bf16_t*)(p.ws + O_YA) + tok * 1024 + hd * 64 + fq * 4;
#pragma unroll
            for (int dv2 = 0; dv2 < 4; dv2 += 2) {
                uint2 ov[2];
#pragma unroll
                for (int q = 0; q < 2; ++q) {
                    const int dvt = dv2 + q;
                    const uint2 oc = *(const uint2*)(OC + dvt * 16), ow = *(const uint2*)(OW + dvt * 16), az = *(const uint2*)(AZ + dvt * 16);
                    const float y0 = (g0 * lo16(oc.x) + g1 * o[h][dvt][0] + g2 * lo16(ow.x)) * silu(lo16(az.x));
                    const float y1 = (g0 * hi16(oc.x) + g1 * o[h][dvt][1] + g2 * hi16(ow.x)) * silu(hi16(az.x));
                    const float y2 = (g0 * lo16(oc.y) + g1 * o[h][dvt][2] + g2 * lo16(ow.y)) * silu(lo16(az.y));
                    const float y3 = (g0 * hi16(oc.y) + g1 * o[h][dvt][3] + g2 * hi16(ow.y)) * silu(hi16(az.y));
                    ov[q].x = pk2(y0, y1); ov[q].y = pk2(y2, y3);
                }
                *(uint4*)(YA - fq * 4 + (dv2 + (fq & 1)) * 16 + (fq >> 1) * 8) = pair16(ov[0], ov[1]);
            }
        }
    }
}

DEVI void up_tile(const Params& p, int item, char* lds) {
    const int nt = item >> 5, mt = item & 31, m0 = mt * 256, n0 = nt * 64;
    const int tid = tidx(), lane = tid & 63, wid = tid >> 6, wr = wid >> 1, wc = wid & 1, fr = lane & 15, fq = lane >> 4;
    const bf16_t* P = (const bf16_t*)(p.ws + O_P);
    f32x4 acc[8][2], acc2[8][2];
#pragma unroll
    for (int i = 0; i < 8; ++i) { acc[i][0] = acc[i][1] = acc2[i][0] = acc2[i][1] = (f32x4){0.f, 0.f, 0.f, 0.f}; }
    gemm3_main<false, 2>(acc, lds, (const bf16_t*)(p.ws + O_YM), 1024, (const bf16_t*)(p.ws + O_WUM), 1024, 2047, m0, n0, 1024);
    gemm3_main<false, 2>(acc2, lds, (const bf16_t*)(p.ws + O_YA), 1024, (const bf16_t*)(p.ws + O_WUA), 1024, 2047, m0, n0, 1024);
    bf16_t* MG = (bf16_t*)(p.ws + O_MG);
#pragma unroll
    for (int mi = 0; mi < 8; ++mi) {
        const int row = m0 + wr * 128 + mi * 16 + fr;
        uint2 ov[2];
        const int pc = n0 + wc * 32 + (fq & 1) * 16 + (fq >> 1) * 8;
        const uint4 gm16 = *(const uint4*)(P + (size_t)row * NPS + C_GM + pc), ga16 = *(const uint4*)(P + (size_t)row * NPS + C_GA + pc);
        uint2 ta, tb;
        ta.x = gm16.x; ta.y = gm16.y; tb.x = gm16.z; tb.y = gm16.w;
        const uint4 gmu = pair16(ta, tb);
        ta.x = ga16.x; ta.y = ga16.y; tb.x = ga16.z; tb.y = ga16.w;
        const uint4 gau = pair16(ta, tb);
#pragma unroll
        for (int ni = 0; ni < 2; ++ni) {
            uint2 gm, ga;
            gm.x = ni ? gmu.z : gmu.x; gm.y = ni ? gmu.w : gmu.y; ga.x = ni ? gau.z : gau.x; ga.y = ni ? gau.w : gau.y;
            const float y0 = acc[mi][ni][0] * sigm(lo16(gm.x)) + acc2[mi][ni][0] * sigm(lo16(ga.x)), y1 = acc[mi][ni][1] * sigm(hi16(gm.x)) + acc2[mi][ni][1] * sigm(hi16(ga.x));
            const float y2 = acc[mi][ni][2] * sigm(lo16(gm.y)) + acc2[mi][ni][2] * sigm(lo16(ga.y)), y3 = acc[mi][ni][3] * sigm(hi16(gm.y)) + acc2[mi][ni][3] * sigm(hi16(ga.y));
            ov[ni].x = pk2(y0, y1); ov[ni].y = pk2(y2, y3);
        }
        *(uint4*)(MG + (size_t)row * DM + n0 + wc * 32 + (fq & 1) * 16 + (fq >> 1) * 8) = pair16(ov[0], ov[1]);
    }
}
DEVI void out_tile(const Params& p, int item, char* lds) {
    const int nt = item >> 5, mt = item & 31, m0 = mt * 256, n0 = nt * 128;
    const int tid = tidx(), lane = tid & 63, wid = tid >> 6, wr = wid >> 1, wc = wid & 1, fr = lane & 15, fq = lane >> 4;
    f32x4 acc[8][4];
    zero_acc2(acc);
    gemm3_main<false, 4>(acc, lds, (const bf16_t*)(p.ws + O_MG), DM, (const bf16_t*)(p.ws + O_WOUT), DM, 2047, m0, n0, DM);
    bf16_t* O = (bf16_t*)(p.ws + O_OUT);
#pragma unroll
    for (int mi = 0; mi < 8; ++mi)
#pragma unroll
        for (int ni = 0; ni < 4; ni += 2) {
            const int row = m0 + wr * 128 + mi * 16 + fr, col = n0 + wc * 64 + (ni + (fq & 1)) * 16 + (fq >> 1) * 8;
            uint2 x, y;
            x.x = pk2(acc[mi][ni][0], acc[mi][ni][1]); x.y = pk2(acc[mi][ni][2], acc[mi][ni][3]);
            y.x = pk2(acc[mi][ni + 1][0], acc[mi][ni + 1][1]); y.y = pk2(acc[mi][ni + 1][2], acc[mi][ni + 1][3]);
            *(uint4*)(O + (size_t)row * DM + col) = pair16(x, y);
        }
}
DEVI void final_rows(const Params& p, int item) {
    const int thr_ = tidx();
    const int lane = thr_ & 63, wid = thr_ >> 6;
    const int row = item * 4 + wid;
    const bf16_t* orow = (const bf16_t*)(p.ws + O_OUT) + (size_t)row * DM;
    const float* xr = p.x + (size_t)row * DM;
    f32x4 v[8];
    float ss = 0.f;
#pragma unroll
    for (int i = 0; i < 8; ++i) { const uint2 u = *(const uint2*)(orow + i * 256 + lane * 4); v[i] = (f32x4){lo16(u.x), hi16(u.x), lo16(u.y), hi16(u.y)}; ss += v[i][0] * v[i][0] + v[i][1] * v[i][1] + v[i][2] * v[i][2] + v[i][3] * v[i][3]; }
    ss = wave_sum(ss);
    const float rs = rsqrtf(ss * (1.f / DM) + 1e-6f);
    float* dr = p.out + (size_t)row * DM;
#pragma unroll
    for (int i = 0; i < 8; ++i) {
        const f32x4 g = *(const f32x4*)(p.post_g + i * 256 + lane * 4);
        const f32x4 xv = *(const f32x4*)(xr + i * 256 + lane * 4);
#if DBG == 0
        *(f32x4*)(dr + i * 256 + lane * 4) = xv + v[i] * rs * g;
#elif DBG == 1
        *(f32x4*)(dr + i * 256 + lane * 4) = xv;
#elif DBG == 9
        {
            const int cc = (i * 256 + lane * 4) & 1023;
            const uint2 u0 = *(const uint2*)((const bf16_t*)(p.ws + O_XC) + (size_t)row * 1024 + cc);
            const uint2 u1 = *(const uint2*)((const bf16_t*)(p.ws + O_QM) + (size_t)row * 1024 + cc);
            const uint2 u2 = *(const uint2*)((const bf16_t*)(p.ws + O_KM) + (size_t)row * 1024 + cc);
            const uint2 u3 = *(const uint2*)((const bf16_t*)(p.ws + O_VMT) + (size_t)row * 1024 + cc);
            const int fi = (row & 15) * 2048 + i * 256 + lane * 4;
            const f32x4 f0 = *(const f32x4*)((const float*)(p.ws + O_FA) + fi), f1 = *(const f32x4*)((const float*)(p.ws + O_FM) + fi), f2 = *(const f32x4*)((const float*)(p.ws + O_FL) + fi);
            f32x4 d = {lo16(u0.x) + lo16(u1.x) + lo16(u2.x) + lo16(u3.x), hi16(u0.x) + hi16(u1.x) + hi16(u2.x) + hi16(u3.x), lo16(u0.y) + lo16(u1.y) + lo16(u2.y) + lo16(u3.y), hi16(u0.y) + hi16(u1.y) + hi16(u2.y) + hi16(u3.y)};
            #if PSEL == 0
            d = (f32x4){lo16(u3.x), hi16(u3.x), lo16(u3.y), hi16(u3.y)};
            *(f32x4*)(dr + i * 256 + lane * 4) = xv + d;
#elif PSEL == 1
            d = (f32x4){lo16(u0.x), hi16(u0.x), lo16(u0.y), hi16(u0.y)};
            *(f32x4*)(dr + i * 256 + lane * 4) = xv + d;
#elif PSEL == 2
            *(f32x4*)(dr + i * 256 + lane * 4) = xv + f0 + f1 + f2;
#else
            *(f32x4*)(dr + i * 256 + lane * 4) = xv + d + f0 + f1 + f2;
#endif
        }
#else
        {
            const bf16_t* src = DBG == 2 ? (const bf16_t*)(p.ws + O_MG) + (size_t)row * DM : DBG == 3 ? (const bf16_t*)(p.ws + O_P) + (size_t)row * NPS + 2048
                              : DBG == 4 ? (const bf16_t*)(p.ws + O_YM) + (size_t)row * 1024 : DBG == 5 ? (const bf16_t*)(p.ws + O_YA) + (size_t)row * 1024
                              : DBG == 6 ? (const bf16_t*)(p.ws + O_P) + (size_t)row * NPS + 4096 : (const bf16_t*)(p.ws + O_P) + (size_t)row * NPS + 7680;
            const int cc = (i * 256 + lane * 4) & ((DBG == 4 || DBG == 5) ? 1023 : 2047);
            const uint2 u = *(const uint2*)(src + cc);
            f32x4 d = {lo16(u.x), hi16(u.x), lo16(u.y), hi16(u.y)};
            *(f32x4*)(dr + i * 256 + lane * 4) = xv + d;
        }
#endif
    }
}


__global__ void __launch_bounds__(256, 2) fwd_megakernel(Params p) {
    extern __shared__ __attribute__((aligned(16))) char lds[];
    const int G = gridDim.x, bid = blockIdx.x;
    if (threadIdx.x == 0) *(uint4*)(lds + LDS_MAIN) = make_uint4(0u, 0u, 0u, 0u);
    __syncthreads();
    XcdBarrier xb = xcd_barrier_post((unsigned*)(p.ws + O_BAR), (volatile LAS unsigned*)(lds + LDS_MAIN));
    if (p.ws == nullptr) cg::this_grid().sync();
    for (int rep = 0; rep < NREP(0); ++rep)
    for (int it = bid; it < 2048 + N_TTILES + 32; it += G) {
        if (it < N_TTILES) transpose_item(p, it, lds);
        else if (it < N_TTILES + 2048) rmsnorm_rows(p, it - N_TTILES);
        else bias_item(p, it - N_TTILES - 2048);
    }
    xcd_barrier(xb);
    for (int rep = 0; rep < NREP(1); ++rep)
    for (int it = bid; it < 32 * 93; it += G) inproj_tile(p, it, lds);
    if (G >= 128 && bid >= G - 64) {
        if (threadIdx.x == 0) {
            unsigned* cnt = (unsigned*)(p.ws + O_BAR);
            XB_SPIN(xb_ld(cnt) < 128u * NREP(1), cnt);
            __builtin_amdgcn_fence(__ATOMIC_ACQUIRE, "agent");
            asm volatile("s_waitcnt vmcnt(0)" ::: "memory");
        }
        __syncthreads();
        __builtin_amdgcn_fence(__ATOMIC_ACQUIRE, "agent");
        cmp1_tile(p, bid - (G - 64), lds);
    } else if (G < 128) {
        xcd_barrier(xb);
        for (int it = bid; it < 64; it += G) cmp1_tile(p, it, lds);
    }
    xcd_barrier(xb);
    for (int rep = 0; rep < NREP(2); ++rep)
    for (int it = bid; it < 16 + 4096; it += G) {
        if (it < 16) scan_item(p, it, lds);
        else conv_item(p, it - 16);
    }
    xcd_barrier(xb);
    for (int rep = 0; rep < NREP(3); ++rep)
    for (int it = bid; it < 1024 + 32; it += G) {
        if (it < 32) cmp2_tile(p, it, lds);
        else qk_tile(p, it - 32, lds);
    }
    xcd_barrier(xb);
    for (int rep = 0; rep < NREP(4); ++rep) {
        for (int r2 = 0; r2 < NREP(8); ++r2)
        for (int it = bid; it < 512; it += G) mlstm2_item(p, it, lds);
        for (int r2 = 0; r2 < NREP(9); ++r2)
        if (bid >= (G >> 1)) for (int it = bid - (G >> 1); it < 512; it += G - (G >> 1)) cmp3_item(p, it, lds);
        for (int r2 = 0; r2 < NREP(10); ++r2)
        for (int it = bid; it < 512; it += G) nsa2_item<false, 4>(p, it >> 4, it & 15, 0, lds);
    }
    xcd_barrier(xb);
    for (int rep = 0; rep < NREP(5); ++rep)
    for (int it = bid; it < 1024; it += G) {
        const int idx = it & 511, hp = it >> 9;
        nsa2_item<true, 2>(p, hp ? (idx >> 4) : 31 - (idx >> 4), idx & 15, hp * 2, lds);
    }
    xcd_barrier(xb);
    for (int rep = 0; rep < NREP(6); ++rep)
    for (int it = bid; it < 1024; it += G) up_tile(p, it, lds);
    xcd_barrier(xb);
    for (int rep = 0; rep < NREP(7); ++rep)
    for (int it = bid; it < 512; it += G) out_tile(p, it, lds);
    xcd_barrier(xb);
    for (int rep = 0; rep < NREP(11); ++rep)
    for (int it = bid; it < 2048; it += G) final_rows(p, it);
}

extern "C" void kernel_launch(void* const* d_in, const int* in_sizes, int n_in, void* d_out, int out_size, void* d_ws, size_t ws_size,
                              hipStream_t stream) {
    static int grid_blocks = 0;
    if (!grid_blocks) {
        int dev = 0, cus = 0, per_cu = 0;
        hipGetDevice(&dev);
        hipDeviceGetAttribute(&cus, hipDeviceAttributeMultiprocessorCount, dev);
        hipFuncSetAttribute((const void*)fwd_megakernel, hipFuncAttributeMaxDynamicSharedMemorySize, LDS_BYTES);
        hipOccupancyMaxActiveBlocksPerMultiprocessor(&per_cu, fwd_megakernel, 256, LDS_BYTES);
        if (per_cu < 1) per_cu = 1;
        if (per_cu > 2) per_cu = 2;
        grid_blocks = cus * per_cu;
    }
    if (ws_size < O_END2) { fprintf(stderr, "workspace too small: %zu < %zu\n", ws_size, (size_t)O_END); return; }
    Params p{};
    const float** f = (const float**)&p;
    for (int i = 0; i < 21; ++i) f[i] = (const float*)d_in[i];
    p.out = (float*)d_out;
    p.ws = (char*)d_ws;
    hipMemsetAsync((char*)d_ws + O_BAR, 0, XCD_BAR_WORDS * 4, stream);
    void* args[] = {&p};
    hipError_t e = hipLaunchCooperativeKernel((void*)fwd_megakernel, dim3(grid_blocks), dim3(256), args, LDS_BYTES, stream);
    if (e != hipSuccess) fprintf(stderr, "cooperative launch failed: %s (grid %d)\n", hipGetErrorString(e), grid_blocks);
}
```

```cpp
#include <hip/hip_runtime.h>
#include <hip/hip_cooperative_groups.h>
#include <stdint.h>
#include <cstdio>
namespace cg = cooperative_groups;

typedef unsigned short bf16_t;
typedef short bf16x8 __attribute__((ext_vector_type(8)));
typedef float f32x4 __attribute__((ext_vector_type(4)));
#define DEVI __device__ __forceinline__

constexpr int T = 8192, S = 2048, DM = 2048;
constexpr int NP = 11904, NPS = 11776, DIN = 11832;
constexpr int C_MX = 0, C_MV = 1024, C_MO = 2048, C_MZ = 3072, C_AQ = 4096, C_KC = 5120, C_VC = 5376, C_KS = 5632,
              C_VS = 5888, C_KW = 6144, C_VW = 6400, C_AZ = 6656, C_GM = 7680, C_GA = 9728, C_GATE = 11776;
constexpr size_t O_R0 = 0;
constexpr size_t O_R1 = O_R0 + 33554432;
constexpr size_t O_P = O_R1 + 50331648;
constexpr size_t O_WUM = O_P + 192937984;
constexpr size_t O_WUA = O_WUM + 4194304;
constexpr size_t O_WOUT = O_WUA + 4194304;
constexpr size_t O_WQ = O_WOUT + 8388608;
constexpr size_t O_WK = O_WQ + 524288;
constexpr size_t O_W1K = O_WK + 524288;
constexpr size_t O_W1V = O_W1K + 1048576;
constexpr size_t O_W2K = O_W1V + 1048576;
constexpr size_t O_W2V = O_W2K + 32768;
constexpr size_t O_G = O_W2V + 32768;
constexpr size_t O_VMT = O_G + 2097152;
constexpr size_t O_VST = O_VMT + 16777216;
constexpr size_t O_VWT = O_VST + 4194304;
constexpr size_t O_HC = O_VWT + 4194304;
constexpr size_t O_KCF = O_HC + 2097152;
constexpr size_t O_VCF = O_KCF + 524288;
constexpr size_t O_B1P = O_VCF + 524288;
constexpr size_t O_FA = O_B1P + 32768;
constexpr size_t O_FM = O_FA + 131072;
constexpr size_t O_FL = O_FM + 131072;
constexpr size_t O_SEL = O_FL + 131072;
constexpr size_t O_YM = O_SEL + 131072;
constexpr size_t O_END = O_YM + 16777216;
constexpr size_t O_XC = O_R1, O_QM = O_R1 + 16777216, O_KM = O_R1 + 2 * 16777216, O_YA = O_QM;
constexpr size_t O_OC = O_R0, O_OW = O_R0 + 16777216, O_MG = O_R0, O_H = O_R0, O_WINT = O_R1, O_OUT = O_P;

constexpr int LDS_MAIN = 73728;
constexpr int LDS_BYTES = LDS_MAIN + 64;
constexpr size_t O_BAR = O_END;
constexpr size_t O_END2 = O_BAR + 16384;
#ifndef DBG
#define DBG 0
#endif
#ifndef REPM
#define REPM 0
#endif
#define NREP(k) (((REPM >> (k)) & 1) ? 2 : 1)
#ifndef DSTOP
#define DSTOP 9
#endif
#ifndef PSEL
#define PSEL 0
#endif

struct Params {
    const float *x, *pre_g, *w_in, *conv_w, *conv_b, *w_q, *w_k, *b_i, *b_f, *norm_g, *skip, *pe_k, *w1_k, *w2_k, *pe_v, *w1_v,
        *w2_v, *w_up_m, *w_up_a, *w_out, *post_g;
    float* out;
    char* ws;
};

DEVI int tidx() { int t = threadIdx.x; asm volatile("" : "+v"(t)); return t; }
DEVI float bf2f(bf16_t b) { return __uint_as_float(((unsigned)b) << 16); }
typedef __bf16 bf16v2_t __attribute__((ext_vector_type(2)));
typedef float f32v2_t __attribute__((ext_vector_type(2)));
DEVI unsigned pk2(float lo, float hi) {
    f32v2_t v = {lo, hi};
    bf16v2_t b = __builtin_convertvector(v, bf16v2_t);
    return __builtin_bit_cast(unsigned, b);
}
DEVI bf16_t f2bf(float f) { return (bf16_t)(pk2(f, 0.f) & 0xffffu); }
DEVI float lo16(unsigned u) { return __uint_as_float(u << 16); }
DEVI float hi16(unsigned u) { return __uint_as_float(u & 0xffff0000u); }
DEVI float sigm(float x) { return 1.f / (1.f + __expf(-x)); }
DEVI float silu(float x) { return x / (1.f + __expf(-x)); }
DEVI f32x4 mma(bf16x8 a, bf16x8 b, f32x4 c) { return __builtin_amdgcn_mfma_f32_16x16x32_bf16(a, b, c, 0, 0, 0); }
DEVI float rdlane(float v, int l) { return __uint_as_float(__builtin_amdgcn_readlane(__float_as_uint(v), l)); }
DEVI uint4 pair16(uint2 x, uint2 y) {
    const auto r0 = __builtin_amdgcn_permlane16_swap(x.x, y.x, false, false);
    const auto r1 = __builtin_amdgcn_permlane16_swap(x.y, y.y, false, false);
    return make_uint4(r0[0], r1[0], r0[1], r1[1]);
}
typedef unsigned u32x4_t __attribute__((ext_vector_type(4)));
DEVI void store_nt16(void* ptr, uint4 v) { u32x4_t x = {v.x, v.y, v.z, v.w}; __builtin_nontemporal_store(x, (u32x4_t*)ptr); }
DEVI float wave_max(float v) {
#pragma unroll
    for (int o = 32; o > 0; o >>= 1) v = fmaxf(v, __shfl_xor(v, o));
    return v;
}
DEVI float wave_sum(float v) {
#pragma unroll
    for (int o = 32; o > 0; o >>= 1) v += __shfl_xor(v, o);
    return v;
}
DEVI bf16x8 pack8(const float* v) {
    union { unsigned u[4]; bf16x8 b; } x;
    x.u[0] = pk2(v[0], v[1]); x.u[1] = pk2(v[2], v[3]); x.u[2] = pk2(v[4], v[5]); x.u[3] = pk2(v[6], v[7]);
    return x.b;
}
DEVI bf16x8 join8(uint2 a, uint2 b) {
    union { unsigned u[4]; bf16x8 v; } x;
    x.u[0] = a.x; x.u[1] = a.y; x.u[2] = b.x; x.u[3] = b.y;
    return x.v;
}

#define XB_TMO      128
#define XB_XCNT(j)  (256  + 64 * (j))
#define XB_XSUB(j)  (1280 + 64 * (j))
#define XB_XGEN(j)  (2304 + 64 * (j))
#define XB_TOP      3328
#define XB_TOPGEN   3392
#define XCD_BAR_WORDS 3456
#define XB_SPIN_CAP (1u << 18)
#define LAS __attribute__((address_space(3)))
DEVI unsigned xb_ld(unsigned* p) { return __hip_atomic_load(p, __ATOMIC_RELAXED, __HIP_MEMORY_SCOPE_AGENT); }
DEVI unsigned xb_add(unsigned* p, unsigned v) { return __hip_atomic_fetch_add(p, v, __ATOMIC_RELAXED, __HIP_MEMORY_SCOPE_AGENT); }
DEVI unsigned xb_xcc_id() { return (unsigned)__builtin_amdgcn_s_getreg((3 << 11) | 20) & 0xFu; }
#define XB_SPIN(cond, bar) do { unsigned _sp = 0; while (cond) { __builtin_amdgcn_s_sleep(1); \
    if ((++_sp & 255u) == 0u) { if (xb_ld(&(bar)[XB_TMO])) break; if (_sp > XB_SPIN_CAP) { atomicAdd(&(bar)[XB_TMO], 1u); break; } } } } while (0)
struct XcdBarrier { unsigned* bar; unsigned x; volatile LAS unsigned* st; };
DEVI XcdBarrier xcd_barrier_post(unsigned* bar, volatile LAS unsigned* st) {
    XcdBarrier b; b.bar = bar; b.x = xb_xcc_id(); b.st = st;
    if (threadIdx.x == 0) (void)xb_add(&bar[XB_XCNT(b.x)], 1u);
    return b;
}
DEVI void xcd_barrier_complete(unsigned* bar, unsigned x, unsigned& nloc, unsigned& nx) {
    const unsigned G = gridDim.x * gridDim.y * gridDim.z;
    unsigned sum, cnt, mine, sp = 0u;
    for (;;) {
        sum = 0u; cnt = 0u; mine = 0u;
#pragma unroll
        for (unsigned j = 0; j < 16; ++j) { const unsigned c = xb_ld(&bar[XB_XCNT(j)]); sum += c; cnt += (c > 0u) ? 1u : 0u; mine = (j == x) ? c : mine; }
        if (sum == G) break;
        __builtin_amdgcn_s_sleep(1);
        if ((++sp & 255u) == 0u) { if (xb_ld(&bar[XB_TMO])) break; if (sp > XB_SPIN_CAP) { atomicAdd(&bar[XB_TMO], 1u); break; } }
    }
    nloc = mine > 0u ? mine : 1u; nx = cnt > 0u ? cnt : 1u;
}
DEVI void xcd_barrier(const XcdBarrier& b) {
    asm volatile("s_waitcnt vmcnt(0)" ::: "memory");
    __syncthreads();
    if (threadIdx.x == 0) {
        unsigned* bar = b.bar;
        __builtin_amdgcn_s_waitcnt(0);
        unsigned nloc = b.st[0], nx = b.st[1];
        if (nloc == 0u) { xcd_barrier_complete(bar, b.x, nloc, nx); b.st[0] = nloc; b.st[1] = nx; }
        const unsigned old = xb_add(&bar[XB_XSUB(b.x)], 1u);
        const unsigned gen = old / nloc;
        if (old + 1u == (gen + 1u) * nloc) {
            __builtin_amdgcn_fence(__ATOMIC_RELEASE, "agent");
            asm volatile("s_waitcnt vmcnt(0)" ::: "memory");
            const unsigned og = xb_add(&bar[XB_TOP], 1u);
            const unsigned tg = og / nx;
            if (og + 1u == (tg + 1u) * nx) xb_add(&bar[XB_TOPGEN], 1u);
            else XB_SPIN(xb_ld(&bar[XB_TOPGEN]) == tg, bar);
            __builtin_amdgcn_fence(__ATOMIC_ACQUIRE, "agent");
            xb_add(&bar[XB_XGEN(b.x)], 1u);
            asm volatile("s_waitcnt vmcnt(0)" ::: "memory");
        } else {
            XB_SPIN(xb_ld(&bar[XB_XGEN(b.x)]) == gen, bar);
            __builtin_amdgcn_fence(__ATOMIC_ACQUIRE, "agent");
            asm volatile("s_waitcnt vmcnt(0)" ::: "memory");
        }
    }
    __syncthreads();
}
template <bool TR, int NI, class RB>
DEVI void gemm_main(f32x4 (&acc)[4][NI], char* lds, RB rowbase, size_t hi, const bf16_t* Bt, int ldb, int nBmax, int m0, int n0, int K) {
    const int tid = tidx(), lane = tid & 63, wid = tid >> 6, wr = wid >> 1, wc = wid & 1, fr = lane & 15, fq = lane >> 4;
    const int c = tid & 7, r0 = tid >> 3;
    const bf16_t* ab[4];
    const bf16_t* bb[NI];
#pragma unroll
    for (int i = 0; i < 4; ++i) ab[i] = rowbase(m0 + r0 + i * 32) + c * 8;
#pragma unroll
    for (int i = 0; i < NI; ++i) {
        int nr = n0 + r0 + i * 32;
        if (nr > nBmax) nr = nBmax;
        bb[i] = Bt + (size_t)nr * ldb + c * 8;
    }
    uint4 ra[4], rb[NI];
    const int nk = K >> 6;
    const int lw = (c >> 2) * 8192 + r0 * 64 + (c & 3) * 16;
#pragma unroll
    for (int i = 0; i < 4; ++i) ra[i] = *(const uint4*)(ab[i]);
#pragma unroll
    for (int i = 0; i < NI; ++i) rb[i] = *(const uint4*)(bb[i]);
#pragma unroll
    for (int i = 0; i < 4; ++i) *(uint4*)(lds + lw + i * 2048) = ra[i];
#pragma unroll
    for (int i = 0; i < NI; ++i) *(uint4*)(lds + 16384 + lw + i * 2048) = rb[i];
    __syncthreads();
    for (int kt = 0; kt < nk; ++kt) {
        const int buf = kt & 1;
        if (kt + 1 < nk) {
            const size_t ao = (size_t)(kt + 1) * hi;
            const int bo = (kt + 1) * 64;
#pragma unroll
            for (int i = 0; i < 4; ++i) ra[i] = *(const uint4*)(ab[i] + ao);
#pragma unroll
            for (int i = 0; i < NI; ++i) rb[i] = *(const uint4*)(bb[i] + bo);
        }
        const char* la = lds + buf * 32768;
        const char* lb = la + 16384;
#pragma unroll
        for (int kp = 0; kp < 2; ++kp) {
            bf16x8 af[4], bf[NI];
#pragma unroll
            for (int i = 0; i < 4; ++i) af[i] = *(const bf16x8*)(la + kp * 8192 + (wr * 64 + i * 16 + fr) * 64 + fq * 16);
#pragma unroll
            for (int i = 0; i < NI; ++i) bf[i] = *(const bf16x8*)(lb + kp * 8192 + (wc * NI * 16 + i * 16 + fr) * 64 + fq * 16);
#pragma unroll
            for (int mi = 0; mi < 4; ++mi)
#pragma unroll
                for (int ni = 0; ni < NI; ++ni) acc[mi][ni] = TR ? mma(af[mi], bf[ni], acc[mi][ni]) : mma(bf[ni], af[mi], acc[mi][ni]);
        }
        if (kt + 1 < nk) {
            char* lwp = lds + (buf ^ 1) * 32768 + lw;
#pragma unroll
            for (int i = 0; i < 4; ++i) *(uint4*)(lwp + i * 2048) = ra[i];
#pragma unroll
            for (int i = 0; i < NI; ++i) *(uint4*)(lwp + 16384 + i * 2048) = rb[i];
        }
        __syncthreads();
    }
}
template <int NI>
DEVI void zero_acc(f32x4 (&acc)[4][NI]) {
#pragma unroll
    for (int i = 0; i < 4; ++i)
#pragma unroll
        for (int j = 0; j < NI; ++j) acc[i][j] = (f32x4){0.f, 0.f, 0.f, 0.f};
}
struct RowLin {
    const bf16_t* A; size_t lda;
    DEVI const bf16_t* operator()(int r) const { return A + (size_t)r * lda; }
};


template <bool TR>
DEVI void gemm2_main(f32x4 (&acc)[8][4], char* lds, const bf16_t* A, size_t lda, const bf16_t* Bt, int ldb, int nBmax, int m0, int n0, int K) {
    const int tid = tidx(), lane = tid & 63, wid = tid >> 6, wr = wid >> 1, wc = wid & 1, fr = lane & 15, fq = lane >> 4;
    const int c = tid & 3, r0 = tid >> 2;
    const bf16_t* ap = A + (size_t)(m0 + r0) * lda + c * 8;
    const bf16_t* bp0; const bf16_t* bp1;
    { int nr = n0 + r0; if (nr > nBmax) nr = nBmax; bp0 = Bt + (size_t)nr * ldb + c * 8; nr = n0 + r0 + 64; if (nr > nBmax) nr = nBmax; bp1 = Bt + (size_t)nr * ldb + c * 8; }
    const size_t a64 = (size_t)64 * lda;
    uint4 ra0, ra1, ra2, ra3, rb0, rb1;
    const int nk = K >> 5;
    const int lw = r0 * 64 + c * 16;
#define G2_LOAD(ko)                                                                                       \
    { ra0 = *(const uint4*)(ap + (ko)); ra1 = *(const uint4*)(ap + a64 + (ko)); ra2 = *(const uint4*)(ap + 2 * a64 + (ko)); \
      ra3 = *(const uint4*)(ap + 3 * a64 + (ko)); rb0 = *(const uint4*)(bp0 + (ko)); rb1 = *(const uint4*)(bp1 + (ko)); }
#define G2_STORE(st_)                                                                                     \
    { char* b_ = lds + (st_) * 24576 + lw; *(uint4*)(b_) = ra0; *(uint4*)(b_ + 4096) = ra1; *(uint4*)(b_ + 8192) = ra2; \
      *(uint4*)(b_ + 12288) = ra3; *(uint4*)(b_ + 16384) = rb0; *(uint4*)(b_ + 16384 + 4096) = rb1; }
    G2_LOAD(0);
    G2_STORE(0);
    __syncthreads();
    for (int kt = 0; kt < nk; ++kt) {
        const int st = kt & 1;
        if (kt + 1 < nk) G2_LOAD((kt + 1) * 32);
        const char* la = lds + st * 24576 + (wr * 128 + fr) * 64 + fq * 16;
        const char* lb = lds + st * 24576 + 16384 + (wc * 64 + fr) * 64 + fq * 16;
        bf16x8 bf[4];
#pragma unroll
        for (int i = 0; i < 4; ++i) bf[i] = *(const bf16x8*)(lb + i * 1024);
#pragma unroll
        for (int mi = 0; mi < 8; ++mi) {
            const bf16x8 af = *(const bf16x8*)(la + mi * 1024);
#pragma unroll
            for (int ni = 0; ni < 4; ++ni) acc[mi][ni] = TR ? mma(af, bf[ni], acc[mi][ni]) : mma(bf[ni], af, acc[mi][ni]);
        }
        if (kt + 1 < nk) G2_STORE(st ^ 1);
        __syncthreads();
    }
}

#define RAW_BARRIER() do { asm volatile("s_waitcnt lgkmcnt(0)" ::: "memory"); __builtin_amdgcn_s_barrier(); } while (0)
template <bool TR, int NI>
DEVI void gemm3_main(f32x4 (&acc)[8][NI], char* lds, const bf16_t* A, size_t lda, const bf16_t* Bt, int ldb, int nBmax, int m0, int n0, int K) {
    const int tid = tidx(), lane = tid & 63, wid = __builtin_amdgcn_readfirstlane(tid >> 6), wr = wid >> 1, wc = wid & 1, fr = lane & 15, fq = lane >> 4;
    const int c = tid & 3, r0 = tid >> 2;
    const bf16_t* ap = A + (size_t)(m0 + r0) * lda + c * 8;
    const bf16_t* bp0; const bf16_t* bp1;
    { int nr = n0 + r0; if (nr > nBmax) nr = nBmax; bp0 = Bt + (size_t)nr * ldb + c * 8; nr = n0 + r0 + 64; if (nr > nBmax) nr = nBmax; bp1 = Bt + (size_t)nr * ldb + c * 8; }
    const size_t a64 = (size_t)64 * lda;
    const int nk = K >> 5;
#define G3_ISSUE(kt_, st_)                                                                                                   \
    { char* d_ = lds + (st_) * 24576 + wid * 1024; const int ko_ = (kt_) * 32;                                               \
      __builtin_amdgcn_global_load_lds((const unsigned*)(ap + ko_), (unsigned*)(d_), 16, 0, 0);                               \
      __builtin_amdgcn_global_load_lds((const unsigned*)(ap + a64 + ko_), (unsigned*)(d_ + 4096), 16, 0, 0);                  \
      __builtin_amdgcn_global_load_lds((const unsigned*)(ap + 2 * a64 + ko_), (unsigned*)(d_ + 8192), 16, 0, 0);              \
      __builtin_amdgcn_global_load_lds((const unsigned*)(ap + 3 * a64 + ko_), (unsigned*)(d_ + 12288), 16, 0, 0);             \
      __builtin_amdgcn_global_load_lds((const unsigned*)(bp0 + ko_), (unsigned*)(d_ + 16384), 16, 0, 0);                      \
      if (NI == 4) __builtin_amdgcn_global_load_lds((const unsigned*)(bp1 + ko_), (unsigned*)(d_ + 20480), 16, 0, 0); }
    G3_ISSUE(0, 0);
    G3_ISSUE(1, 1);
    int st = 0;
    for (int kt = 0; kt < nk; ++kt) {
        if (kt + 1 < nk) { if (NI == 4) asm volatile("s_waitcnt vmcnt(6)" ::: "memory"); else asm volatile("s_waitcnt vmcnt(5)" ::: "memory"); }
        else asm volatile("s_waitcnt vmcnt(0)" ::: "memory");
        RAW_BARRIER();
        if (kt + 2 < nk) { const int s2 = st >= 1 ? st - 1 : 2; G3_ISSUE(kt + 2, s2); }
        const char* la = lds + st * 24576 + (wr * 128 + fr) * 64 + fq * 16;
        const char* lb = lds + st * 24576 + 16384 + (wc * NI * 16 + fr) * 64 + fq * 16;
        bf16x8 bf[NI];
#pragma unroll
        for (int i = 0; i < NI; ++i) bf[i] = *(const bf16x8*)(lb + i * 1024);
        __builtin_amdgcn_s_setprio(1);
#pragma unroll
        for (int mi = 0; mi < 8; ++mi) {
            const bf16x8 af = *(const bf16x8*)(la + mi * 1024);
#pragma unroll
            for (int ni = 0; ni < NI; ++ni) acc[mi][ni] = TR ? mma(af, bf[ni], acc[mi][ni]) : mma(bf[ni], af, acc[mi][ni]);
        }
        __builtin_amdgcn_s_setprio(0);
        st = st == 2 ? 0 : st + 1;
    }
    RAW_BARRIER();
}
DEVI void zero_acc2(f32x4 (&acc)[8][4]) {
#pragma unroll
    for (int i = 0; i < 8; ++i)
#pragma unroll
        for (int j = 0; j < 4; ++j) acc[i][j] = (f32x4){0.f, 0.f, 0.f, 0.f};
}
DEVI void rmsnorm_rows(const Params& p, int item) {
    const int thr_ = tidx();
    const int lane = thr_ & 63, wid = thr_ >> 6;
    const int row = item * 4 + wid;
    const float* xr = p.x + (size_t)row * DM;
    f32x4 v[8];
    float ss = 0.f;
#pragma unroll
    for (int i = 0; i < 8; ++i) { v[i] = *(const f32x4*)(xr + (i >> 1) * 512 + lane * 8 + (i & 1) * 4); ss += v[i][0] * v[i][0] + v[i][1] * v[i][1] + v[i][2] * v[i][2] + v[i][3] * v[i][3]; }
    ss = wave_sum(ss);
    const float rs = rsqrtf(ss * (1.f / DM) + 1e-6f);
    bf16_t* hr = (bf16_t*)(p.ws + O_H) + (size_t)row * DM;
#pragma unroll
    for (int i = 0; i < 8; i += 2) {
        const f32x4 g0 = *(const f32x4*)(p.pre_g + (i >> 1) * 512 + lane * 8), g1 = *(const f32x4*)(p.pre_g + (i >> 1) * 512 + lane * 8 + 4);
        *(uint4*)(hr + (i >> 1) * 512 + lane * 8) = make_uint4(pk2(v[i][0] * rs * g0[0], v[i][1] * rs * g0[1]), pk2(v[i][2] * rs * g0[2], v[i][3] * rs * g0[3]),
                                                            pk2(v[i + 1][0] * rs * g1[0], v[i + 1][1] * rs * g1[1]), pk2(v[i + 1][2] * rs * g1[2], v[i + 1][3] * rs * g1[3]));
    }
}
struct TJob { const float* src; bf16_t* dst; int K, ld, width; };
DEVI bool tjob(const Params& p, int j, TJob& t) {
    char* ws = p.ws;
    bf16_t* wint = (bf16_t*)(ws + O_WINT);
    switch (j) {
        case 0: t = {p.w_in, wint, 2048, DIN, 4096}; return true;
        case 1: t = {p.w_in + 4104, wint + (size_t)4096 * 2048, 2048, DIN, 2560}; return true;
        case 2: t = {p.w_in + 6712, wint + (size_t)6656 * 2048, 2048, DIN, 5120}; return true;
        case 3: t = {p.w_in + 4096, wint + (size_t)11776 * 2048, 2048, DIN, 8}; return true;
        case 4: t = {p.w_in + 6664, wint + (size_t)11784 * 2048, 2048, DIN, 48}; return true;
        case 5: t = {nullptr, wint + (size_t)11832 * 2048, 2048, DIN, 72}; return true;
        case 6: t = {p.w_up_m, (bf16_t*)(ws + O_WUM), 1024, 2048, 2048}; return true;
        case 7: t = {p.w_up_a, (bf16_t*)(ws + O_WUA), 1024, 2048, 2048}; return true;
        case 8: t = {p.w_out, (bf16_t*)(ws + O_WOUT), 2048, 2048, 2048}; return true;
        case 9: case 10: case 11: case 12: t = {p.w_q + (j - 9) * 65536, (bf16_t*)(ws + O_WQ) + (j - 9) * 65536, 256, 256, 256}; return true;
        case 13: case 14: case 15: case 16: t = {p.w_k + (j - 13) * 65536, (bf16_t*)(ws + O_WK) + (j - 13) * 65536, 256, 256, 256}; return true;
        case 17: t = {p.w1_k, (bf16_t*)(ws + O_W1K), 2048, 256, 256}; return true;
        case 18: t = {p.w1_v, (bf16_t*)(ws + O_W1V), 2048, 256, 256}; return true;
        case 19: t = {p.w2_k, (bf16_t*)(ws + O_W2K), 256, 64, 64}; return true;
        case 20: t = {p.w2_v, (bf16_t*)(ws + O_W2V), 256, 64, 64}; return true;
        default: return false;
    }
}
constexpr int N_TJOBS = 21;
constexpr int N_TTILES = 4264;
DEVI void transpose_item(const Params& p, int item, char* lds) {
    const int thr_ = tidx();
    TJob t;
    int j = 0;
    for (; j < N_TJOBS; ++j) {
        tjob(p, j, t);
        const int cnt = (t.K >> 6) * ((t.width + 127) >> 7);
        if (item < cnt) break;
        item -= cnt;
    }
    if (j >= N_TJOBS) return;
    const int tk = t.K >> 6;
    const int kt = item % tk, nt = item / tk;
    const int lane = thr_ & 63, wid = thr_ >> 6, kg = lane >> 3, nc = lane & 7;
    const int k0 = kt * 64 + kg * 8, n = nt * 128 + wid * 32 + nc * 4;
    if (n >= t.width) return;
    f32x4 v[8];
    if (t.src) {
        const float* sp = t.src + (size_t)k0 * t.ld + n;
#pragma unroll
        for (int r = 0; r < 8; ++r) v[r] = *(const f32x4*)(sp + (size_t)r * t.ld);
    } else {
#pragma unroll
        for (int r = 0; r < 8; ++r) v[r] = (f32x4){0.f, 0.f, 0.f, 0.f};
    }
    bf16_t* d = t.dst + (size_t)n * t.K + k0;
#pragma unroll
    for (int jj = 0; jj < 4; ++jj)
        *(uint4*)(d + (size_t)jj * t.K) = make_uint4(pk2(v[0][jj], v[1][jj]), pk2(v[2][jj], v[3][jj]), pk2(v[4][jj], v[5][jj]), pk2(v[6][jj], v[7][jj]));
}
DEVI void bias_item(const Params& p, int item) {
    const int thr_ = tidx();
    const int kv = item >> 4, seg = item & 15, j = thr_;
    const float* pe = kv ? p.pe_v : p.pe_k;
    const float* w1 = kv ? p.w1_v : p.w1_k;
    float a = 0.f;
#pragma unroll 8
    for (int k = seg * 128; k < seg * 128 + 128; ++k) a += pe[k] * w1[(size_t)k * 256 + j];
    ((float*)(p.ws + O_B1P))[(kv * 16 + seg) * 256 + j] = a;
}

DEVI void inproj_tile(const Params& p, int item, char* lds) {
    const int ni_ = item >> 5, mt = item & 31;
    const int nt = ni_ < 4 ? 40 + ni_ : (ni_ < 44 ? ni_ - 4 : ni_);
    const int m0 = mt * 256, n0 = nt * 128;
    const bool tr = (nt >= 8 && nt < 16) || nt == 46 || nt == 47 || nt == 50 || nt == 51;
    const int tid = tidx(), lane = tid & 63, wid = tid >> 6, wr = wid >> 1, wc = wid & 1, fr = lane & 15, fq = lane >> 4;
    f32x4 acc[8][4];
    zero_acc2(acc);
    const bf16_t* A = (const bf16_t*)(p.ws + O_H);
    const bf16_t* Bt = (const bf16_t*)(p.ws + O_WINT);
    if (tr) {
        gemm3_main<true, 4>(acc, lds, A, DM, Bt, DM, NP - 1, m0, n0, DM);
        bf16_t* base; int cb, ncol;
        if (nt < 16) { base = (bf16_t*)(p.ws + O_VMT); cb = C_MV; ncol = 1024; }
        else if (nt < 48) { base = (bf16_t*)(p.ws + O_VST); cb = C_VS; ncol = 256; }
        else { base = (bf16_t*)(p.ws + O_VWT); cb = C_VW; ncol = 256; }
#pragma unroll
        for (int mi = 0; mi < 8; mi += 2)
#pragma unroll
            for (int ni = 0; ni < 4; ++ni) {
                const int row = m0 + wr * 128 + (mi + (fq & 1)) * 16 + (fq >> 1) * 8, col = n0 + wc * 64 + ni * 16 + fr - cb;
                const int b = row >> 11, s_ = row & 2047;
                uint2 x, y;
                x.x = pk2(acc[mi][ni][0], acc[mi][ni][1]); x.y = pk2(acc[mi][ni][2], acc[mi][ni][3]);
                y.x = pk2(acc[mi + 1][ni][0], acc[mi + 1][ni][1]); y.y = pk2(acc[mi + 1][ni][2], acc[mi + 1][ni][3]);
                store_nt16(base + ((size_t)(b * ncol + col)) * S + s_, pair16(x, y));
            }
    } else {
        gemm3_main<false, 4>(acc, lds, A, DM, Bt, DM, NP - 1, m0, n0, DM);
        if (n0 == C_GATE) {
            float* G = (float*)(p.ws + O_G);
#pragma unroll
            for (int mi = 0; mi < 8; ++mi)
#pragma unroll
                for (int ni = 0; ni < 4; ++ni) {
                    const int row = m0 + wr * 128 + mi * 16 + fr, cl = wc * 64 + ni * 16 + fq * 4;
                    if (cl < 56) *(f32x4*)(G + (size_t)row * 64 + cl) = acc[mi][ni];
                }
        } else {
            bf16_t* P = (bf16_t*)(p.ws + O_P);
#pragma unroll
            for (int mi = 0; mi < 8; ++mi)
#pragma unroll
                for (int ni = 0; ni < 4; ni += 2) {
                    const int row = m0 + wr * 128 + mi * 16 + fr, col = n0 + wc * 64 + (ni + (fq & 1)) * 16 + (fq >> 1) * 8;
                    uint2 x, y;
                    x.x = pk2(acc[mi][ni][0], acc[mi][ni][1]); x.y = pk2(acc[mi][ni][2], acc[mi][ni][3]);
                    y.x = pk2(acc[mi][ni + 1][0], acc[mi][ni + 1][1]); y.y = pk2(acc[mi][ni + 1][2], acc[mi][ni + 1][3]);
                    store_nt16(P + (size_t)row * NPS + col, pair16(x, y));
                }
        }
    }
    if (ni_ < 4) {
        asm volatile("s_waitcnt vmcnt(0)" ::: "memory");
        __syncthreads();
        if (threadIdx.x == 0) {
            __builtin_amdgcn_fence(__ATOMIC_RELEASE, "agent");
            asm volatile("s_waitcnt vmcnt(0)" ::: "memory");
            xb_add((unsigned*)(p.ws + O_BAR) + 0, 1u);
        }
    }
}

DEVI void conv_item(const Params& p, int item) {
    const int thr_ = tidx();
    const int tok0 = item * 8 + (thr_ >> 7) * 4, c = (thr_ & 127) * 8;
    const int s0 = tok0 & 2047;
    const bf16_t* P = (const bf16_t*)(p.ws + O_P);
    uint4 xr[7];
#pragma unroll
    for (int j = 0; j < 7; ++j) {
        xr[j] = make_uint4(0u, 0u, 0u, 0u);
        if (s0 + j - 3 >= 0) xr[j] = *(const uint4*)(P + (size_t)(tok0 + j - 3) * NPS + C_MX + c);
    }
    f32x4 w[4][2];
#pragma unroll
    for (int k = 0; k < 4; ++k) { w[k][0] = *(const f32x4*)(p.conv_w + k * 1024 + c); w[k][1] = *(const f32x4*)(p.conv_w + k * 1024 + c + 4); }
    const f32x4 b0 = *(const f32x4*)(p.conv_b + c), b1 = *(const f32x4*)(p.conv_b + c + 4);
#pragma unroll
    for (int t = 0; t < 4; ++t) {
        f32x4 a0 = b0, a1 = b1;
#pragma unroll
        for (int k = 0; k < 4; ++k) {
            const uint4 xv = xr[t + k];
            a0 += (f32x4){lo16(xv.x), hi16(xv.x), lo16(xv.y), hi16(xv.y)} * w[k][0];
            a1 += (f32x4){lo16(xv.z), hi16(xv.z), lo16(xv.w), hi16(xv.w)} * w[k][1];
        }
        *(uint4*)((bf16_t*)(p.ws + O_XC) + (size_t)(tok0 + t) * 1024 + c) =
            make_uint4(pk2(silu(a0[0]), silu(a0[1])), pk2(silu(a0[2]), silu(a0[3])), pk2(silu(a1[0]), silu(a1[1])), pk2(silu(a1[2]), silu(a1[3])));
    }
}
struct RowCmp {
    const bf16_t* Pc;
    DEVI const bf16_t* operator()(int r) const {
        if (r > 2031) r = 2031;
        const int bg = r / 127, n = r - bg * 127, b = bg >> 2, g = bg & 3;
        return Pc + (size_t)(b * S + 16 * n) * NPS + g * 64;
    }
};
DEVI void cmp1_tile(const Params& p, int item, char* lds) {
    const int kv = item >> 5, mt = (item >> 1) & 15, nt = item & 1;
    const int m0 = mt * 128, n0 = nt * 128;
    const int tid = tidx(), lane = tid & 63, wid = tid >> 6, wr = wid >> 1, wc = wid & 1, fr = lane & 15, fq = lane >> 4;
    f32x4 acc[4][4];
    zero_acc(acc);
    RowCmp rc{(const bf16_t*)(p.ws + O_P) + (kv ? C_VC : C_KC)};
    gemm_main<false, 4>(acc, lds, rc, (size_t)NPS, (const bf16_t*)(p.ws + (kv ? O_W1V : O_W1K)), 2048, 255, m0, n0, 2048);
    const float* bp = (const float*)(p.ws + O_B1P) + kv * 16 * 256;
    bf16_t* HC = (bf16_t*)(p.ws + O_HC) + (size_t)kv * 2048 * 256;
#pragma unroll
    for (int ni = 0; ni < 4; ++ni) {
        const int col = n0 + wc * 64 + ni * 16 + fq * 4;
        f32x4 bs = {0.f, 0.f, 0.f, 0.f};
        for (int sg = 0; sg < 16; ++sg) bs += *(const f32x4*)(bp + sg * 256 + col);
#pragma unroll
        for (int mi = 0; mi < 4; ++mi) {
            const int row = m0 + wr * 64 + mi * 16 + fr;
            const f32x4 v = acc[mi][ni] + bs;
            uint2 o; o.x = pk2(silu(v[0]), silu(v[1])); o.y = pk2(silu(v[2]), silu(v[3]));
            *(uint2*)(HC + (size_t)row * 256 + col) = o;
        }
    }
}
DEVI void scan_item(const Params& p, int item, char* lds) {
    const int thr_ = tidx();
    const int b = item >> 2, h = item & 3, tid = thr_;
    const float* G = (const float*)(p.ws + O_G);
    float* red = (float*)lds;
    const float bi = p.b_i[h], bfv = p.b_f[h];
    float ig[8], F[8];
    float run = 0.f;
#pragma unroll
    for (int i = 0; i < 8; ++i) {
        const size_t tok = (size_t)b * S + tid * 8 + i;
        ig[i] = G[tok * 64 + h] + bi;
        const float fg = G[tok * 64 + 4 + h] + bfv;
        const float lf = fminf(fg, 0.f) - log1pf(expf(-fabsf(fg)));
        run += lf;
        F[i] = run;
    }
    red[tid] = run;
    __syncthreads();
    float ex = 0.f;
    for (int j = 0; j < tid; ++j) ex += red[j];
    __syncthreads();
    float a[8], mx[8];
    float rm = -1e30f;
#pragma unroll
    for (int i = 0; i < 8; ++i) { F[i] += ex; a[i] = ig[i] - F[i]; rm = fmaxf(rm, a[i]); mx[i] = rm; }
    red[tid] = rm;
    __syncthreads();
    float em = -1e30f;
    for (int j = 0; j < tid; ++j) em = fmaxf(em, red[j]);
    __syncthreads();
    float* FA = (float*)(p.ws + O_FA) + item * S + tid * 8;
    float* FM = (float*)(p.ws + O_FM) + item * S + tid * 8;
    float* FL = (float*)(p.ws + O_FL) + item * S + tid * 8;
#pragma unroll
    for (int i = 0; i < 8; ++i) { const float m = fmaxf(mx[i], em); FA[i] = a[i]; FM[i] = m; FL[i] = F[i] + m; }
}

DEVI void qk_tile(const Params& p, int item, char* lds) {
    const int nt = item & 1, mt = (item >> 1) & 63, h = (item >> 7) & 3, qk = item >> 9;
    const int m0 = mt * 128, n0 = nt * 128;
    const int tid = tidx(), lane = tid & 63, wid = tid >> 6, wr = wid >> 1, wc = wid & 1, fr = lane & 15, fq = lane >> 4;
    f32x4 acc[4][4];
    zero_acc(acc);
    RowLin rl{(const bf16_t*)(p.ws + O_XC) + h * 256, (size_t)1024};
    gemm_main<false, 4>(acc, lds, rl, 64, (const bf16_t*)(p.ws + (qk ? O_WK : O_WQ)) + h * 65536, 256, 255, m0, n0, 256);
    bf16_t* O = (bf16_t*)(p.ws + (qk ? O_KM : O_QM));
    const float sc = qk ? 0.0625f : 1.f;
#pragma unroll
    for (int mi = 0; mi < 4; ++mi)
#pragma unroll
        for (int ni = 0; ni < 4; ni += 2) {
            const int row = m0 + wr * 64 + mi * 16 + fr, col = h * 256 + n0 + wc * 64 + (ni + (fq & 1)) * 16 + (fq >> 1) * 8;
            uint2 x, y;
            x.x = pk2(acc[mi][ni][0] * sc, acc[mi][ni][1] * sc); x.y = pk2(acc[mi][ni][2] * sc, acc[mi][ni][3] * sc);
            y.x = pk2(acc[mi][ni + 1][0] * sc, acc[mi][ni + 1][1] * sc); y.y = pk2(acc[mi][ni + 1][2] * sc, acc[mi][ni + 1][3] * sc);
            *(uint4*)(O + (size_t)row * 1024 + col) = pair16(x, y);
        }
}
DEVI void cmp2_tile(const Params& p, int item, char* lds) {
    const int kv = item >> 4, mt = item & 15, m0 = mt * 128;
    const int tid = tidx(), lane = tid & 63, wid = tid >> 6, wr = wid >> 1, wc = wid & 1, fr = lane & 15, fq = lane >> 4;
    f32x4 acc[4][4];
    zero_acc(acc);
    RowLin rl{(const bf16_t*)(p.ws + O_HC) + (size_t)kv * 2048 * 256, (size_t)256};
    gemm_main<false, 4>(acc, lds, rl, 64, (const bf16_t*)(p.ws + (kv ? O_W2V : O_W2K)), 256, 63, m0, 0, 256);
    float* O = (float*)(p.ws + (kv ? O_VCF : O_KCF));
    if (wc == 0) {
#pragma unroll
        for (int mi = 0; mi < 4; ++mi)
#pragma unroll
            for (int ni = 0; ni < 4; ++ni) {
                const int row = m0 + wr * 64 + mi * 16 + fr, col = ni * 16 + fq * 4;
                if (row < 2032) *(f32x4*)(O + (size_t)row * 64 + col) = acc[mi][ni];
            }
    }
}

DEVI void mlstm_item(const Params& p, int item) {
    const int thr_ = tidx();
    const int qb = 31 - (item >> 4), bh = item & 15, b = bh >> 2, h = bh & 3;
    const int lane = thr_ & 63, wid = __builtin_amdgcn_readfirstlane(thr_ >> 6), fr = lane & 15, fq = lane >> 4;
    const int t0 = qb * 64 + wid * 16, trow = t0 + fr;
    const bf16_t* Qm = (const bf16_t*)(p.ws + O_QM);
    const bf16_t* Km = (const bf16_t*)(p.ws + O_KM);
    const bf16_t* VmT = (const bf16_t*)(p.ws + O_VMT);
    const float* fa = (const float*)(p.ws + O_FA) + bh * S;
    const float mx = ((const float*)(p.ws + O_FM))[bh * S + trow];
    bf16x8 qf[8];
    {
        const bf16_t* qrow = Qm + (size_t)(b * S + trow) * 1024 + h * 256 + fq * 8;
#pragma unroll
        for (int ks = 0; ks < 8; ++ks) qf[ks] = *(const bf16x8*)(qrow + ks * 32);
    }
    f32x4 o[16];
#pragma unroll
    for (int i = 0; i < 16; ++i) o[i] = (f32x4){0.f, 0.f, 0.f, 0.f};
    float den = 0.f;
    const bf16_t* kbase = Km + (size_t)(b * S + fr) * 1024 + h * 256 + fq * 8;
    const bf16_t* vbase = VmT + ((size_t)(b * 1024 + h * 256 + fr)) * S + fq * 4;
    for (int s0 = 0; s0 < t0 + 16; s0 += 32) {
        f32x4 sa = {0.f, 0.f, 0.f, 0.f}, sb = {0.f, 0.f, 0.f, 0.f};
        const bf16_t* k0 = kbase + (size_t)s0 * 1024;
        const bf16_t* k1 = k0 + 16 * 1024;
#pragma unroll
        for (int ks = 0; ks < 8; ++ks) {
            sa = mma(*(const bf16x8*)(k0 + ks * 32), qf[ks], sa);
            sb = mma(*(const bf16x8*)(k1 + ks * 32), qf[ks], sb);
            if (ks == 3) __builtin_amdgcn_sched_barrier(0);
        }
        __builtin_amdgcn_sched_barrier(0);
        const f32x4 a0 = *(const f32x4*)(fa + s0 + fq * 4), a1 = *(const f32x4*)(fa + s0 + 16 + fq * 4);
        float pv[8];
#pragma unroll
        for (int r = 0; r < 4; ++r) {
            const int s = s0 + fq * 4 + r;
            const float w0 = (s <= trow) ? __expf(a0[r] - mx) : 0.f;
            const float w1 = (s + 16 <= trow) ? __expf(a1[r] - mx) : 0.f;
            pv[r] = sa[r] * w0; pv[4 + r] = sb[r] * w1;
            den += pv[r] + pv[4 + r];
        }
        const bf16x8 pf = pack8(pv);
#pragma unroll
        for (int dvt = 0; dvt < 16; ++dvt) {
            const bf16_t* vp = vbase + (size_t)(dvt * 16) * S + s0;
            const bf16x8 vf = join8(*(const uint2*)vp, *(const uint2*)(vp + 16));
            o[dvt] = mma(vf, pf, o[dvt]);
            if ((dvt & 3) == 3) __builtin_amdgcn_sched_barrier(0);
        }
    }
    den += __shfl_xor(den, 16);
    den += __shfl_xor(den, 32);
    const float lower = __expf(-((const float*)(p.ws + O_FL))[bh * S + trow]);
    const float inv = 1.f / fmaxf(fabsf(den), lower);
    const bf16_t* Prow = (const bf16_t*)(p.ws + O_P) + (size_t)(b * S + trow) * NPS;
    float sum = 0.f;
#pragma unroll
    for (int dvt = 0; dvt < 16; ++dvt) {
        const int c = h * 256 + dvt * 16 + fq * 4;
        const uint2 op = *(const uint2*)(Prow + C_MO + c);
        o[dvt][0] *= inv * sigm(lo16(op.x)); o[dvt][1] *= inv * sigm(hi16(op.x)); o[dvt][2] *= inv * sigm(lo16(op.y)); o[dvt][3] *= inv * sigm(hi16(op.y));
        sum += o[dvt][0] + o[dvt][1] + o[dvt][2] + o[dvt][3];
    }
    sum += __shfl_xor(sum, 16);
    sum += __shfl_xor(sum, 32);
    const float mu = sum * (1.f / 256.f);
    float vs = 0.f;
#pragma unroll
    for (int dvt = 0; dvt < 16; ++dvt)
#pragma unroll
        for (int r = 0; r < 4; ++r) { const float d = o[dvt][r] - mu; vs += d * d; }
    vs += __shfl_xor(vs, 16);
    vs += __shfl_xor(vs, 32);
    const float rstd = rsqrtf(vs * (1.f / 256.f) + 1e-6f);
    const bf16_t* xcrow = (const bf16_t*)(p.ws + O_XC) + (size_t)(b * S + trow) * 1024;
    bf16_t* ymrow = (bf16_t*)(p.ws + O_YM) + (size_t)(b * S + trow) * 1024;
#pragma unroll
    for (int dvt = 0; dvt < 16; ++dvt) {
        const int c = h * 256 + dvt * 16 + fq * 4;
        const f32x4 ng = *(const f32x4*)(p.norm_g + c), sk = *(const f32x4*)(p.skip + c);
        const uint2 xc = *(const uint2*)(xcrow + c), mz = *(const uint2*)(Prow + C_MZ + c);
        const float y0 = ((o[dvt][0] - mu) * rstd * ng[0] + sk[0] * lo16(xc.x)) * silu(lo16(mz.x));
        const float y1 = ((o[dvt][1] - mu) * rstd * ng[1] + sk[1] * hi16(xc.x)) * silu(hi16(mz.x));
        const float y2 = ((o[dvt][2] - mu) * rstd * ng[2] + sk[2] * lo16(xc.y)) * silu(lo16(mz.y));
        const float y3 = ((o[dvt][3] - mu) * rstd * ng[3] + sk[3] * hi16(xc.y)) * silu(hi16(mz.y));
        uint2 ov; ov.x = pk2(y0, y1); ov.y = pk2(y2, y3);
        *(uint2*)(ymrow + c) = ov;
    }
}

DEVI void cmp_item(const Params& p, int item, char* lds) {
    const int thr_ = tidx();
    const int tt = item & 31, bg = item >> 5, b = bg >> 2, g = bg & 3;
    const int lane = thr_ & 63, wid = __builtin_amdgcn_readfirstlane(thr_ >> 6);
    float* kcs = (float*)lds;
    float* psum = (float*)(lds + 33280) + wid * 128;
    const float* KC = (const float*)(p.ws + O_KCF) + (size_t)bg * 127 * 64;
    const float* VC = (const float*)(p.ws + O_VCF) + (size_t)bg * 127 * 64;
    for (int i = thr_; i < 127 * 64; i += 256) kcs[(i >> 6) * 65 + (i & 63)] = KC[i];
    __syncthreads();
    const bf16_t* P = (const bf16_t*)(p.ws + O_P);
    bf16_t* OC = (bf16_t*)(p.ws + O_OC);
    unsigned* SEL = (unsigned*)(p.ws + O_SEL);
#pragma unroll 1
    for (int i = 0; i < 16; ++i) {
        const int t = tt * 64 + wid * 16 + i;
        const size_t tok = (size_t)b * S + t;
        const int nvalid = t >= 31 ? ((t - 31) >> 4) + 1 : 0;
        unsigned mask = 1u;
        if (nvalid == 0) {
#pragma unroll
            for (int h = 0; h < 4; ++h) OC[tok * 1024 + (g * 4 + h) * 64 + lane] = 0;
        } else {
            float qh[4];
#pragma unroll
            for (int h = 0; h < 4; ++h) qh[h] = bf2f(P[tok * NPS + C_AQ + (g * 4 + h) * 64 + lane]) * 0.125f;
            float s0[4] = {0.f, 0.f, 0.f, 0.f}, s1[4] = {0.f, 0.f, 0.f, 0.f};
            const int n1 = lane + 64 > 126 ? 126 : lane + 64;
            const float* k0p = kcs + lane * 65;
            const float* k1p = kcs + n1 * 65;
#pragma unroll
            for (int d = 0; d < 64; ++d) {
                const float k0 = k0p[d], k1 = k1p[d];
#pragma unroll
                for (int h = 0; h < 4; ++h) { const float qd = rdlane(qh[h], d); s0[h] += qd * k0; s1[h] += qd * k1; }
            }
            const bool v0 = lane < nvalid, v1 = lane + 64 < nvalid;
            float p0[4], p1[4];
#pragma unroll
            for (int h = 0; h < 4; ++h) {
                const float mxv = wave_max(fmaxf(v0 ? s0[h] : -1e30f, v1 ? s1[h] : -1e30f));
                const float e0 = v0 ? __expf(s0[h] - mxv) : 0.f, e1 = v1 ? __expf(s1[h] - mxv) : 0.f;
                const float sm = wave_sum(e0 + e1);
                const float is = 1.f / sm;
                p0[h] = e0 * is; p1[h] = e1 * is;
            }
            float oc[4] = {0.f, 0.f, 0.f, 0.f};
            const int na = nvalid < 64 ? nvalid : 64;
            for (int n = 0; n < na; ++n) {
                const float vv = VC[n * 64 + lane];
#pragma unroll
                for (int h = 0; h < 4; ++h) oc[h] += rdlane(p0[h], n) * vv;
            }
            for (int n = 64; n < nvalid; ++n) {
                const float vv = VC[n * 64 + lane];
#pragma unroll
                for (int h = 0; h < 4; ++h) oc[h] += rdlane(p1[h], n - 64) * vv;
            }
#pragma unroll
            for (int h = 0; h < 4; ++h) OC[tok * 1024 + (g * 4 + h) * 64 + lane] = f2bf(oc[h]);
            psum[lane] = p0[0] + p0[1] + p0[2] + p0[3];
            psum[lane + 64] = (lane + 64 < 127) ? (p1[0] + p1[1] + p1[2] + p1[3]) : 0.f;
            __builtin_amdgcn_wave_barrier();
            float sc = -3e30f;
            const int cur = t >> 6;
            if (lane < 32) {
                float imp = 0.f;
#pragma unroll
                for (int k = -1; k < 4; ++k) { const int n = 4 * lane + k; if (n >= 0) imp += psum[n]; }
                const bool forced = lane == 0 || lane == cur || lane == cur - 1;
                sc = forced ? 1e30f : (lane <= cur ? imp : -1e30f);
            }
            __builtin_amdgcn_wave_barrier();
            mask = 0u;
#pragma unroll 1
            for (int it = 0; it < 8; ++it) {
                const float mv = wave_max(sc);
                const unsigned long long bal = __ballot(sc == mv);
                const int win = __ffsll((long long)bal) - 1;
                mask |= 1u << win;
                if (lane == win) sc = -4e30f;
            }
        }
        if (lane == 0) SEL[bg * S + t] = mask;
    }
    __syncthreads();
}

DEVI void attn_chunk(f32x4 (&o)[4], float& m, float& l, bf16x8 q0, bf16x8 q1, const bf16_t* kp, const bf16_t* vp, unsigned vm) {
    f32x4 sa = {0.f, 0.f, 0.f, 0.f}, sb = {0.f, 0.f, 0.f, 0.f};
    sa = mma(*(const bf16x8*)(kp), q0, sa);
    sa = mma(*(const bf16x8*)(kp + 32), q1, sa);
    sb = mma(*(const bf16x8*)(kp + (size_t)16 * NPS), q0, sb);
    sb = mma(*(const bf16x8*)(kp + (size_t)16 * NPS + 32), q1, sb);
    float v[8];
#pragma unroll
    for (int r = 0; r < 4; ++r) { v[r] = sa[r] * 0.125f; v[4 + r] = sb[r] * 0.125f; }
    float mxv = -1e30f;
#pragma unroll
    for (int e = 0; e < 8; ++e) if ((vm >> e) & 1u) mxv = fmaxf(mxv, v[e]);
    mxv = fmaxf(mxv, __shfl_xor(mxv, 16));
    mxv = fmaxf(mxv, __shfl_xor(mxv, 32));
    const float mn = fmaxf(m, mxv);
    const float alpha = __expf(m - mn);
    m = mn;
    float ps = 0.f;
#pragma unroll
    for (int e = 0; e < 8; ++e) { v[e] = ((vm >> e) & 1u) ? __expf(v[e] - mn) : 0.f; ps += v[e]; }
    l = l * alpha + ps;
    const bf16x8 pf = pack8(v);
#pragma unroll
    for (int dvt = 0; dvt < 4; ++dvt) {
        o[dvt] *= alpha;
        const bf16_t* vq = vp + (size_t)(dvt * 16) * S;
        const bf16x8 vf = join8(*(const uint2*)vq, *(const uint2*)(vq + 16));
        o[dvt] = mma(vf, pf, o[dvt]);
    }
}
template <bool SELB>
DEVI void nsa_item(const Params& p, int item) {
    const int thr_ = tidx();
    const int tile = item & 127, bg = item >> 7, b = bg >> 2, g = bg & 3;
    const int lane = thr_ & 63, wid = __builtin_amdgcn_readfirstlane(thr_ >> 6), fr = lane & 15, fq = lane >> 4;
    const int hd = g * 4 + wid, t0 = tile * 16, trow = t0 + fr;
    const bf16_t* P = (const bf16_t*)(p.ws + O_P);
    const size_t tok = (size_t)b * S + trow;
    const bf16_t* qp = P + tok * NPS + C_AQ + hd * 64 + fq * 8;
    const bf16x8 q0 = *(const bf16x8*)qp, q1 = *(const bf16x8*)(qp + 32);
    const bf16_t* kb = P + (size_t)(b * S + fr) * NPS + (SELB ? C_KS : C_KW) + g * 64 + fq * 8;
    const bf16_t* vb = (const bf16_t*)(p.ws + (SELB ? O_VST : O_VWT)) + (size_t)(b * 256 + g * 64 + fr) * S + fq * 4;
    f32x4 o[4];
#pragma unroll
    for (int i = 0; i < 4; ++i) o[i] = (f32x4){0.f, 0.f, 0.f, 0.f};
    float m = -1e30f, l = 0.f;
    if (!SELB) {
        int lo = t0 - 511;
        if (lo < 0) lo = 0;
        for (int s0 = lo & ~31; s0 < t0 + 16; s0 += 32) {
            unsigned vm = 0;
#pragma unroll
            for (int e = 0; e < 8; ++e) { const int s = s0 + (e >> 2) * 16 + fq * 4 + (e & 3); if (s <= trow && s > trow - 512) vm |= 1u << e; }
            attn_chunk(o, m, l, q0, q1, kb + (size_t)s0 * NPS, vb + s0, vm);
        }
    } else {
        const unsigned rm = ((const unsigned*)(p.ws + O_SEL))[bg * S + trow];
        unsigned un = rm;
        un |= __shfl_xor(un, 1); un |= __shfl_xor(un, 2); un |= __shfl_xor(un, 4); un |= __shfl_xor(un, 8);
        un = __builtin_amdgcn_readfirstlane(un);
        const int cur = t0 >> 6;
        for (int j = 0; j <= cur; ++j) {
            if (!((un >> j) & 1u)) continue;
            const bool rs = (rm >> j) & 1u;
#pragma unroll
            for (int hf = 0; hf < 2; ++hf) {
                const int s0 = j * 64 + hf * 32;
                unsigned vm = 0;
#pragma unroll
                for (int e = 0; e < 8; ++e) { const int s = s0 + (e >> 2) * 16 + fq * 4 + (e & 3); if (rs && s <= trow) vm |= 1u << e; }
                attn_chunk(o, m, l, q0, q1, kb + (size_t)s0 * NPS, vb + s0, vm);
            }
        }
    }
    l += __shfl_xor(l, 16);
    l += __shfl_xor(l, 32);
    const float inv = 1.f / l;
    if (!SELB) {
        bf16_t* OW = (bf16_t*)(p.ws + O_OW) + tok * 1024 + hd * 64 + fq * 4;
#pragma unroll
        for (int dvt = 0; dvt < 4; ++dvt) {
            uint2 ov; ov.x = pk2(o[dvt][0] * inv, o[dvt][1] * inv); ov.y = pk2(o[dvt][2] * inv, o[dvt][3] * inv);
            *(uint2*)(OW + dvt * 16) = ov;
        }
    } else {
        const float* G = (const float*)(p.ws + O_G) + tok * 64 + 8 + hd * 3;
        const float g0 = sigm(G[0]), g1 = sigm(G[1]) * inv, g2 = sigm(G[2]);
        const bf16_t* OC = (const bf16_t*)(p.ws + O_OC) + tok * 1024 + hd * 64 + fq * 4;
        const bf16_t* OW = (const bf16_t*)(p.ws + O_OW) + tok * 1024 + hd * 64 + fq * 4;
        const bf16_t* AZ = P + tok * NPS + C_AZ + hd * 64 + fq * 4;
        bf16_t* YA = (bf16_t*)(p.ws + O_YA) + tok * 1024 + hd * 64 + fq * 4;
#pragma unroll
        for (int dvt = 0; dvt < 4; ++dvt) {
            const uint2 oc = *(const uint2*)(OC + dvt * 16), ow = *(const uint2*)(OW + dvt * 16), az = *(const uint2*)(AZ + dvt * 16);
            const float y0 = (g0 * lo16(oc.x) + g1 * o[dvt][0] + g2 * lo16(ow.x)) * silu(lo16(az.x));
            const float y1 = (g0 * hi16(oc.x) + g1 * o[dvt][1] + g2 * hi16(ow.x)) * silu(hi16(az.x));
            const float y2 = (g0 * lo16(oc.y) + g1 * o[dvt][2] + g2 * lo16(ow.y)) * silu(lo16(az.y));
            const float y3 = (g0 * hi16(oc.y) + g1 * o[dvt][3] + g2 * hi16(ow.y)) * silu(hi16(az.y));
            uint2 ov; ov.x = pk2(y0, y1); ov.y = pk2(y2, y3);
            *(uint2*)(YA + dvt * 16) = ov;
        }
    }
}


constexpr int ML_K = 16384, ML_V = 20480, ML_STAGE = ML_K + ML_V;
DEVI void mlstm2_item(const Params& p, int item, char* lds) {
    const int thr_ = tidx();
    const int half = item >> 8, idx = item & 255;
    const int qb = half ? (idx >> 4) : 31 - (idx >> 4), bh = idx & 15, b = bh >> 2, h = bh & 3;
    const int lane = thr_ & 63, wid = __builtin_amdgcn_readfirstlane(thr_ >> 6), fr = lane & 15, fq = lane >> 4;
    const int T0 = qb * 64, t0 = T0 + wid * 16, trow = t0 + fr;
    const bf16_t* Km = (const bf16_t*)(p.ws + O_KM) + (size_t)(b * S) * 1024 + h * 256;
    const bf16_t* VmT = (const bf16_t*)(p.ws + O_VMT) + (size_t)(b * 1024 + h * 256) * S;
    const float* fa = (const float*)(p.ws + O_FA) + bh * S;
    const float mx = ((const float*)(p.ws + O_FM))[bh * S + trow];
    bf16x8 qf[8];
    {
        const bf16_t* qrow = (const bf16_t*)(p.ws + O_QM) + (size_t)(b * S + trow) * 1024 + h * 256 + fq * 8;
#pragma unroll
        for (int ks = 0; ks < 8; ++ks) qf[ks] = *(const bf16x8*)(qrow + ks * 32);
    }
    f32x4 o[16];
#pragma unroll
    for (int i = 0; i < 16; ++i) o[i] = (f32x4){0.f, 0.f, 0.f, 0.f};
    float den = 0.f;
    const int kr = thr_ >> 5, kc = thr_ & 31, vr = thr_ >> 2, vc = thr_ & 3;
    uint4 rk0, rk1, rk2, rk3, rv0, rv1, rv2, rv3;
#define ML_GLOAD(s0_)                                                                      \
    {                                                                                      \
        const bf16_t* kp_ = Km + (size_t)((s0_) + kr) * 1024 + kc * 8;                     \
        rk0 = *(const uint4*)(kp_); rk1 = *(const uint4*)(kp_ + 8 * 1024);                 \
        rk2 = *(const uint4*)(kp_ + 16 * 1024); rk3 = *(const uint4*)(kp_ + 24 * 1024);    \
        const bf16_t* vp_ = VmT + (size_t)vr * S + (s0_) + vc * 8;                         \
        rv0 = *(const uint4*)(vp_); rv1 = *(const uint4*)(vp_ + (size_t)64 * S);           \
        rv2 = *(const uint4*)(vp_ + (size_t)128 * S); rv3 = *(const uint4*)(vp_ + (size_t)192 * S); \
    }
#define ML_LSTORE(st_)                                                                     \
    {                                                                                      \
        char* kb_ = lds + (st_) * ML_STAGE + (kc >> 2) * 2048 + kr * 64 + (kc & 3) * 16;   \
        *(uint4*)(kb_) = rk0; *(uint4*)(kb_ + 8 * 64) = rk1; *(uint4*)(kb_ + 16 * 64) = rk2; *(uint4*)(kb_ + 24 * 64) = rk3; \
        char* vb_ = lds + (st_) * ML_STAGE + ML_K + vr * 80 + vc * 16;                     \
        *(uint4*)(vb_) = rv0; *(uint4*)(vb_ + 64 * 80) = rv1; *(uint4*)(vb_ + 128 * 80) = rv2; *(uint4*)(vb_ + 192 * 80) = rv3; \
    }
    const int nch = 2 * qb + 2;
    ML_GLOAD(0);
    ML_LSTORE(0);
    __syncthreads();
    for (int ci = 0; ci < nch; ++ci) {
        const int s0 = ci * 32, st = ci & 1;
        if (ci + 1 < nch) ML_GLOAD(s0 + 32);
        if (s0 < t0 + 16) {
            __builtin_amdgcn_s_setprio(1);
            const char* kb = lds + st * ML_STAGE;
            const char* vb = kb + ML_K;
            const f32x4 a0 = *(const f32x4*)(fa + s0 + fq * 4), a1 = *(const f32x4*)(fa + s0 + 16 + fq * 4);
            f32x4 sa = {0.f, 0.f, 0.f, 0.f}, sb = {0.f, 0.f, 0.f, 0.f};
#pragma unroll
            for (int ks = 0; ks < 8; ++ks) {
                sa = mma(*(const bf16x8*)(kb + ks * 2048 + fr * 64 + fq * 16), qf[ks], sa);
                sb = mma(*(const bf16x8*)(kb + ks * 2048 + (16 + fr) * 64 + fq * 16), qf[ks], sb);
            }
            float pv[8];
#pragma unroll
            for (int r = 0; r < 4; ++r) {
                const int s = s0 + fq * 4 + r;
                const float w0 = (s <= trow) ? __expf(a0[r] - mx) : 0.f;
                const float w1 = (s + 16 <= trow) ? __expf(a1[r] - mx) : 0.f;
                pv[r] = sa[r] * w0; pv[4 + r] = sb[r] * w1;
                den += pv[r] + pv[4 + r];
            }
            const bf16x8 pf = pack8(pv);
#pragma unroll
            for (int dvt = 0; dvt < 16; ++dvt) {
                const char* vp = vb + (dvt * 16 + fr) * 80 + fq * 8;
                const bf16x8 vf = join8(*(const uint2*)vp, *(const uint2*)(vp + 32));
                o[dvt] = mma(vf, pf, o[dvt]);
            }
            __builtin_amdgcn_s_setprio(0);
        }
        if (ci + 1 < nch) ML_LSTORE(st ^ 1);
        __syncthreads();
    }
    den += __shfl_xor(den, 16);
    den += __shfl_xor(den, 32);
    const float lower = __expf(-((const float*)(p.ws + O_FL))[bh * S + trow]);
    const float inv = 1.f / fmaxf(fabsf(den), lower);
    const bf16_t* Prow = (const bf16_t*)(p.ws + O_P) + (size_t)(b * S + trow) * NPS;
    float sum = 0.f;
#pragma unroll
    for (int dvt = 0; dvt < 16; ++dvt) {
        const int c = h * 256 + dvt * 16 + fq * 4;
        const uint2 op = *(const uint2*)(Prow + C_MO + c);
        o[dvt][0] *= inv * sigm(lo16(op.x)); o[dvt][1] *= inv * sigm(hi16(op.x)); o[dvt][2] *= inv * sigm(lo16(op.y)); o[dvt][3] *= inv * sigm(hi16(op.y));
        sum += o[dvt][0] + o[dvt][1] + o[dvt][2] + o[dvt][3];
    }
    sum += __shfl_xor(sum, 16);
    sum += __shfl_xor(sum, 32);
    const float mu = sum * (1.f / 256.f);
    float vs = 0.f;
#pragma unroll
    for (int dvt = 0; dvt < 16; ++dvt)
#pragma unroll
        for (int r = 0; r < 4; ++r) { const float d = o[dvt][r] - mu; vs += d * d; }
    vs += __shfl_xor(vs, 16);
    vs += __shfl_xor(vs, 32);
    const float rstd = rsqrtf(vs * (1.f / 256.f) + 1e-6f);
    const bf16_t* xcrow = (const bf16_t*)(p.ws + O_XC) + (size_t)(b * S + trow) * 1024;
    bf16_t* ymrow = (bf16_t*)(p.ws + O_YM) + (size_t)(b * S + trow) * 1024;
#pragma unroll
    for (int dv2 = 0; dv2 < 16; dv2 += 2) {
        uint2 ov[2];
#pragma unroll
        for (int q = 0; q < 2; ++q) {
            const int dvt = dv2 + q, c = h * 256 + dvt * 16 + fq * 4;
            const f32x4 ng = *(const f32x4*)(p.norm_g + c), sk = *(const f32x4*)(p.skip + c);
            const uint2 xc = *(const uint2*)(xcrow + c), mz = *(const uint2*)(Prow + C_MZ + c);
            const float y0 = ((o[dvt][0] - mu) * rstd * ng[0] + sk[0] * lo16(xc.x)) * silu(lo16(mz.x));
            const float y1 = ((o[dvt][1] - mu) * rstd * ng[1] + sk[1] * hi16(xc.x)) * silu(hi16(mz.x));
            const float y2 = ((o[dvt][2] - mu) * rstd * ng[2] + sk[2] * lo16(xc.y)) * silu(lo16(mz.y));
            const float y3 = ((o[dvt][3] - mu) * rstd * ng[3] + sk[3] * hi16(xc.y)) * silu(hi16(mz.y));
            ov[q].x = pk2(y0, y1); ov[q].y = pk2(y2, y3);
        }
        *(uint4*)(ymrow + h * 256 + (dv2 + (fq & 1)) * 16 + (fq >> 1) * 8) = pair16(ov[0], ov[1]);
    }
}


constexpr int CM_K = 16384, CM_VS = 272;
DEVI void cmp3_item(const Params& p, int item, char* lds) {
    const int thr_ = tidx();
    const int tile = item & 31, bg = item >> 5, b = bg >> 2, g = bg & 3;
    const int lane = thr_ & 63, wid = __builtin_amdgcn_readfirstlane(thr_ >> 6), fr = lane & 15, fq = lane >> 4;
    const int T0 = tile * 64, t0 = T0 + wid * 16, trow = t0 + fr, cur = tile;
    const float* KC = (const float*)(p.ws + O_KCF) + (size_t)bg * 127 * 64;
    const float* VC = (const float*)(p.ws + O_VCF) + (size_t)bg * 127 * 64;
    for (int i = 0; i < 32; ++i) {
        const int n = i * 4 + (thr_ >> 6), d = thr_ & 63;
        const float kv = n < 127 ? KC[n * 64 + d] : 0.f, vv = n < 127 ? VC[n * 64 + d] : 0.f;
        *(bf16_t*)(lds + (d >> 5) * 8192 + n * 64 + (d & 31) * 2) = f2bf(kv);
        *(bf16_t*)(lds + CM_K + d * CM_VS + n * 2) = f2bf(vv);
    }
    __syncthreads();
    const bf16_t* P = (const bf16_t*)(p.ws + O_P);
    const size_t tok = (size_t)b * S + trow;
    bf16x8 qf[4][2];
#pragma unroll
    for (int h = 0; h < 4; ++h) {
        const bf16_t* qp = P + tok * NPS + C_AQ + (g * 4 + h) * 64 + fq * 8;
        qf[h][0] = *(const bf16x8*)qp; qf[h][1] = *(const bf16x8*)(qp + 32);
    }
    const int nv = trow >= 31 ? ((trow - 31) >> 4) + 1 : 0;
    const int nvw = t0 + 15 >= 31 ? ((t0 + 15 - 31) >> 4) + 1 : 0;
    const int nchunk = (nvw + 31) >> 5;
    float m[4], l[4];
#pragma unroll
    for (int h = 0; h < 4; ++h) { m[h] = -1e30f; l[h] = 0.f; }
    for (int c = 0; c < nchunk; ++c) {
        bf16x8 kf[2][2];
#pragma unroll
        for (int stl = 0; stl < 2; ++stl)
#pragma unroll
            for (int ks = 0; ks < 2; ++ks) kf[stl][ks] = *(const bf16x8*)(lds + ks * 8192 + (c * 32 + stl * 16 + fr) * 64 + fq * 16);
        unsigned vm = 0;
#pragma unroll
        for (int e = 0; e < 8; ++e) { const int n = c * 32 + (e >> 2) * 16 + fq * 4 + (e & 3); if (n < nv) vm |= 1u << e; }
#pragma unroll
        for (int h = 0; h < 4; ++h) {
            f32x4 sa = {0.f, 0.f, 0.f, 0.f}, sb = {0.f, 0.f, 0.f, 0.f};
            sa = mma(kf[0][0], qf[h][0], sa); sa = mma(kf[0][1], qf[h][1], sa);
            sb = mma(kf[1][0], qf[h][0], sb); sb = mma(kf[1][1], qf[h][1], sb);
            float v[8];
#pragma unroll
            for (int r = 0; r < 4; ++r) { v[r] = sa[r] * 0.125f; v[4 + r] = sb[r] * 0.125f; }
            float mxv = -1e30f;
#pragma unroll
            for (int e = 0; e < 8; ++e) if ((vm >> e) & 1u) mxv = fmaxf(mxv, v[e]);
            mxv = fmaxf(mxv, __shfl_xor(mxv, 16));
            mxv = fmaxf(mxv, __shfl_xor(mxv, 32));
            const float mn = fmaxf(m[h], mxv);
            float ps = 0.f;
#pragma unroll
            for (int e = 0; e < 8; ++e) ps += ((vm >> e) & 1u) ? __expf(v[e] - mn) : 0.f;
            l[h] = l[h] * __expf(m[h] - mn) + ps;
            m[h] = mn;
        }
    }
    float linv[4];
#pragma unroll
    for (int h = 0; h < 4; ++h) {
        float lt = l[h];
        lt += __shfl_xor(lt, 16);
        lt += __shfl_xor(lt, 32);
        linv[h] = lt > 0.f ? 1.f / lt : 0.f;
    }
    f32x4 o[4][4];
#pragma unroll
    for (int h = 0; h < 4; ++h)
#pragma unroll
        for (int i = 0; i < 4; ++i) o[h][i] = (f32x4){0.f, 0.f, 0.f, 0.f};
    float own4[8], last[8];
#pragma unroll
    for (int k = 0; k < 8; ++k) { own4[k] = 0.f; last[k] = 0.f; }
#pragma unroll
    for (int c = 0; c < 4; ++c) {
        if (c < nchunk) {
            bf16x8 kf[2][2];
#pragma unroll
            for (int stl = 0; stl < 2; ++stl)
#pragma unroll
                for (int ks = 0; ks < 2; ++ks) kf[stl][ks] = *(const bf16x8*)(lds + ks * 8192 + (c * 32 + stl * 16 + fr) * 64 + fq * 16);
            bf16x8 vf[4];
#pragma unroll
            for (int dvt = 0; dvt < 4; ++dvt) {
                const char* vp = lds + CM_K + (dvt * 16 + fr) * CM_VS + c * 64 + fq * 8;
                vf[dvt] = join8(*(const uint2*)vp, *(const uint2*)(vp + 32));
            }
            unsigned vm = 0;
#pragma unroll
            for (int e = 0; e < 8; ++e) { const int n = c * 32 + (e >> 2) * 16 + fq * 4 + (e & 3); if (n < nv) vm |= 1u << e; }
#pragma unroll
            for (int h = 0; h < 4; ++h) {
                f32x4 sa = {0.f, 0.f, 0.f, 0.f}, sb = {0.f, 0.f, 0.f, 0.f};
                sa = mma(kf[0][0], qf[h][0], sa); sa = mma(kf[0][1], qf[h][1], sa);
                sb = mma(kf[1][0], qf[h][0], sb); sb = mma(kf[1][1], qf[h][1], sb);
                float v[8];
#pragma unroll
                for (int r = 0; r < 4; ++r) { v[r] = sa[r] * 0.125f; v[4 + r] = sb[r] * 0.125f; }
#pragma unroll
                for (int e = 0; e < 8; ++e) v[e] = ((vm >> e) & 1u) ? __expf(v[e] - m[h]) * linv[h] : 0.f;
                own4[2 * c] += (v[0] + v[1]) + (v[2] + v[3]); last[2 * c] += v[3];
                own4[2 * c + 1] += (v[4] + v[5]) + (v[6] + v[7]); last[2 * c + 1] += v[7];
                const bf16x8 pf = pack8(v);
#pragma unroll
                for (int dvt = 0; dvt < 4; ++dvt) o[h][dvt] = mma(vf[dvt], pf, o[h][dvt]);
            }
        }
    }
    bf16_t* OC = (bf16_t*)(p.ws + O_OC) + tok * 1024 + g * 256;
#pragma unroll
    for (int h = 0; h < 4; ++h)
#pragma unroll
        for (int dvt = 0; dvt < 4; dvt += 2) {
            uint2 x, y;
            x.x = pk2(o[h][dvt][0], o[h][dvt][1]); x.y = pk2(o[h][dvt][2], o[h][dvt][3]);
            y.x = pk2(o[h][dvt + 1][0], o[h][dvt + 1][1]); y.y = pk2(o[h][dvt + 1][2], o[h][dvt + 1][3]);
            *(uint4*)(OC + h * 64 + (dvt + (fq & 1)) * 16 + (fq >> 1) * 8) = pair16(x, y);
        }
    float sc[8];
    float prev = 0.f;
#pragma unroll
    for (int k = 0; k < 8; ++k) {
        const float rcv = __shfl(last[k], (lane + 48) & 63);
        const float carry = fq > 0 ? rcv : prev;
        prev = rcv;
        const int j = 4 * k + fq;
        const bool forced = j == 0 || j == cur || j == cur - 1;
        sc[k] = forced ? 1e30f : (j <= cur ? own4[k] + carry : -1e30f);
    }
    unsigned mask = 0u;
#pragma unroll 1
    for (int it = 0; it < 8; ++it) {
        float bv = sc[0];
        int bj = fq;
#pragma unroll
        for (int k = 1; k < 8; ++k) if (sc[k] > bv) { bv = sc[k]; bj = 4 * k + fq; }
#pragma unroll
        for (int off = 16; off <= 32; off <<= 1) {
            const float ov = __shfl_xor(bv, off);
            const int oj = __shfl_xor(bj, off);
            if (ov > bv || (ov == bv && oj < bj)) { bv = ov; bj = oj; }
        }
        mask |= 1u << bj;
#pragma unroll
        for (int k = 0; k < 8; ++k) if (4 * k + fq == bj) sc[k] = -4e30f;
    }
    if (fq == 0) ((unsigned*)(p.ws + O_SEL))[bg * S + trow] = mask & ((2u << cur) - 1u);
    __syncthreads();
}

constexpr int AT_K = 8192, AT_V = 9216, AT_STAGE = AT_K + AT_V;
template <bool SELB, int NH>
DEVI void nsa2_item(const Params& p, int tile, int bg, int h0, char* lds) {
    const int thr_ = tidx();
    const int b = bg >> 2, g = bg & 3;
    const int lane = thr_ & 63, wid = __builtin_amdgcn_readfirstlane(thr_ >> 6), fr = lane & 15, fq = lane >> 4;
    const int T0 = tile * 64, t0 = T0 + wid * 16, trow = t0 + fr, cur = tile;
    const bf16_t* P = (const bf16_t*)(p.ws + O_P);
    const size_t tok = (size_t)b * S + trow;
    bf16x8 qf[NH][2];
#pragma unroll
    for (int h = 0; h < NH; ++h) {
        const bf16_t* qp = P + tok * NPS + C_AQ + (g * 4 + h0 + h) * 64 + fq * 8;
        qf[h][0] = *(const bf16x8*)qp; qf[h][1] = *(const bf16x8*)(qp + 32);
    }
    unsigned rm = 0xffffffffu, wmask, gmask;
    if (SELB) {
        rm = ((const unsigned*)(p.ws + O_SEL))[bg * S + trow];
        unsigned un = rm;
        un |= __shfl_xor(un, 1); un |= __shfl_xor(un, 2); un |= __shfl_xor(un, 4); un |= __shfl_xor(un, 8);
        wmask = __builtin_amdgcn_readfirstlane(un) & ((2u << cur) - 1u);
        unsigned* lu = (unsigned*)(lds + 2 * AT_STAGE);
        if (lane == 0) lu[wid] = wmask;
        __syncthreads();
        gmask = lu[0] | lu[1] | lu[2] | lu[3];
        gmask = __builtin_amdgcn_readfirstlane(gmask);
    } else {
        const int lo = cur >= 8 ? cur - 8 : 0;
        gmask = ((2u << cur) - 1u) & ~((1u << lo) - 1u);
        const int wl = t0 - 511 > 0 ? (t0 - 511) >> 6 : 0;
        wmask = gmask & ~((1u << wl) - 1u);
    }
    const bf16_t* kg = P + (size_t)(b * S) * NPS + (SELB ? C_KS : C_KW) + g * 64;
    const bf16_t* vg = (const bf16_t*)(p.ws + (SELB ? O_VST : O_VWT)) + (size_t)(b * 256 + g * 64) * S;
    const int sc = thr_ & 7, sr = thr_ >> 3;
    uint4 rk0, rk1, rv0, rv1;
#define AT_GLOAD(jj)                                                                                   \
    {                                                                                                  \
        rk0 = *(const uint4*)(kg + (size_t)((jj) * 64 + sr) * NPS + sc * 8);                           \
        rk1 = *(const uint4*)(kg + (size_t)((jj) * 64 + sr + 32) * NPS + sc * 8);                      \
        rv0 = *(const uint4*)(vg + (size_t)(sr) * S + (jj) * 64 + sc * 8);                             \
        rv1 = *(const uint4*)(vg + (size_t)(sr + 32) * S + (jj) * 64 + sc * 8);                        \
    }
#define AT_LSTORE(stt)                                                                                 \
    {                                                                                                  \
        char* base_ = lds + (stt) * AT_STAGE;                                                          \
        *(uint4*)(base_ + (sc >> 2) * 4096 + (sr) * 64 + (sc & 3) * 16) = rk0;                         \
        *(uint4*)(base_ + (sc >> 2) * 4096 + (sr + 32) * 64 + (sc & 3) * 16) = rk1;                    \
        *(uint4*)(base_ + AT_K + (sr) * 144 + sc * 16) = rv0;                                          \
        *(uint4*)(base_ + AT_K + (sr + 32) * 144 + sc * 16) = rv1;                                     \
    }
    f32x4 o[NH][4];
    float m[NH], l[NH];
#pragma unroll
    for (int h = 0; h < NH; ++h) {
        m[h] = -1e30f; l[h] = 0.f;
#pragma unroll
        for (int i = 0; i < 4; ++i) o[h][i] = (f32x4){0.f, 0.f, 0.f, 0.f};
    }
    unsigned rem = gmask;
    int j = __ffs(rem) - 1;
    rem &= rem - 1;
    AT_GLOAD(j);
    AT_LSTORE(0);
    __syncthreads();
    int st = 0;
    while (true) {
        const int jn = rem ? __ffs(rem) - 1 : -1;
        rem &= rem - 1;
        if (jn >= 0) AT_GLOAD(jn);
        if ((wmask >> j) & 1u) {
            __builtin_amdgcn_s_setprio(1);
            const char* kb = lds + st * AT_STAGE;
            const char* vb = kb + AT_K;
            const bool rs = (rm >> j) & 1u;
#pragma unroll
            for (int c = 0; c < 2; ++c) {
                const int s0 = j * 64 + c * 32;
                bf16x8 kf[2][2];
#pragma unroll
                for (int stl = 0; stl < 2; ++stl)
#pragma unroll
                    for (int ks = 0; ks < 2; ++ks) kf[stl][ks] = *(const bf16x8*)(kb + ks * 4096 + (c * 32 + stl * 16 + fr) * 64 + fq * 16);
                bf16x8 vf[4];
#pragma unroll
                for (int dvt = 0; dvt < 4; ++dvt) {
                    const char* vp = vb + (dvt * 16 + fr) * 144 + c * 64 + fq * 8;
                    vf[dvt] = join8(*(const uint2*)vp, *(const uint2*)(vp + 32));
                }
                unsigned vm = 0;
#pragma unroll
                for (int e = 0; e < 8; ++e) {
                    const int s = s0 + (e >> 2) * 16 + fq * 4 + (e & 3);
                    if (rs && s <= trow && (SELB || s > trow - 512)) vm |= 1u << e;
                }
#pragma unroll
                for (int h = 0; h < NH; ++h) {
                    f32x4 sa = {0.f, 0.f, 0.f, 0.f}, sb = {0.f, 0.f, 0.f, 0.f};
                    sa = mma(kf[0][0], qf[h][0], sa); sa = mma(kf[0][1], qf[h][1], sa);
                    sb = mma(kf[1][0], qf[h][0], sb); sb = mma(kf[1][1], qf[h][1], sb);
                    constexpr float SC = 0.125f * 1.44269504f;
                    float v[8];
#pragma unroll
                    for (int r = 0; r < 4; ++r) { v[r] = sa[r]; v[4 + r] = sb[r]; }
                    float mxv = -1e30f;
#pragma unroll
                    for (int e = 0; e < 8; ++e) if ((vm >> e) & 1u) mxv = fmaxf(mxv, v[e]);
                    mxv = fmaxf(mxv, __shfl_xor(mxv, 16));
                    mxv = fmaxf(mxv, __shfl_xor(mxv, 32));
                    const float mn = fmaxf(m[h], mxv);
                    const float alpha = __builtin_amdgcn_exp2f((m[h] - mn) * SC);
                    m[h] = mn;
                    const float mb = -mn * SC;
                    float ps = 0.f;
#pragma unroll
                    for (int e = 0; e < 8; ++e) { v[e] = ((vm >> e) & 1u) ? __builtin_amdgcn_exp2f(fmaf(v[e], SC, mb)) : 0.f; ps += v[e]; }
                    l[h] = l[h] * alpha + ps;
                    const bf16x8 pf = pack8(v);
#pragma unroll
                    for (int dvt = 0; dvt < 4; ++dvt) { o[h][dvt] *= alpha; o[h][dvt] = mma(vf[dvt], pf, o[h][dvt]); }
                }
            }
            __builtin_amdgcn_s_setprio(0);
        }
        if (jn < 0) break;
        AT_LSTORE(st ^ 1);
        __syncthreads();
        st ^= 1;
        j = jn;
    }
    __syncthreads();
#pragma unroll
    for (int h = 0; h < NH; ++h) {
        const int hd = g * 4 + h0 + h;
        float lt = l[h];
        lt += __shfl_xor(lt, 16);
        lt += __shfl_xor(lt, 32);
        const float inv = 1.f / lt;
        if (!SELB) {
            bf16_t* OW = (bf16_t*)(p.ws + O_OW) + tok * 1024 + hd * 64;
#pragma unroll
            for (int dvt = 0; dvt < 4; dvt += 2) {
                uint2 x, y;
                x.x = pk2(o[h][dvt][0] * inv, o[h][dvt][1] * inv); x.y = pk2(o[h][dvt][2] * inv, o[h][dvt][3] * inv);
                y.x = pk2(o[h][dvt + 1][0] * inv, o[h][dvt + 1][1] * inv); y.y = pk2(o[h][dvt + 1][2] * inv, o[h][dvt + 1][3] * inv);
                *(uint4*)(OW + (dvt + (fq & 1)) * 16 + (fq >> 1) * 8) = pair16(x, y);
            }
        } else {
            const float* G = (const float*)(p.ws + O_G) + tok * 64 + 8 + hd * 3;
            const float g0 = sigm(G[0]), g1 = sigm(G[1]) * inv, g2 = sigm(G[2]);
            const bf16_t* OC = (const bf16_t*)(p.ws + O_OC) + tok * 1024 + hd * 64 + fq * 4;
            const bf16_t* OW = (const bf16_t*)(p.ws + O_OW) + tok * 1024 + hd * 64 + fq * 4;
            const bf16_t* AZ = P + tok * NPS + C_AZ + hd * 64 + fq * 4;
            bf16_t* YA = (bf16_t*)(p.ws + O_YA) + tok * 1024 + hd * 64 + fq * 4;
#pragma unroll
            for (int dv2 = 0; dv2 < 4; dv2 += 2) {
                uint2 ov[2];
#pragma unroll
                for (int q = 0; q < 2; ++q) {
                    const int dvt = dv2 + q;
                    const uint2 oc = *(const uint2*)(OC + dvt * 16), ow = *(const uint2*)(OW + dvt * 16), az = *(const uint2*)(AZ + dvt * 16);
                    const float y0 = (g0 * lo16(oc.x) + g1 * o[h][dvt][0] + g2 * lo16(ow.x)) * silu(lo16(az.x));
                    const float y1 = (g0 * hi16(oc.x) + g1 * o[h][dvt][1] + g2 * hi16(ow.x)) * silu(hi16(az.x));
                    const float y2 = (g0 * lo16(oc.y) + g1 * o[h][dvt][2] + g2 * lo16(ow.y)) * silu(lo16(az.y));
                    const float y3 = (g0 * hi16(oc.y) + g1 * o[h][dvt][3] + g2 * hi16(ow.y)) * silu(hi16(az.y));
                    ov[q].x = pk2(y0, y1); ov[q].y = pk2(y2, y3);
                }
                *(uint4*)(YA - fq * 4 + (dv2 + (fq & 1)) * 16 + (fq >> 1) * 8) = pair16(ov[0], ov[1]);
            }
        }
    }
}

DEVI void up_tile(const Params& p, int item, char* lds) {
    const int nt = item >> 5, mt = item & 31, m0 = mt * 256, n0 = nt * 64;
    const int tid = tidx(), lane = tid & 63, wid = tid >> 6, wr = wid >> 1, wc = wid & 1, fr = lane & 15, fq = lane >> 4;
    const bf16_t* P = (const bf16_t*)(p.ws + O_P);
    f32x4 acc[8][2], acc2[8][2];
#pragma unroll
    for (int i = 0; i < 8; ++i) { acc[i][0] = acc[i][1] = acc2[i][0] = acc2[i][1] = (f32x4){0.f, 0.f, 0.f, 0.f}; }
    gemm3_main<false, 2>(acc, lds, (const bf16_t*)(p.ws + O_YM), 1024, (const bf16_t*)(p.ws + O_WUM), 1024, 2047, m0, n0, 1024);
    gemm3_main<false, 2>(acc2, lds, (const bf16_t*)(p.ws + O_YA), 1024, (const bf16_t*)(p.ws + O_WUA), 1024, 2047, m0, n0, 1024);
    bf16_t* MG = (bf16_t*)(p.ws + O_MG);
#pragma unroll
    for (int mi = 0; mi < 8; ++mi) {
        const int row = m0 + wr * 128 + mi * 16 + fr;
        uint2 ov[2];
        const int pc = n0 + wc * 32 + (fq & 1) * 16 + (fq >> 1) * 8;
        const uint4 gm16 = *(const uint4*)(P + (size_t)row * NPS + C_GM + pc), ga16 = *(const uint4*)(P + (size_t)row * NPS + C_GA + pc);
        uint2 ta, tb;
        ta.x = gm16.x; ta.y = gm16.y; tb.x = gm16.z; tb.y = gm16.w;
        const uint4 gmu = pair16(ta, tb);
        ta.x = ga16.x; ta.y = ga16.y; tb.x = ga16.z; tb.y = ga16.w;
        const uint4 gau = pair16(ta, tb);
#pragma unroll
        for (int ni = 0; ni < 2; ++ni) {
            uint2 gm, ga;
            gm.x = ni ? gmu.z : gmu.x; gm.y = ni ? gmu.w : gmu.y; ga.x = ni ? gau.z : gau.x; ga.y = ni ? gau.w : gau.y;
            const float y0 = acc[mi][ni][0] * sigm(lo16(gm.x)) + acc2[mi][ni][0] * sigm(lo16(ga.x)), y1 = acc[mi][ni][1] * sigm(hi16(gm.x)) + acc2[mi][ni][1] * sigm(hi16(ga.x));
            const float y2 = acc[mi][ni][2] * sigm(lo16(gm.y)) + acc2[mi][ni][2] * sigm(lo16(ga.y)), y3 = acc[mi][ni][3] * sigm(hi16(gm.y)) + acc2[mi][ni][3] * sigm(hi16(ga.y));
            ov[ni].x = pk2(y0, y1); ov[ni].y = pk2(y2, y3);
        }
        *(uint4*)(MG + (size_t)row * DM + n0 + wc * 32 + (fq & 1) * 16 + (fq >> 1) * 8) = pair16(ov[0], ov[1]);
    }
}
DEVI void out_tile(const Params& p, int item, char* lds) {
    const int nt = item >> 5, mt = item & 31, m0 = mt * 256, n0 = nt * 128;
    const int tid = tidx(), lane = tid & 63, wid = tid >> 6, wr = wid >> 1, wc = wid & 1, fr = lane & 15, fq = lane >> 4;
    f32x4 acc[8][4];
    zero_acc2(acc);
    gemm3_main<false, 4>(acc, lds, (const bf16_t*)(p.ws + O_MG), DM, (const bf16_t*)(p.ws + O_WOUT), DM, 2047, m0, n0, DM);
    bf16_t* O = (bf16_t*)(p.ws + O_OUT);
#pragma unroll
    for (int mi = 0; mi < 8; ++mi)
#pragma unroll
        for (int ni = 0; ni < 4; ni += 2) {
            const int row = m0 + wr * 128 + mi * 16 + fr, col = n0 + wc * 64 + (ni + (fq & 1)) * 16 + (fq >> 1) * 8;
            uint2 x, y;
            x.x = pk2(acc[mi][ni][0], acc[mi][ni][1]); x.y = pk2(acc[mi][ni][2], acc[mi][ni][3]);
            y.x = pk2(acc[mi][ni + 1][0], acc[mi][ni + 1][1]); y.y = pk2(acc[mi][ni + 1][2], acc[mi][ni + 1][3]);
            *(uint4*)(O + (size_t)row * DM + col) = pair16(x, y);
        }
}
DEVI void final_rows(const Params& p, int item) {
    const int thr_ = tidx();
    const int lane = thr_ & 63, wid = thr_ >> 6;
    const int row = item * 4 + wid;
    const bf16_t* orow = (const bf16_t*)(p.ws + O_OUT) + (size_t)row * DM;
    const float* xr = p.x + (size_t)row * DM;
    f32x4 v[8];
    float ss = 0.f;
#pragma unroll
    for (int i = 0; i < 8; ++i) { const uint2 u = *(const uint2*)(orow + i * 256 + lane * 4); v[i] = (f32x4){lo16(u.x), hi16(u.x), lo16(u.y), hi16(u.y)}; ss += v[i][0] * v[i][0] + v[i][1] * v[i][1] + v[i][2] * v[i][2] + v[i][3] * v[i][3]; }
    ss = wave_sum(ss);
    const float rs = rsqrtf(ss * (1.f / DM) + 1e-6f);
    float* dr = p.out + (size_t)row * DM;
#pragma unroll
    for (int i = 0; i < 8; ++i) {
        const f32x4 g = *(const f32x4*)(p.post_g + i * 256 + lane * 4);
        const f32x4 xv = *(const f32x4*)(xr + i * 256 + lane * 4);
#if DBG == 0
        *(f32x4*)(dr + i * 256 + lane * 4) = xv + v[i] * rs * g;
#elif DBG == 1
        *(f32x4*)(dr + i * 256 + lane * 4) = xv;
#elif DBG == 9
        {
            const int cc = (i * 256 + lane * 4) & 1023;
            const uint2 u0 = *(const uint2*)((const bf16_t*)(p.ws + O_XC) + (size_t)row * 1024 + cc);
            const uint2 u1 = *(const uint2*)((const bf16_t*)(p.ws + O_QM) + (size_t)row * 1024 + cc);
            const uint2 u2 = *(const uint2*)((const bf16_t*)(p.ws + O_KM) + (size_t)row * 1024 + cc);
            const uint2 u3 = *(const uint2*)((const bf16_t*)(p.ws + O_VMT) + (size_t)row * 1024 + cc);
            const int fi = (row & 15) * 2048 + i * 256 + lane * 4;
            const f32x4 f0 = *(const f32x4*)((const float*)(p.ws + O_FA) + fi), f1 = *(const f32x4*)((const float*)(p.ws + O_FM) + fi), f2 = *(const f32x4*)((const float*)(p.ws + O_FL) + fi);
            f32x4 d = {lo16(u0.x) + lo16(u1.x) + lo16(u2.x) + lo16(u3.x), hi16(u0.x) + hi16(u1.x) + hi16(u2.x) + hi16(u3.x), lo16(u0.y) + lo16(u1.y) + lo16(u2.y) + lo16(u3.y), hi16(u0.y) + hi16(u1.y) + hi16(u2.y) + hi16(u3.y)};
            #if PSEL == 0
            d = (f32x4){lo16(u3.x), hi16(u3.x), lo16(u3.y), hi16(u3.y)};
            *(f32x4*)(dr + i * 256 + lane * 4) = xv + d;
#elif PSEL == 1
            d = (f32x4){lo16(u0.x), hi16(u0.x), lo16(u0.y), hi16(u0.y)};
            *(f32x4*)(dr + i * 256 + lane * 4) = xv + d;
#elif PSEL == 2
            *(f32x4*)(dr + i * 256 + lane * 4) = xv + f0 + f1 + f2;
#else
            *(f32x4*)(dr + i * 256 + lane * 4) = xv + d + f0 + f1 + f2;
#endif
        }
#else
        {
            const bf16_t* src = DBG == 2 ? (const bf16_t*)(p.ws + O_MG) + (size_t)row * DM : DBG == 3 ? (const bf16_t*)(p.ws + O_P) + (size_t)row * NPS + 2048
                              : DBG == 4 ? (const bf16_t*)(p.ws + O_YM) + (size_t)row * 1024 : DBG == 5 ? (const bf16_t*)(p.ws + O_YA) + (size_t)row * 1024
                              : DBG == 6 ? (const bf16_t*)(p.ws + O_P) + (size_t)row * NPS + 4096 : (const bf16_t*)(p.ws + O_P) + (size_t)row * NPS + 7680;
            const int cc = (i * 256 + lane * 4) & ((DBG == 4 || DBG == 5) ? 1023 : 2047);
            const uint2 u = *(const uint2*)(src + cc);
            f32x4 d = {lo16(u.x), hi16(u.x), lo16(u.y), hi16(u.y)};
            *(f32x4*)(dr + i * 256 + lane * 4) = xv + d;
        }
#endif
    }
}


__global__ void __launch_bounds__(256, 2) fwd_megakernel(Params p) {
    extern __shared__ __attribute__((aligned(16))) char lds[];
    const int G = gridDim.x, bid = blockIdx.x;
    if (threadIdx.x == 0) *(uint4*)(lds + LDS_MAIN) = make_uint4(0u, 0u, 0u, 0u);
    __syncthreads();
    XcdBarrier xb = xcd_barrier_post((unsigned*)(p.ws + O_BAR), (volatile LAS unsigned*)(lds + LDS_MAIN));
    if (p.ws == nullptr) cg::this_grid().sync();
    for (int rep = 0; rep < NREP(0); ++rep)
    for (int it = bid; it < 2048 + N_TTILES + 32; it += G) {
        if (it < N_TTILES) transpose_item(p, it, lds);
        else if (it < N_TTILES + 2048) rmsnorm_rows(p, it - N_TTILES);
        else bias_item(p, it - N_TTILES - 2048);
    }
    xcd_barrier(xb);
    for (int rep = 0; rep < NREP(1); ++rep)
    for (int it = bid; it < 32 * 93; it += G) inproj_tile(p, it, lds);
    if (G >= 128 && bid >= G - 64) {
        if (threadIdx.x == 0) {
            unsigned* cnt = (unsigned*)(p.ws + O_BAR);
            XB_SPIN(xb_ld(cnt) < 128u * NREP(1), cnt);
            __builtin_amdgcn_fence(__ATOMIC_ACQUIRE, "agent");
            asm volatile("s_waitcnt vmcnt(0)" ::: "memory");
        }
        __syncthreads();
        __builtin_amdgcn_fence(__ATOMIC_ACQUIRE, "agent");
        cmp1_tile(p, bid - (G - 64), lds);
    } else if (G < 128) {
        xcd_barrier(xb);
        for (int it = bid; it < 64; it += G) cmp1_tile(p, it, lds);
    }
    xcd_barrier(xb);
    for (int rep = 0; rep < NREP(2); ++rep)
    for (int it = bid; it < 16 + 1024; it += G) {
        if (it < 16) scan_item(p, it, lds);
        else conv_item(p, it - 16);
    }
    xcd_barrier(xb);
    for (int rep = 0; rep < NREP(3); ++rep)
    for (int it = bid; it < 1024 + 32; it += G) {
        if (it < 32) cmp2_tile(p, it, lds);
        else qk_tile(p, it - 32, lds);
    }
    xcd_barrier(xb);
    for (int rep = 0; rep < NREP(4); ++rep) {
        for (int r2 = 0; r2 < NREP(8); ++r2)
        for (int it = bid; it < 512; it += G) mlstm2_item(p, it, lds);
        for (int r2 = 0; r2 < NREP(9); ++r2)
        if (bid >= (G >> 1)) for (int it = bid - (G >> 1); it < 512; it += G - (G >> 1)) cmp3_item(p, it, lds);
        for (int r2 = 0; r2 < NREP(10); ++r2)
        for (int it = bid; it < 512; it += G) nsa2_item<false, 4>(p, it >> 4, it & 15, 0, lds);
    }
    xcd_barrier(xb);
    for (int rep = 0; rep < NREP(5); ++rep)
    for (int it = bid; it < 1024; it += G) {
        const int idx = it & 511, hp = it >> 9;
        nsa2_item<true, 2>(p, hp ? (idx >> 4) : 31 - (idx >> 4), idx & 15, hp * 2, lds);
    }
    xcd_barrier(xb);
    for (int rep = 0; rep < NREP(6); ++rep)
    for (int it = bid; it < 1024; it += G) up_tile(p, it, lds);
    xcd_barrier(xb);
    for (int rep = 0; rep < NREP(7); ++rep)
    for (int it = bid; it < 512; it += G) out_tile(p, it, lds);
    xcd_barrier(xb);
    for (int rep = 0; rep < NREP(11); ++rep)
    for (int it = bid; it < 2048; it += G) final_rows(p, it);
}

extern "C" void kernel_launch(void* const* d_in, const int* in_sizes, int n_in, void* d_out, int out_size, void* d_ws, size_t ws_size,
                              hipStream_t stream) {
    static int grid_blocks = 0;
    if (!grid_blocks) {
        int dev = 0, cus = 0, per_cu = 0;
        hipGetDevice(&dev);
        hipDeviceGetAttribute(&cus, hipDeviceAttributeMultiprocessorCount, dev);
        hipFuncSetAttribute((const void*)fwd_megakernel, hipFuncAttributeMaxDynamicSharedMemorySize, LDS_BYTES);
        hipOccupancyMaxActiveBlocksPerMultiprocessor(&per_cu, fwd_megakernel, 256, LDS_BYTES);
        if (per_cu < 1) per_cu = 1;
        if (per_cu > 2) per_cu = 2;
        grid_blocks = cus * per_cu;
    }
    if (ws_size < O_END2) { fprintf(stderr, "workspace too small: %zu < %zu\n", ws_size, (size_t)O_END); return; }
    Params p{};
    const float** f = (const float**)&p;
    for (int i = 0; i < 21; ++i) f[i] = (const float*)d_in[i];
    p.out = (float*)d_out;
    p.ws = (char*)d_ws;
    hipMemsetAsync((char*)d_ws + O_BAR, 0, XCD_BAR_WORDS * 4, stream);
    void* args[] = {&p};
    hipError_t e = hipLaunchCooperativeKernel((void*)fwd_megakernel, dim3(grid_blocks), dim3(256), args, LDS_BYTES, stream);
    if (e != hipSuccess) fprintf(stderr, "cooperative launch failed: %s (grid %d)\n", hipGetErrorString(e), grid_blocks);
}
```

```cpp
#include <hip/hip_runtime.h>
#include <hip/hip_cooperative_groups.h>
#include <stdint.h>
#include <cstdio>
namespace cg = cooperative_groups;

typedef unsigned short bf16_t;
typedef short bf16x8 __attribute__((ext_vector_type(8)));
typedef float f32x4 __attribute__((ext_vector_type(4)));
#define DEVI __device__ __forceinline__

constexpr int T = 8192, S = 2048, DM = 2048;
constexpr int NP = 11904, NPS = 11776, DIN = 11832;
constexpr int C_MX = 0, C_MV = 1024, C_MO = 2048, C_MZ = 3072, C_AQ = 4096, C_KC = 5120, C_VC = 5376, C_KS = 5632,
              C_VS = 5888, C_KW = 6144, C_VW = 6400, C_AZ = 6656, C_GM = 7680, C_GA = 9728, C_GATE = 11776;
constexpr size_t O_R0 = 0;
constexpr size_t O_R1 = O_R0 + 33554432;
constexpr size_t O_P = O_R1 + 50331648;
constexpr size_t O_WUM = O_P + 192937984;
constexpr size_t O_WUA = O_WUM + 4194304;
constexpr size_t O_WOUT = O_WUA + 4194304;
constexpr size_t O_WQ = O_WOUT + 8388608;
constexpr size_t O_WK = O_WQ + 524288;
constexpr size_t O_W1K = O_WK + 524288;
constexpr size_t O_W1V = O_W1K + 1048576;
constexpr size_t O_W2K = O_W1V + 1048576;
constexpr size_t O_W2V = O_W2K + 32768;
constexpr size_t O_G = O_W2V + 32768;
constexpr size_t O_VMT = O_G + 2097152;
constexpr size_t O_VST = O_VMT + 16777216;
constexpr size_t O_VWT = O_VST + 4194304;
constexpr size_t O_HC = O_VWT + 4194304;
constexpr size_t O_KCF = O_HC + 2097152;
constexpr size_t O_VCF = O_KCF + 524288;
constexpr size_t O_B1P = O_VCF + 524288;
constexpr size_t O_FA = O_B1P + 32768;
constexpr size_t O_FM = O_FA + 131072;
constexpr size_t O_FL = O_FM + 131072;
constexpr size_t O_SEL = O_FL + 131072;
constexpr size_t O_YM = O_SEL + 131072;
constexpr size_t O_END = O_YM + 16777216;
constexpr size_t O_XC = O_R1, O_QM = O_R1 + 16777216, O_KM = O_R1 + 2 * 16777216, O_YA = O_QM;
constexpr size_t O_OC = O_R0, O_OW = O_R0 + 16777216, O_MG = O_R0, O_H = O_R0, O_WINT = O_R1, O_OUT = O_P;

constexpr int LDS_MAIN = 73728;
constexpr int LDS_BYTES = LDS_MAIN + 64;
constexpr size_t O_BAR = O_END;
constexpr size_t O_END2 = O_BAR + 16384;
#ifndef DBG
#define DBG 0
#endif
#ifndef REPM
#define REPM 0
#endif
#define NREP(k) (((REPM >> (k)) & 1) ? 2 : 1)
#ifndef DSTOP
#define DSTOP 9
#endif
#ifndef PSEL
#define PSEL 0
#endif

struct Params {
    const float *x, *pre_g, *w_in, *conv_w, *conv_b, *w_q, *w_k, *b_i, *b_f, *norm_g, *skip, *pe_k, *w1_k, *w2_k, *pe_v, *w1_v,
        *w2_v, *w_up_m, *w_up_a, *w_out, *post_g;
    float* out;
    char* ws;
};

DEVI int tidx() { int t = threadIdx.x; asm volatile("" : "+v"(t)); return t; }
DEVI float bf2f(bf16_t b) { return __uint_as_float(((unsigned)b) << 16); }
typedef __bf16 bf16v2_t __attribute__((ext_vector_type(2)));
typedef float f32v2_t __attribute__((ext_vector_type(2)));
DEVI unsigned pk2(float lo, float hi) {
    f32v2_t v = {lo, hi};
    bf16v2_t b = __builtin_convertvector(v, bf16v2_t);
    return __builtin_bit_cast(unsigned, b);
}
DEVI bf16_t f2bf(float f) { return (bf16_t)(pk2(f, 0.f) & 0xffffu); }
DEVI float lo16(unsigned u) { return __uint_as_float(u << 16); }
DEVI float hi16(unsigned u) { return __uint_as_float(u & 0xffff0000u); }
DEVI float sigm(float x) { return 1.f / (1.f + __expf(-x)); }
DEVI float silu(float x) { return x / (1.f + __expf(-x)); }
DEVI f32x4 mma(bf16x8 a, bf16x8 b, f32x4 c) { return __builtin_amdgcn_mfma_f32_16x16x32_bf16(a, b, c, 0, 0, 0); }
DEVI float rdlane(float v, int l) { return __uint_as_float(__builtin_amdgcn_readlane(__float_as_uint(v), l)); }
DEVI uint4 pair16(uint2 x, uint2 y) {
    const auto r0 = __builtin_amdgcn_permlane16_swap(x.x, y.x, false, false);
    const auto r1 = __builtin_amdgcn_permlane16_swap(x.y, y.y, false, false);
    return make_uint4(r0[0], r1[0], r0[1], r1[1]);
}
typedef unsigned u32x4_t __attribute__((ext_vector_type(4)));
DEVI void store_nt16(void* ptr, uint4 v) { u32x4_t x = {v.x, v.y, v.z, v.w}; __builtin_nontemporal_store(x, (u32x4_t*)ptr); }
DEVI float wave_max(float v) {
#pragma unroll
    for (int o = 32; o > 0; o >>= 1) v = fmaxf(v, __shfl_xor(v, o));
    return v;
}
DEVI float wave_sum(float v) {
#pragma unroll
    for (int o = 32; o > 0; o >>= 1) v += __shfl_xor(v, o);
    return v;
}
DEVI bf16x8 pack8(const float* v) {
    union { unsigned u[4]; bf16x8 b; } x;
    x.u[0] = pk2(v[0], v[1]); x.u[1] = pk2(v[2], v[3]); x.u[2] = pk2(v[4], v[5]); x.u[3] = pk2(v[6], v[7]);
    return x.b;
}
DEVI bf16x8 join8(uint2 a, uint2 b) {
    union { unsigned u[4]; bf16x8 v; } x;
    x.u[0] = a.x; x.u[1] = a.y; x.u[2] = b.x; x.u[3] = b.y;
    return x.v;
}

#define XB_TMO      128
#define XB_XCNT(j)  (256  + 64 * (j))
#define XB_XSUB(j)  (1280 + 64 * (j))
#define XB_XGEN(j)  (2304 + 64 * (j))
#define XB_TOP      3328
#define XB_TOPGEN   3392
#define XCD_BAR_WORDS 3456
#define XB_SPIN_CAP (1u << 18)
#define LAS __attribute__((address_space(3)))
DEVI unsigned xb_ld(unsigned* p) { return __hip_atomic_load(p, __ATOMIC_RELAXED, __HIP_MEMORY_SCOPE_AGENT); }
DEVI unsigned xb_add(unsigned* p, unsigned v) { return __hip_atomic_fetch_add(p, v, __ATOMIC_RELAXED, __HIP_MEMORY_SCOPE_AGENT); }
DEVI unsigned xb_xcc_id() { return (unsigned)__builtin_amdgcn_s_getreg((3 << 11) | 20) & 0xFu; }
#define XB_SPIN(cond, bar) do { unsigned _sp = 0; while (cond) { __builtin_amdgcn_s_sleep(1); \
    if ((++_sp & 255u) == 0u) { if (xb_ld(&(bar)[XB_TMO])) break; if (_sp > XB_SPIN_CAP) { atomicAdd(&(bar)[XB_TMO], 1u); break; } } } } while (0)
struct XcdBarrier { unsigned* bar; unsigned x; volatile LAS unsigned* st; };
DEVI XcdBarrier xcd_barrier_post(unsigned* bar, volatile LAS unsigned* st) {
    XcdBarrier b; b.bar = bar; b.x = xb_xcc_id(); b.st = st;
    if (threadIdx.x == 0) (void)xb_add(&bar[XB_XCNT(b.x)], 1u);
    return b;
}
DEVI void xcd_barrier_complete(unsigned* bar, unsigned x, unsigned& nloc, unsigned& nx) {
    const unsigned G = gridDim.x * gridDim.y * gridDim.z;
    unsigned sum, cnt, mine, sp = 0u;
    for (;;) {
        sum = 0u; cnt = 0u; mine = 0u;
#pragma unroll
        for (unsigned j = 0; j < 16; ++j) { const unsigned c = xb_ld(&bar[XB_XCNT(j)]); sum += c; cnt += (c > 0u) ? 1u : 0u; mine = (j == x) ? c : mine; }
        if (sum == G) break;
        __builtin_amdgcn_s_sleep(1);
        if ((++sp & 255u) == 0u) { if (xb_ld(&bar[XB_TMO])) break; if (sp > XB_SPIN_CAP) { atomicAdd(&bar[XB_TMO], 1u); break; } }
    }
    nloc = mine > 0u ? mine : 1u; nx = cnt > 0u ? cnt : 1u;
}
DEVI void xcd_barrier(const XcdBarrier& b) {
    asm volatile("s_waitcnt vmcnt(0)" ::: "memory");
    __syncthreads();
    if (threadIdx.x == 0) {
        unsigned* bar = b.bar;
        __builtin_amdgcn_s_waitcnt(0);
        unsigned nloc = b.st[0], nx = b.st[1];
        if (nloc == 0u) { xcd_barrier_complete(bar, b.x, nloc, nx); b.st[0] = nloc; b.st[1] = nx; }
        const unsigned old = xb_add(&bar[XB_XSUB(b.x)], 1u);
        const unsigned gen = old / nloc;
        if (old + 1u == (gen + 1u) * nloc) {
            __builtin_amdgcn_fence(__ATOMIC_RELEASE, "agent");
            asm volatile("s_waitcnt vmcnt(0)" ::: "memory");
            const unsigned og = xb_add(&bar[XB_TOP], 1u);
            const unsigned tg = og / nx;
            if (og + 1u == (tg + 1u) * nx) xb_add(&bar[XB_TOPGEN], 1u);
            else XB_SPIN(xb_ld(&bar[XB_TOPGEN]) == tg, bar);
            __builtin_amdgcn_fence(__ATOMIC_ACQUIRE, "agent");
            xb_add(&bar[XB_XGEN(b.x)], 1u);
            asm volatile("s_waitcnt vmcnt(0)" ::: "memory");
        } else {
            XB_SPIN(xb_ld(&bar[XB_XGEN(b.x)]) == gen, bar);
            __builtin_amdgcn_fence(__ATOMIC_ACQUIRE, "agent");
            asm volatile("s_waitcnt vmcnt(0)" ::: "memory");
        }
    }
    __syncthreads();
}
template <bool TR, int NI, class RB>
DEVI void gemm_main(f32x4 (&acc)[4][NI], char* lds, RB rowbase, size_t hi, const bf16_t* Bt, int ldb, int nBmax, int m0, int n0, int K) {
    const int tid = tidx(), lane = tid & 63, wid = tid >> 6, wr = wid >> 1, wc = wid & 1, fr = lane & 15, fq = lane >> 4;
    const int c = tid & 7, r0 = tid >> 3;
    const bf16_t* ab[4];
    const bf16_t* bb[NI];
#pragma unroll
    for (int i = 0; i < 4; ++i) ab[i] = rowbase(m0 + r0 + i * 32) + c * 8;
#pragma unroll
    for (int i = 0; i < NI; ++i) {
        int nr = n0 + r0 + i * 32;
        if (nr > nBmax) nr = nBmax;
        bb[i] = Bt + (size_t)nr * ldb + c * 8;
    }
    uint4 ra[4], rb[NI];
    const int nk = K >> 6;
    const int lw = (c >> 2) * 8192 + r0 * 64 + (c & 3) * 16;
#pragma unroll
    for (int i = 0; i < 4; ++i) ra[i] = *(const uint4*)(ab[i]);
#pragma unroll
    for (int i = 0; i < NI; ++i) rb[i] = *(const uint4*)(bb[i]);
#pragma unroll
    for (int i = 0; i < 4; ++i) *(uint4*)(lds + lw + i * 2048) = ra[i];
#pragma unroll
    for (int i = 0; i < NI; ++i) *(uint4*)(lds + 16384 + lw + i * 2048) = rb[i];
    __syncthreads();
    for (int kt = 0; kt < nk; ++kt) {
        const int buf = kt & 1;
        if (kt + 1 < nk) {
            const size_t ao = (size_t)(kt + 1) * hi;
            const int bo = (kt + 1) * 64;
#pragma unroll
            for (int i = 0; i < 4; ++i) ra[i] = *(const uint4*)(ab[i] + ao);
#pragma unroll
            for (int i = 0; i < NI; ++i) rb[i] = *(const uint4*)(bb[i] + bo);
        }
        const char* la = lds + buf * 32768;
        const char* lb = la + 16384;
#pragma unroll
        for (int kp = 0; kp < 2; ++kp) {
            bf16x8 af[4], bf[NI];
#pragma unroll
            for (int i = 0; i < 4; ++i) af[i] = *(const bf16x8*)(la + kp * 8192 + (wr * 64 + i * 16 + fr) * 64 + fq * 16);
#pragma unroll
            for (int i = 0; i < NI; ++i) bf[i] = *(const bf16x8*)(lb + kp * 8192 + (wc * NI * 16 + i * 16 + fr) * 64 + fq * 16);
#pragma unroll
            for (int mi = 0; mi < 4; ++mi)
#pragma unroll
                for (int ni = 0; ni < NI; ++ni) acc[mi][ni] = TR ? mma(af[mi], bf[ni], acc[mi][ni]) : mma(bf[ni], af[mi], acc[mi][ni]);
        }
        if (kt + 1 < nk) {
            char* lwp = lds + (buf ^ 1) * 32768 + lw;
#pragma unroll
            for (int i = 0; i < 4; ++i) *(uint4*)(lwp + i * 2048) = ra[i];
#pragma unroll
            for (int i = 0; i < NI; ++i) *(uint4*)(lwp + 16384 + i * 2048) = rb[i];
        }
        __syncthreads();
    }
}
template <int NI>
DEVI void zero_acc(f32x4 (&acc)[4][NI]) {
#pragma unroll
    for (int i = 0; i < 4; ++i)
#pragma unroll
        for (int j = 0; j < NI; ++j) acc[i][j] = (f32x4){0.f, 0.f, 0.f, 0.f};
}
struct RowLin {
    const bf16_t* A; size_t lda;
    DEVI const bf16_t* operator()(int r) const { return A + (size_t)r * lda; }
};


template <bool TR>
DEVI void gemm2_main(f32x4 (&acc)[8][4], char* lds, const bf16_t* A, size_t lda, const bf16_t* Bt, int ldb, int nBmax, int m0, int n0, int K) {
    const int tid = tidx(), lane = tid & 63, wid = tid >> 6, wr = wid >> 1, wc = wid & 1, fr = lane & 15, fq = lane >> 4;
    const int c = tid & 3, r0 = tid >> 2;
    const bf16_t* ap = A + (size_t)(m0 + r0) * lda + c * 8;
    const bf16_t* bp0; const bf16_t* bp1;
    { int nr = n0 + r0; if (nr > nBmax) nr = nBmax; bp0 = Bt + (size_t)nr * ldb + c * 8; nr = n0 + r0 + 64; if (nr > nBmax) nr = nBmax; bp1 = Bt + (size_t)nr * ldb + c * 8; }
    const size_t a64 = (size_t)64 * lda;
    uint4 ra0, ra1, ra2, ra3, rb0, rb1;
    const int nk = K >> 5;
    const int lw = r0 * 64 + c * 16;
#define G2_LOAD(ko)                                                                                       \
    { ra0 = *(const uint4*)(ap + (ko)); ra1 = *(const uint4*)(ap + a64 + (ko)); ra2 = *(const uint4*)(ap + 2 * a64 + (ko)); \
      ra3 = *(const uint4*)(ap + 3 * a64 + (ko)); rb0 = *(const uint4*)(bp0 + (ko)); rb1 = *(const uint4*)(bp1 + (ko)); }
#define G2_STORE(st_)                                                                                     \
    { char* b_ = lds + (st_) * 24576 + lw; *(uint4*)(b_) = ra0; *(uint4*)(b_ + 4096) = ra1; *(uint4*)(b_ + 8192) = ra2; \
      *(uint4*)(b_ + 12288) = ra3; *(uint4*)(b_ + 16384) = rb0; *(uint4*)(b_ + 16384 + 4096) = rb1; }
    G2_LOAD(0);
    G2_STORE(0);
    __syncthreads();
    for (int kt = 0; kt < nk; ++kt) {
        const int st = kt & 1;
        if (kt + 1 < nk) G2_LOAD((kt + 1) * 32);
        const char* la = lds + st * 24576 + (wr * 128 + fr) * 64 + fq * 16;
        const char* lb = lds + st * 24576 + 16384 + (wc * 64 + fr) * 64 + fq * 16;
        bf16x8 bf[4];
#pragma unroll
        for (int i = 0; i < 4; ++i) bf[i] = *(const bf16x8*)(lb + i * 1024);
#pragma unroll
        for (int mi = 0; mi < 8; ++mi) {
            const bf16x8 af = *(const bf16x8*)(la + mi * 1024);
#pragma unroll
            for (int ni = 0; ni < 4; ++ni) acc[mi][ni] = TR ? mma(af, bf[ni], acc[mi][ni]) : mma(bf[ni], af, acc[mi][ni]);
        }
        if (kt + 1 < nk) G2_STORE(st ^ 1);
        __syncthreads();
    }
}

#define RAW_BARRIER() do { asm volatile("s_waitcnt lgkmcnt(0)" ::: "memory"); __builtin_amdgcn_s_barrier(); } while (0)
template <bool TR, int NI>
DEVI void gemm3_main(f32x4 (&acc)[8][NI], char* lds, const bf16_t* A, size_t lda, const bf16_t* Bt, int ldb, int nBmax, int m0, int n0, int K) {
    const int tid = tidx(), lane = tid & 63, wid = __builtin_amdgcn_readfirstlane(tid >> 6), wr = wid >> 1, wc = wid & 1, fr = lane & 15, fq = lane >> 4;
    const int c = tid & 3, r0 = tid >> 2;
    const bf16_t* ap = A + (size_t)(m0 + r0) * lda + c * 8;
    const bf16_t* bp0; const bf16_t* bp1;
    { int nr = n0 + r0; if (nr > nBmax) nr = nBmax; bp0 = Bt + (size_t)nr * ldb + c * 8; nr = n0 + r0 + 64; if (nr > nBmax) nr = nBmax; bp1 = Bt + (size_t)nr * ldb + c * 8; }
    const size_t a64 = (size_t)64 * lda;
    const int nk = K >> 5;
#define G3_ISSUE(kt_, st_)                                                                                                   \
    { char* d_ = lds + (st_) * 24576 + wid * 1024; const int ko_ = (kt_) * 32;                                               \
      __builtin_amdgcn_global_load_lds((const unsigned*)(ap + ko_), (unsigned*)(d_), 16, 0, 0);                               \
      __builtin_amdgcn_global_load_lds((const unsigned*)(ap + a64 + ko_), (unsigned*)(d_ + 4096), 16, 0, 0);                  \
      __builtin_amdgcn_global_load_lds((const unsigned*)(ap + 2 * a64 + ko_), (unsigned*)(d_ + 8192), 16, 0, 0);              \
      __builtin_amdgcn_global_load_lds((const unsigned*)(ap + 3 * a64 + ko_), (unsigned*)(d_ + 12288), 16, 0, 0);             \
      __builtin_amdgcn_global_load_lds((const unsigned*)(bp0 + ko_), (unsigned*)(d_ + 16384), 16, 0, 0);                      \
      if (NI == 4) __builtin_amdgcn_global_load_lds((const unsigned*)(bp1 + ko_), (unsigned*)(d_ + 20480), 16, 0, 0); }
    G3_ISSUE(0, 0);
    G3_ISSUE(1, 1);
    int st = 0;
    for (int kt = 0; kt < nk; ++kt) {
        if (kt + 1 < nk) { if (NI == 4) asm volatile("s_waitcnt vmcnt(6)" ::: "memory"); else asm volatile("s_waitcnt vmcnt(5)" ::: "memory"); }
        else asm volatile("s_waitcnt vmcnt(0)" ::: "memory");
        RAW_BARRIER();
        if (kt + 2 < nk) { const int s2 = st >= 1 ? st - 1 : 2; G3_ISSUE(kt + 2, s2); }
        const char* la = lds + st * 24576 + (wr * 128 + fr) * 64 + fq * 16;
        const char* lb = lds + st * 24576 + 16384 + (wc * NI * 16 + fr) * 64 + fq * 16;
        bf16x8 bf[NI];
#pragma unroll
        for (int i = 0; i < NI; ++i) bf[i] = *(const bf16x8*)(lb + i * 1024);
        __builtin_amdgcn_s_setprio(1);
#pragma unroll
        for (int mi = 0; mi < 8; ++mi) {
            const bf16x8 af = *(const bf16x8*)(la + mi * 1024);
#pragma unroll
            for (int ni = 0; ni < NI; ++ni) acc[mi][ni] = TR ? mma(af, bf[ni], acc[mi][ni]) : mma(bf[ni], af, acc[mi][ni]);
        }
        __builtin_amdgcn_s_setprio(0);
        st = st == 2 ? 0 : st + 1;
    }
    RAW_BARRIER();
}
DEVI void zero_acc2(f32x4 (&acc)[8][4]) {
#pragma unroll
    for (int i = 0; i < 8; ++i)
#pragma unroll
        for (int j = 0; j < 4; ++j) acc[i][j] = (f32x4){0.f, 0.f, 0.f, 0.f};
}
DEVI void rmsnorm_rows(const Params& p, int item) {
    const int thr_ = tidx();
    const int lane = thr_ & 63, wid = thr_ >> 6;
    const int row = item * 4 + wid;
    const float* xr = p.x + (size_t)row * DM;
    f32x4 v[8];
    float ss = 0.f;
#pragma unroll
    for (int i = 0; i < 8; ++i) { v[i] = *(const f32x4*)(xr + (i >> 1) * 512 + lane * 8 + (i & 1) * 4); ss += v[i][0] * v[i][0] + v[i][1] * v[i][1] + v[i][2] * v[i][2] + v[i][3] * v[i][3]; }
    ss = wave_sum(ss);
    const float rs = rsqrtf(ss * (1.f / DM) + 1e-6f);
    bf16_t* hr = (bf16_t*)(p.ws + O_H) + (size_t)row * DM;
#pragma unroll
    for (int i = 0; i < 8; i += 2) {
        const f32x4 g0 = *(const f32x4*)(p.pre_g + (i >> 1) * 512 + lane * 8), g1 = *(const f32x4*)(p.pre_g + (i >> 1) * 512 + lane * 8 + 4);
        *(uint4*)(hr + (i >> 1) * 512 + lane * 8) = make_uint4(pk2(v[i][0] * rs * g0[0], v[i][1] * rs * g0[1]), pk2(v[i][2] * rs * g0[2], v[i][3] * rs * g0[3]),
                                                            pk2(v[i + 1][0] * rs * g1[0], v[i + 1][1] * rs * g1[1]), pk2(v[i + 1][2] * rs * g1[2], v[i + 1][3] * rs * g1[3]));
    }
}
struct TJob { const float* src; bf16_t* dst; int K, ld, width; };
DEVI bool tjob(const Params& p, int j, TJob& t) {
    char* ws = p.ws;
    bf16_t* wint = (bf16_t*)(ws + O_WINT);
    switch (j) {
        case 0: t = {p.w_in, wint, 2048, DIN, 4096}; return true;
        case 1: t = {p.w_in + 4104, wint + (size_t)4096 * 2048, 2048, DIN, 2560}; return true;
        case 2: t = {p.w_in + 6712, wint + (size_t)6656 * 2048, 2048, DIN, 5120}; return true;
        case 3: t = {p.w_in + 4096, wint + (size_t)11776 * 2048, 2048, DIN, 8}; return true;
        case 4: t = {p.w_in + 6664, wint + (size_t)11784 * 2048, 2048, DIN, 48}; return true;
        case 5: t = {nullptr, wint + (size_t)11832 * 2048, 2048, DIN, 72}; return true;
        case 6: t = {p.w_up_m, (bf16_t*)(ws + O_WUM), 1024, 2048, 2048}; return true;
        case 7: t = {p.w_up_a, (bf16_t*)(ws + O_WUA), 1024, 2048, 2048}; return true;
        case 8: t = {p.w_out, (bf16_t*)(ws + O_WOUT), 2048, 2048, 2048}; return true;
        case 9: case 10: case 11: case 12: t = {p.w_q + (j - 9) * 65536, (bf16_t*)(ws + O_WQ) + (j - 9) * 65536, 256, 256, 256}; return true;
        case 13: case 14: case 15: case 16: t = {p.w_k + (j - 13) * 65536, (bf16_t*)(ws + O_WK) + (j - 13) * 65536, 256, 256, 256}; return true;
        case 17: t = {p.w1_k, (bf16_t*)(ws + O_W1K), 2048, 256, 256}; return true;
        case 18: t = {p.w1_v, (bf16_t*)(ws + O_W1V), 2048, 256, 256}; return true;
        case 19: t = {p.w2_k, (bf16_t*)(ws + O_W2K), 256, 64, 64}; return true;
        case 20: t = {p.w2_v, (bf16_t*)(ws + O_W2V), 256, 64, 64}; return true;
        default: return false;
    }
}
constexpr int N_TJOBS = 21;
constexpr int N_TTILES = 4264;
DEVI void transpose_item(const Params& p, int item, char* lds) {
    const int thr_ = tidx();
    TJob t;
    int j = 0;
    for (; j < N_TJOBS; ++j) {
        tjob(p, j, t);
        const int cnt = (t.K >> 6) * ((t.width + 127) >> 7);
        if (item < cnt) break;
        item -= cnt;
    }
    if (j >= N_TJOBS) return;
    const int tk = t.K >> 6;
    const int kt = item % tk, nt = item / tk;
    const int lane = thr_ & 63, wid = thr_ >> 6, kg = lane >> 3, nc = lane & 7;
    const int k0 = kt * 64 + kg * 8, n = nt * 128 + wid * 32 + nc * 4;
    if (n >= t.width) return;
    f32x4 v[8];
    if (t.src) {
        const float* sp = t.src + (size_t)k0 * t.ld + n;
#pragma unroll
        for (int r = 0; r < 8; ++r) v[r] = *(const f32x4*)(sp + (size_t)r * t.ld);
    } else {
#pragma unroll
        for (int r = 0; r < 8; ++r) v[r] = (f32x4){0.f, 0.f, 0.f, 0.f};
    }
    bf16_t* d = t.dst + (size_t)n * t.K + k0;
#pragma unroll
    for (int jj = 0; jj < 4; ++jj)
        *(uint4*)(d + (size_t)jj * t.K) = make_uint4(pk2(v[0][jj], v[1][jj]), pk2(v[2][jj], v[3][jj]), pk2(v[4][jj], v[5][jj]), pk2(v[6][jj], v[7][jj]));
}
DEVI void bias_item(const Params& p, int item) {
    const int thr_ = tidx();
    const int kv = item >> 4, seg = item & 15, j = thr_;
    const float* pe = kv ? p.pe_v : p.pe_k;
    const float* w1 = kv ? p.w1_v : p.w1_k;
    float a = 0.f;
#pragma unroll 8
    for (int k = seg * 128; k < seg * 128 + 128; ++k) a += pe[k] * w1[(size_t)k * 256 + j];
    ((float*)(p.ws + O_B1P))[(kv * 16 + seg) * 256 + j] = a;
}

DEVI void inproj_tile(const Params& p, int item, char* lds) {
    const int ni_ = item >> 5, mt = item & 31;
    const int nt = ni_ < 4 ? 40 + ni_ : (ni_ < 44 ? ni_ - 4 : ni_);
    const int m0 = mt * 256, n0 = nt * 128;
    const bool tr = (nt >= 8 && nt < 16) || nt == 46 || nt == 47 || nt == 50 || nt == 51;
    const int tid = tidx(), lane = tid & 63, wid = tid >> 6, wr = wid >> 1, wc = wid & 1, fr = lane & 15, fq = lane >> 4;
    f32x4 acc[8][4];
    zero_acc2(acc);
    const bf16_t* A = (const bf16_t*)(p.ws + O_H);
    const bf16_t* Bt = (const bf16_t*)(p.ws + O_WINT);
    if (tr) {
        gemm3_main<true, 4>(acc, lds, A, DM, Bt, DM, NP - 1, m0, n0, DM);
        bf16_t* base; int cb, ncol;
        if (nt < 16) { base = (bf16_t*)(p.ws + O_VMT); cb = C_MV; ncol = 1024; }
        else if (nt < 48) { base = (bf16_t*)(p.ws + O_VST); cb = C_VS; ncol = 256; }
        else { base = (bf16_t*)(p.ws + O_VWT); cb = C_VW; ncol = 256; }
#pragma unroll
        for (int mi = 0; mi < 8; mi += 2)
#pragma unroll
            for (int ni = 0; ni < 4; ++ni) {
                const int row = m0 + wr * 128 + (mi + (fq & 1)) * 16 + (fq >> 1) * 8, col = n0 + wc * 64 + ni * 16 + fr - cb;
                const int b = row >> 11, s_ = row & 2047;
                uint2 x, y;
                x.x = pk2(acc[mi][ni][0], acc[mi][ni][1]); x.y = pk2(acc[mi][ni][2], acc[mi][ni][3]);
                y.x = pk2(acc[mi + 1][ni][0], acc[mi + 1][ni][1]); y.y = pk2(acc[mi + 1][ni][2], acc[mi + 1][ni][3]);
                store_nt16(base + ((size_t)(b * ncol + col)) * S + s_, pair16(x, y));
            }
    } else {
        gemm3_main<false, 4>(acc, lds, A, DM, Bt, DM, NP - 1, m0, n0, DM);
        if (n0 == C_GATE) {
            float* G = (float*)(p.ws + O_G);
#pragma unroll
            for (int mi = 0; mi < 8; ++mi)
#pragma unroll
                for (int ni = 0; ni < 4; ++ni) {
                    const int row = m0 + wr * 128 + mi * 16 + fr, cl = wc * 64 + ni * 16 + fq * 4;
                    if (cl < 56) *(f32x4*)(G + (size_t)row * 64 + cl) = acc[mi][ni];
                }
        } else {
            bf16_t* P = (bf16_t*)(p.ws + O_P);
#pragma unroll
            for (int mi = 0; mi < 8; ++mi)
#pragma unroll
                for (int ni = 0; ni < 4; ni += 2) {
                    const int row = m0 + wr * 128 + mi * 16 + fr, col = n0 + wc * 64 + (ni + (fq & 1)) * 16 + (fq >> 1) * 8;
                    uint2 x, y;
                    x.x = pk2(acc[mi][ni][0], acc[mi][ni][1]); x.y = pk2(acc[mi][ni][2], acc[mi][ni][3]);
                    y.x = pk2(acc[mi][ni + 1][0], acc[mi][ni + 1][1]); y.y = pk2(acc[mi][ni + 1][2], acc[mi][ni + 1][3]);
                    store_nt16(P + (size_t)row * NPS + col, pair16(x, y));
                }
        }
    }
    if (ni_ < 4) {
        asm volatile("s_waitcnt vmcnt(0)" ::: "memory");
        __syncthreads();
        if (threadIdx.x == 0) {
            __builtin_amdgcn_fence(__ATOMIC_RELEASE, "agent");
            asm volatile("s_waitcnt vmcnt(0)" ::: "memory");
            xb_add((unsigned*)(p.ws + O_BAR) + 0, 1u);
        }
    }
}

DEVI void conv_item(const Params& p, int item) {
    const int thr_ = tidx();
    const int tok0 = item * 16 + (thr_ >> 7) * 8, c = (thr_ & 127) * 8;
    const int s0 = tok0 & 2047;
    const bf16_t* P = (const bf16_t*)(p.ws + O_P);
    uint4 xr[11];
#pragma unroll
    for (int j = 0; j < 11; ++j) {
        xr[j] = make_uint4(0u, 0u, 0u, 0u);
        if (s0 + j - 3 >= 0) xr[j] = *(const uint4*)(P + (size_t)(tok0 + j - 3) * NPS + C_MX + c);
    }
    f32x4 w[4][2];
#pragma unroll
    for (int k = 0; k < 4; ++k) { w[k][0] = *(const f32x4*)(p.conv_w + k * 1024 + c); w[k][1] = *(const f32x4*)(p.conv_w + k * 1024 + c + 4); }
    const f32x4 b0 = *(const f32x4*)(p.conv_b + c), b1 = *(const f32x4*)(p.conv_b + c + 4);
#pragma unroll
    for (int t = 0; t < 8; ++t) {
        f32x4 a0 = b0, a1 = b1;
#pragma unroll
        for (int k = 0; k < 4; ++k) {
            const uint4 xv = xr[t + k];
            a0 += (f32x4){lo16(xv.x), hi16(xv.x), lo16(xv.y), hi16(xv.y)} * w[k][0];
            a1 += (f32x4){lo16(xv.z), hi16(xv.z), lo16(xv.w), hi16(xv.w)} * w[k][1];
        }
        *(uint4*)((bf16_t*)(p.ws + O_XC) + (size_t)(tok0 + t) * 1024 + c) =
            make_uint4(pk2(silu(a0[0]), silu(a0[1])), pk2(silu(a0[2]), silu(a0[3])), pk2(silu(a1[0]), silu(a1[1])), pk2(silu(a1[2]), silu(a1[3])));
    }
}
struct RowCmp {
    const bf16_t* Pc;
    DEVI const bf16_t* operator()(int r) const {
        if (r > 2031) r = 2031;
        const int bg = r / 127, n = r - bg * 127, b = bg >> 2, g = bg & 3;
        return Pc + (size_t)(b * S + 16 * n) * NPS + g * 64;
    }
};
DEVI void cmp1_tile(const Params& p, int item, char* lds) {
    const int kv = item >> 5, mt = (item >> 1) & 15, nt = item & 1;
    const int m0 = mt * 128, n0 = nt * 128;
    const int tid = tidx(), lane = tid & 63, wid = tid >> 6, wr = wid >> 1, wc = wid & 1, fr = lane & 15, fq = lane >> 4;
    f32x4 acc[4][4];
    zero_acc(acc);
    RowCmp rc{(const bf16_t*)(p.ws + O_P) + (kv ? C_VC : C_KC)};
    gemm_main<false, 4>(acc, lds, rc, (size_t)NPS, (const bf16_t*)(p.ws + (kv ? O_W1V : O_W1K)), 2048, 255, m0, n0, 2048);
    const float* bp = (const float*)(p.ws + O_B1P) + kv * 16 * 256;
    bf16_t* HC = (bf16_t*)(p.ws + O_HC) + (size_t)kv * 2048 * 256;
#pragma unroll
    for (int ni = 0; ni < 4; ++ni) {
        const int col = n0 + wc * 64 + ni * 16 + fq * 4;
        f32x4 bs = {0.f, 0.f, 0.f, 0.f};
        for (int sg = 0; sg < 16; ++sg) bs += *(const f32x4*)(bp + sg * 256 + col);
#pragma unroll
        for (int mi = 0; mi < 4; ++mi) {
            const int row = m0 + wr * 64 + mi * 16 + fr;
            const f32x4 v = acc[mi][ni] + bs;
            uint2 o; o.x = pk2(silu(v[0]), silu(v[1])); o.y = pk2(silu(v[2]), silu(v[3]));
            *(uint2*)(HC + (size_t)row * 256 + col) = o;
        }
    }
}
DEVI void scan_item(const Params& p, int item, char* lds) {
    const int thr_ = tidx();
    const int b = item >> 2, h = item & 3, tid = thr_;
    const float* G = (const float*)(p.ws + O_G);
    float* red = (float*)lds;
    const float bi = p.b_i[h], bfv = p.b_f[h];
    float ig[8], F[8];
    float run = 0.f;
#pragma unroll
    for (int i = 0; i < 8; ++i) {
        const size_t tok = (size_t)b * S + tid * 8 + i;
        ig[i] = G[tok * 64 + h] + bi;
        const float fg = G[tok * 64 + 4 + h] + bfv;
        const float lf = fminf(fg, 0.f) - log1pf(expf(-fabsf(fg)));
        run += lf;
        F[i] = run;
    }
    red[tid] = run;
    __syncthreads();
    float ex = 0.f;
    for (int j = 0; j < tid; ++j) ex += red[j];
    __syncthreads();
    float a[8], mx[8];
    float rm = -1e30f;
#pragma unroll
    for (int i = 0; i < 8; ++i) { F[i] += ex; a[i] = ig[i] - F[i]; rm = fmaxf(rm, a[i]); mx[i] = rm; }
    red[tid] = rm;
    __syncthreads();
    float em = -1e30f;
    for (int j = 0; j < tid; ++j) em = fmaxf(em, red[j]);
    __syncthreads();
    float* FA = (float*)(p.ws + O_FA) + item * S + tid * 8;
    float* FM = (float*)(p.ws + O_FM) + item * S + tid * 8;
    float* FL = (float*)(p.ws + O_FL) + item * S + tid * 8;
#pragma unroll
    for (int i = 0; i < 8; ++i) { const float m = fmaxf(mx[i], em); FA[i] = a[i]; FM[i] = m; FL[i] = F[i] + m; }
}

DEVI void qk_tile(const Params& p, int item, char* lds) {
    const int nt = item & 1, mt = (item >> 1) & 63, h = (item >> 7) & 3, qk = item >> 9;
    const int m0 = mt * 128, n0 = nt * 128;
    const int tid = tidx(), lane = tid & 63, wid = tid >> 6, wr = wid >> 1, wc = wid & 1, fr = lane & 15, fq = lane >> 4;
    f32x4 acc[4][4];
    zero_acc(acc);
    RowLin rl{(const bf16_t*)(p.ws + O_XC) + h * 256, (size_t)1024};
    gemm_main<false, 4>(acc, lds, rl, 64, (const bf16_t*)(p.ws + (qk ? O_WK : O_WQ)) + h * 65536, 256, 255, m0, n0, 256);
    bf16_t* O = (bf16_t*)(p.ws + (qk ? O_KM : O_QM));
    const float sc = qk ? 0.0625f : 1.f;
#pragma unroll
    for (int mi = 0; mi < 4; ++mi)
#pragma unroll
        for (int ni = 0; ni < 4; ni += 2) {
            const int row = m0 + wr * 64 + mi * 16 + fr, col = h * 256 + n0 + wc * 64 + (ni + (fq & 1)) * 16 + (fq >> 1) * 8;
            uint2 x, y;
            x.x = pk2(acc[mi][ni][0] * sc, acc[mi][ni][1] * sc); x.y = pk2(acc[mi][ni][2] * sc, acc[mi][ni][3] * sc);
            y.x = pk2(acc[mi][ni + 1][0] * sc, acc[mi][ni + 1][1] * sc); y.y = pk2(acc[mi][ni + 1][2] * sc, acc[mi][ni + 1][3] * sc);
            *(uint4*)(O + (size_t)row * 1024 + col) = pair16(x, y);
        }
}
DEVI void cmp2_tile(const Params& p, int item, char* lds) {
    const int kv = item >> 4, mt = item & 15, m0 = mt * 128;
    const int tid = tidx(), lane = tid & 63, wid = tid >> 6, wr = wid >> 1, wc = wid & 1, fr = lane & 15, fq = lane >> 4;
    f32x4 acc[4][4];
    zero_acc(acc);
    RowLin rl{(const bf16_t*)(p.ws + O_HC) + (size_t)kv * 2048 * 256, (size_t)256};
    gemm_main<false, 4>(acc, lds, rl, 64, (const bf16_t*)(p.ws + (kv ? O_W2V : O_W2K)), 256, 63, m0, 0, 256);
    float* O = (float*)(p.ws + (kv ? O_VCF : O_KCF));
    if (wc == 0) {
#pragma unroll
        for (int mi = 0; mi < 4; ++mi)
#pragma unroll
            for (int ni = 0; ni < 4; ++ni) {
                const int row = m0 + wr * 64 + mi * 16 + fr, col = ni * 16 + fq * 4;
                if (row < 2032) *(f32x4*)(O + (size_t)row * 64 + col) = acc[mi][ni];
            }
    }
}

DEVI void mlstm_item(const Params& p, int item) {
    const int thr_ = tidx();
    const int qb = 31 - (item >> 4), bh = item & 15, b = bh >> 2, h = bh & 3;
    const int lane = thr_ & 63, wid = __builtin_amdgcn_readfirstlane(thr_ >> 6), fr = lane & 15, fq = lane >> 4;
    const int t0 = qb * 64 + wid * 16, trow = t0 + fr;
    const bf16_t* Qm = (const bf16_t*)(p.ws + O_QM);
    const bf16_t* Km = (const bf16_t*)(p.ws + O_KM);
    const bf16_t* VmT = (const bf16_t*)(p.ws + O_VMT);
    const float* fa = (const float*)(p.ws + O_FA) + bh * S;
    const float mx = ((const float*)(p.ws + O_FM))[bh * S + trow];
    bf16x8 qf[8];
    {
        const bf16_t* qrow = Qm + (size_t)(b * S + trow) * 1024 + h * 256 + fq * 8;
#pragma unroll
        for (int ks = 0; ks < 8; ++ks) qf[ks] = *(const bf16x8*)(qrow + ks * 32);
    }
    f32x4 o[16];
#pragma unroll
    for (int i = 0; i < 16; ++i) o[i] = (f32x4){0.f, 0.f, 0.f, 0.f};
    float den = 0.f;
    const bf16_t* kbase = Km + (size_t)(b * S + fr) * 1024 + h * 256 + fq * 8;
    const bf16_t* vbase = VmT + ((size_t)(b * 1024 + h * 256 + fr)) * S + fq * 4;
    for (int s0 = 0; s0 < t0 + 16; s0 += 32) {
        f32x4 sa = {0.f, 0.f, 0.f, 0.f}, sb = {0.f, 0.f, 0.f, 0.f};
        const bf16_t* k0 = kbase + (size_t)s0 * 1024;
        const bf16_t* k1 = k0 + 16 * 1024;
#pragma unroll
        for (int ks = 0; ks < 8; ++ks) {
            sa = mma(*(const bf16x8*)(k0 + ks * 32), qf[ks], sa);
            sb = mma(*(const bf16x8*)(k1 + ks * 32), qf[ks], sb);
            if (ks == 3) __builtin_amdgcn_sched_barrier(0);
        }
        __builtin_amdgcn_sched_barrier(0);
        const f32x4 a0 = *(const f32x4*)(fa + s0 + fq * 4), a1 = *(const f32x4*)(fa + s0 + 16 + fq * 4);
        float pv[8];
#pragma unroll
        for (int r = 0; r < 4; ++r) {
            const int s = s0 + fq * 4 + r;
            const float w0 = (s <= trow) ? __expf(a0[r] - mx) : 0.f;
            const float w1 = (s + 16 <= trow) ? __expf(a1[r] - mx) : 0.f;
            pv[r] = sa[r] * w0; pv[4 + r] = sb[r] * w1;
            den += pv[r] + pv[4 + r];
        }
        const bf16x8 pf = pack8(pv);
#pragma unroll
        for (int dvt = 0; dvt < 16; ++dvt) {
            const bf16_t* vp = vbase + (size_t)(dvt * 16) * S + s0;
            const bf16x8 vf = join8(*(const uint2*)vp, *(const uint2*)(vp + 16));
            o[dvt] = mma(vf, pf, o[dvt]);
            if ((dvt & 3) == 3) __builtin_amdgcn_sched_barrier(0);
        }
    }
    den += __shfl_xor(den, 16);
    den += __shfl_xor(den, 32);
    const float lower = __expf(-((const float*)(p.ws + O_FL))[bh * S + trow]);
    const float inv = 1.f / fmaxf(fabsf(den), lower);
    const bf16_t* Prow = (const bf16_t*)(p.ws + O_P) + (size_t)(b * S + trow) * NPS;
    float sum = 0.f;
#pragma unroll
    for (int dvt = 0; dvt < 16; ++dvt) {
        const int c = h * 256 + dvt * 16 + fq * 4;
        const uint2 op = *(const uint2*)(Prow + C_MO + c);
        o[dvt][0] *= inv * sigm(lo16(op.x)); o[dvt][1] *= inv * sigm(hi16(op.x)); o[dvt][2] *= inv * sigm(lo16(op.y)); o[dvt][3] *= inv * sigm(hi16(op.y));
        sum += o[dvt][0] + o[dvt][1] + o[dvt][2] + o[dvt][3];
    }
    sum += __shfl_xor(sum, 16);
    sum += __shfl_xor(sum, 32);
    const float mu = sum * (1.f / 256.f);
    float vs = 0.f;
#pragma unroll
    for (int dvt = 0; dvt < 16; ++dvt)
#pragma unroll
        for (int r = 0; r < 4; ++r) { const float d = o[dvt][r] - mu; vs += d * d; }
    vs += __shfl_xor(vs, 16);
    vs += __shfl_xor(vs, 32);
    const float rstd = rsqrtf(vs * (1.f / 256.f) + 1e-6f);
    const bf16_t* xcrow = (const bf16_t*)(p.ws + O_XC) + (size_t)(b * S + trow) * 1024;
    bf16_t* ymrow = (bf16_t*)(p.ws + O_YM) + (size_t)(b * S + trow) * 1024;
#pragma unroll
    for (int dvt = 0; dvt < 16; ++dvt) {
        const int c = h * 256 + dvt * 16 + fq * 4;
        const f32x4 ng = *(const f32x4*)(p.norm_g + c), sk = *(const f32x4*)(p.skip + c);
        const uint2 xc = *(const uint2*)(xcrow + c), mz = *(const uint2*)(Prow + C_MZ + c);
        const float y0 = ((o[dvt][0] - mu) * rstd * ng[0] + sk[0] * lo16(xc.x)) * silu(lo16(mz.x));
        const float y1 = ((o[dvt][1] - mu) * rstd * ng[1] + sk[1] * hi16(xc.x)) * silu(hi16(mz.x));
        const float y2 = ((o[dvt][2] - mu) * rstd * ng[2] + sk[2] * lo16(xc.y)) * silu(lo16(mz.y));
        const float y3 = ((o[dvt][3] - mu) * rstd * ng[3] + sk[3] * hi16(xc.y)) * silu(hi16(mz.y));
        uint2 ov; ov.x = pk2(y0, y1); ov.y = pk2(y2, y3);
        *(uint2*)(ymrow + c) = ov;
    }
}

DEVI void cmp_item(const Params& p, int item, char* lds) {
    const int thr_ = tidx();
    const int tt = item & 31, bg = item >> 5, b = bg >> 2, g = bg & 3;
    const int lane = thr_ & 63, wid = __builtin_amdgcn_readfirstlane(thr_ >> 6);
    float* kcs = (float*)lds;
    float* psum = (float*)(lds + 33280) + wid * 128;
    const float* KC = (const float*)(p.ws + O_KCF) + (size_t)bg * 127 * 64;
    const float* VC = (const float*)(p.ws + O_VCF) + (size_t)bg * 127 * 64;
    for (int i = thr_; i < 127 * 64; i += 256) kcs[(i >> 6) * 65 + (i & 63)] = KC[i];
    __syncthreads();
    const bf16_t* P = (const bf16_t*)(p.ws + O_P);
    bf16_t* OC = (bf16_t*)(p.ws + O_OC);
    unsigned* SEL = (unsigned*)(p.ws + O_SEL);
#pragma unroll 1
    for (int i = 0; i < 16; ++i) {
        const int t = tt * 64 + wid * 16 + i;
        const size_t tok = (size_t)b * S + t;
        const int nvalid = t >= 31 ? ((t - 31) >> 4) + 1 : 0;
        unsigned mask = 1u;
        if (nvalid == 0) {
#pragma unroll
            for (int h = 0; h < 4; ++h) OC[tok * 1024 + (g * 4 + h) * 64 + lane] = 0;
        } else {
            float qh[4];
#pragma unroll
            for (int h = 0; h < 4; ++h) qh[h] = bf2f(P[tok * NPS + C_AQ + (g * 4 + h) * 64 + lane]) * 0.125f;
            float s0[4] = {0.f, 0.f, 0.f, 0.f}, s1[4] = {0.f, 0.f, 0.f, 0.f};
            const int n1 = lane + 64 > 126 ? 126 : lane + 64;
            const float* k0p = kcs + lane * 65;
            const float* k1p = kcs + n1 * 65;
#pragma unroll
            for (int d = 0; d < 64; ++d) {
                const float k0 = k0p[d], k1 = k1p[d];
#pragma unroll
                for (int h = 0; h < 4; ++h) { const float qd = rdlane(qh[h], d); s0[h] += qd * k0; s1[h] += qd * k1; }
            }
            const bool v0 = lane < nvalid, v1 = lane + 64 < nvalid;
            float p0[4], p1[4];
#pragma unroll
            for (int h = 0; h < 4; ++h) {
                const float mxv = wave_max(fmaxf(v0 ? s0[h] : -1e30f, v1 ? s1[h] : -1e30f));
                const float e0 = v0 ? __expf(s0[h] - mxv) : 0.f, e1 = v1 ? __expf(s1[h] - mxv) : 0.f;
                const float sm = wave_sum(e0 + e1);
                const float is = 1.f / sm;
                p0[h] = e0 * is; p1[h] = e1 * is;
            }
            float oc[4] = {0.f, 0.f, 0.f, 0.f};
            const int na = nvalid < 64 ? nvalid : 64;
            for (int n = 0; n < na; ++n) {
                const float vv = VC[n * 64 + lane];
#pragma unroll
                for (int h = 0; h < 4; ++h) oc[h] += rdlane(p0[h], n) * vv;
            }
            for (int n = 64; n < nvalid; ++n) {
                const float vv = VC[n * 64 + lane];
#pragma unroll
                for (int h = 0; h < 4; ++h) oc[h] += rdlane(p1[h], n - 64) * vv;
            }
#pragma unroll
            for (int h = 0; h < 4; ++h) OC[tok * 1024 + (g * 4 + h) * 64 + lane] = f2bf(oc[h]);
            psum[lane] = p0[0] + p0[1] + p0[2] + p0[3];
            psum[lane + 64] = (lane + 64 < 127) ? (p1[0] + p1[1] + p1[2] + p1[3]) : 0.f;
            __builtin_amdgcn_wave_barrier();
            float sc = -3e30f;
            const int cur = t >> 6;
            if (lane < 32) {
                float imp = 0.f;
#pragma unroll
                for (int k = -1; k < 4; ++k) { const int n = 4 * lane + k; if (n >= 0) imp += psum[n]; }
                const bool forced = lane == 0 || lane == cur || lane == cur - 1;
                sc = forced ? 1e30f : (lane <= cur ? imp : -1e30f);
            }
            __builtin_amdgcn_wave_barrier();
            mask = 0u;
#pragma unroll 1
            for (int it = 0; it < 8; ++it) {
                const float mv = wave_max(sc);
                const unsigned long long bal = __ballot(sc == mv);
                const int win = __ffsll((long long)bal) - 1;
                mask |= 1u << win;
                if (lane == win) sc = -4e30f;
            }
        }
        if (lane == 0) SEL[bg * S + t] = mask;
    }
    __syncthreads();
}

DEVI void attn_chunk(f32x4 (&o)[4], float& m, float& l, bf16x8 q0, bf16x8 q1, const bf16_t* kp, const bf16_t* vp, unsigned vm) {
    f32x4 sa = {0.f, 0.f, 0.f, 0.f}, sb = {0.f, 0.f, 0.f, 0.f};
    sa = mma(*(const bf16x8*)(kp), q0, sa);
    sa = mma(*(const bf16x8*)(kp + 32), q1, sa);
    sb = mma(*(const bf16x8*)(kp + (size_t)16 * NPS), q0, sb);
    sb = mma(*(const bf16x8*)(kp + (size_t)16 * NPS + 32), q1, sb);
    float v[8];
#pragma unroll
    for (int r = 0; r < 4; ++r) { v[r] = sa[r] * 0.125f; v[4 + r] = sb[r] * 0.125f; }
    float mxv = -1e30f;
#pragma unroll
    for (int e = 0; e < 8; ++e) if ((vm >> e) & 1u) mxv = fmaxf(mxv, v[e]);
    mxv = fmaxf(mxv, __shfl_xor(mxv, 16));
    mxv = fmaxf(mxv, __shfl_xor(mxv, 32));
    const float mn = fmaxf(m, mxv);
    const float alpha = __expf(m - mn);
    m = mn;
    float ps = 0.f;
#pragma unroll
    for (int e = 0; e < 8; ++e) { v[e] = ((vm >> e) & 1u) ? __expf(v[e] - mn) : 0.f; ps += v[e]; }
    l = l * alpha + ps;
    const bf16x8 pf = pack8(v);
#pragma unroll
    for (int dvt = 0; dvt < 4; ++dvt) {
        o[dvt] *= alpha;
        const bf16_t* vq = vp + (size_t)(dvt * 16) * S;
        const bf16x8 vf = join8(*(const uint2*)vq, *(const uint2*)(vq + 16));
        o[dvt] = mma(vf, pf, o[dvt]);
    }
}
template <bool SELB>
DEVI void nsa_item(const Params& p, int item) {
    const int thr_ = tidx();
    const int tile = item & 127, bg = item >> 7, b = bg >> 2, g = bg & 3;
    const int lane = thr_ & 63, wid = __builtin_amdgcn_readfirstlane(thr_ >> 6), fr = lane & 15, fq = lane >> 4;
    const int hd = g * 4 + wid, t0 = tile * 16, trow = t0 + fr;
    const bf16_t* P = (const bf16_t*)(p.ws + O_P);
    const size_t tok = (size_t)b * S + trow;
    const bf16_t* qp = P + tok * NPS + C_AQ + hd * 64 + fq * 8;
    const bf16x8 q0 = *(const bf16x8*)qp, q1 = *(const bf16x8*)(qp + 32);
    const bf16_t* kb = P + (size_t)(b * S + fr) * NPS + (SELB ? C_KS : C_KW) + g * 64 + fq * 8;
    const bf16_t* vb = (const bf16_t*)(p.ws + (SELB ? O_VST : O_VWT)) + (size_t)(b * 256 + g * 64 + fr) * S + fq * 4;
    f32x4 o[4];
#pragma unroll
    for (int i = 0; i < 4; ++i) o[i] = (f32x4){0.f, 0.f, 0.f, 0.f};
    float m = -1e30f, l = 0.f;
    if (!SELB) {
        int lo = t0 - 511;
        if (lo < 0) lo = 0;
        for (int s0 = lo & ~31; s0 < t0 + 16; s0 += 32) {
            unsigned vm = 0;
#pragma unroll
            for (int e = 0; e < 8; ++e) { const int s = s0 + (e >> 2) * 16 + fq * 4 + (e & 3); if (s <= trow && s > trow - 512) vm |= 1u << e; }
            attn_chunk(o, m, l, q0, q1, kb + (size_t)s0 * NPS, vb + s0, vm);
        }
    } else {
        const unsigned rm = ((const unsigned*)(p.ws + O_SEL))[bg * S + trow];
        unsigned un = rm;
        un |= __shfl_xor(un, 1); un |= __shfl_xor(un, 2); un |= __shfl_xor(un, 4); un |= __shfl_xor(un, 8);
        un = __builtin_amdgcn_readfirstlane(un);
        const int cur = t0 >> 6;
        for (int j = 0; j <= cur; ++j) {
            if (!((un >> j) & 1u)) continue;
            const bool rs = (rm >> j) & 1u;
#pragma unroll
            for (int hf = 0; hf < 2; ++hf) {
                const int s0 = j * 64 + hf * 32;
                unsigned vm = 0;
#pragma unroll
                for (int e = 0; e < 8; ++e) { const int s = s0 + (e >> 2) * 16 + fq * 4 + (e & 3); if (rs && s <= trow) vm |= 1u << e; }
                attn_chunk(o, m, l, q0, q1, kb + (size_t)s0 * NPS, vb + s0, vm);
            }
        }
    }
    l += __shfl_xor(l, 16);
    l += __shfl_xor(l, 32);
    const float inv = 1.f / l;
    if (!SELB) {
        bf16_t* OW = (bf16_t*)(p.ws + O_OW) + tok * 1024 + hd * 64 + fq * 4;
#pragma unroll
        for (int dvt = 0; dvt < 4; ++dvt) {
            uint2 ov; ov.x = pk2(o[dvt][0] * inv, o[dvt][1] * inv); ov.y = pk2(o[dvt][2] * inv, o[dvt][3] * inv);
            *(uint2*)(OW + dvt * 16) = ov;
        }
    } else {
        const float* G = (const float*)(p.ws + O_G) + tok * 64 + 8 + hd * 3;
        const float g0 = sigm(G[0]), g1 = sigm(G[1]) * inv, g2 = sigm(G[2]);
        const bf16_t* OC = (const bf16_t*)(p.ws + O_OC) + tok * 1024 + hd * 64 + fq * 4;
        const bf16_t* OW = (const bf16_t*)(p.ws + O_OW) + tok * 1024 + hd * 64 + fq * 4;
        const bf16_t* AZ = P + tok * NPS + C_AZ + hd * 64 + fq * 4;
        bf16_t* YA = (bf16_t*)(p.ws + O_YA) + tok * 1024 + hd * 64 + fq * 4;
#pragma unroll
        for (int dvt = 0; dvt < 4; ++dvt) {
            const uint2 oc = *(const uint2*)(OC + dvt * 16), ow = *(const uint2*)(OW + dvt * 16), az = *(const uint2*)(AZ + dvt * 16);
            const float y0 = (g0 * lo16(oc.x) + g1 * o[dvt][0] + g2 * lo16(ow.x)) * silu(lo16(az.x));
            const float y1 = (g0 * hi16(oc.x) + g1 * o[dvt][1] + g2 * hi16(ow.x)) * silu(hi16(az.x));
            const float y2 = (g0 * lo16(oc.y) + g1 * o[dvt][2] + g2 * lo16(ow.y)) * silu(lo16(az.y));
            const float y3 = (g0 * hi16(oc.y) + g1 * o[dvt][3] + g2 * hi16(ow.y)) * silu(hi16(az.y));
            uint2 ov; ov.x = pk2(y0, y1); ov.y = pk2(y2, y3);
            *(uint2*)(YA + dvt * 16) = ov;
        }
    }
}


constexpr int ML_K = 16384, ML_V = 20480, ML_STAGE = ML_K + ML_V;
DEVI void mlstm2_item(const Params& p, int item, char* lds) {
    const int thr_ = tidx();
    const int half = item >> 8, idx = item & 255;
    const int qb = half ? (idx >> 4) : 31 - (idx >> 4), bh = idx & 15, b = bh >> 2, h = bh & 3;
    const int lane = thr_ & 63, wid = __builtin_amdgcn_readfirstlane(thr_ >> 6), fr = lane & 15, fq = lane >> 4;
    const int T0 = qb * 64, t0 = T0 + wid * 16, trow = t0 + fr;
    const bf16_t* Km = (const bf16_t*)(p.ws + O_KM) + (size_t)(b * S) * 1024 + h * 256;
    const bf16_t* VmT = (const bf16_t*)(p.ws + O_VMT) + (size_t)(b * 1024 + h * 256) * S;
    const float* fa = (const float*)(p.ws + O_FA) + bh * S;
    const float mx = ((const float*)(p.ws + O_FM))[bh * S + trow];
    bf16x8 qf[8];
    {
        const bf16_t* qrow = (const bf16_t*)(p.ws + O_QM) + (size_t)(b * S + trow) * 1024 + h * 256 + fq * 8;
#pragma unroll
        for (int ks = 0; ks < 8; ++ks) qf[ks] = *(const bf16x8*)(qrow + ks * 32);
    }
    f32x4 o[16];
#pragma unroll
    for (int i = 0; i < 16; ++i) o[i] = (f32x4){0.f, 0.f, 0.f, 0.f};
    float den = 0.f;
    const int kr = thr_ >> 5, kc = thr_ & 31, vr = thr_ >> 2, vc = thr_ & 3;
    uint4 rk0, rk1, rk2, rk3, rv0, rv1, rv2, rv3;
#define ML_GLOAD(s0_)                                                                      \
    {                                                                                      \
        const bf16_t* kp_ = Km + (size_t)((s0_) + kr) * 1024 + kc * 8;                     \
        rk0 = *(const uint4*)(kp_); rk1 = *(const uint4*)(kp_ + 8 * 1024);                 \
        rk2 = *(const uint4*)(kp_ + 16 * 1024); rk3 = *(const uint4*)(kp_ + 24 * 1024);    \
        const bf16_t* vp_ = VmT + (size_t)vr * S + (s0_) + vc * 8;                         \
        rv0 = *(const uint4*)(vp_); rv1 = *(const uint4*)(vp_ + (size_t)64 * S);           \
        rv2 = *(const uint4*)(vp_ + (size_t)128 * S); rv3 = *(const uint4*)(vp_ + (size_t)192 * S); \
    }
#define ML_LSTORE(st_)                                                                     \
    {                                                                                      \
        char* kb_ = lds + (st_) * ML_STAGE + (kc >> 2) * 2048 + kr * 64 + (kc & 3) * 16;   \
        *(uint4*)(kb_) = rk0; *(uint4*)(kb_ + 8 * 64) = rk1; *(uint4*)(kb_ + 16 * 64) = rk2; *(uint4*)(kb_ + 24 * 64) = rk3; \
        char* vb_ = lds + (st_) * ML_STAGE + ML_K + vr * 80 + vc * 16;                     \
        *(uint4*)(vb_) = rv0; *(uint4*)(vb_ + 64 * 80) = rv1; *(uint4*)(vb_ + 128 * 80) = rv2; *(uint4*)(vb_ + 192 * 80) = rv3; \
    }
    const int nch = 2 * qb + 2;
    ML_GLOAD(0);
    ML_LSTORE(0);
    __syncthreads();
    for (int ci = 0; ci < nch; ++ci) {
        const int s0 = ci * 32, st = ci & 1;
        if (ci + 1 < nch) ML_GLOAD(s0 + 32);
        if (s0 < t0 + 16) {
            __builtin_amdgcn_s_setprio(1);
            const char* kb = lds + st * ML_STAGE;
            const char* vb = kb + ML_K;
            const f32x4 a0 = *(const f32x4*)(fa + s0 + fq * 4), a1 = *(const f32x4*)(fa + s0 + 16 + fq * 4);
            f32x4 sa = {0.f, 0.f, 0.f, 0.f}, sb = {0.f, 0.f, 0.f, 0.f};
#pragma unroll
            for (int ks = 0; ks < 8; ++ks) {
                sa = mma(*(const bf16x8*)(kb + ks * 2048 + fr * 64 + fq * 16), qf[ks], sa);
                sb = mma(*(const bf16x8*)(kb + ks * 2048 + (16 + fr) * 64 + fq * 16), qf[ks], sb);
            }
            float pv[8];
#pragma unroll
            for (int r = 0; r < 4; ++r) {
                const int s = s0 + fq * 4 + r;
                const float w0 = (s <= trow) ? __expf(a0[r] - mx) : 0.f;
                const float w1 = (s + 16 <= trow) ? __expf(a1[r] - mx) : 0.f;
                pv[r] = sa[r] * w0; pv[4 + r] = sb[r] * w1;
                den += pv[r] + pv[4 + r];
            }
            const bf16x8 pf = pack8(pv);
#pragma unroll
            for (int dvt = 0; dvt < 16; ++dvt) {
                const char* vp = vb + (dvt * 16 + fr) * 80 + fq * 8;
                const bf16x8 vf = join8(*(const uint2*)vp, *(const uint2*)(vp + 32));
                o[dvt] = mma(vf, pf, o[dvt]);
            }
            __builtin_amdgcn_s_setprio(0);
        }
        if (ci + 1 < nch) ML_LSTORE(st ^ 1);
        __syncthreads();
    }
    den += __shfl_xor(den, 16);
    den += __shfl_xor(den, 32);
    const float lower = __expf(-((const float*)(p.ws + O_FL))[bh * S + trow]);
    const float inv = 1.f / fmaxf(fabsf(den), lower);
    const bf16_t* Prow = (const bf16_t*)(p.ws + O_P) + (size_t)(b * S + trow) * NPS;
    float sum = 0.f;
#pragma unroll
    for (int dvt = 0; dvt < 16; ++dvt) {
        const int c = h * 256 + dvt * 16 + fq * 4;
        const uint2 op = *(const uint2*)(Prow + C_MO + c);
        o[dvt][0] *= inv * sigm(lo16(op.x)); o[dvt][1] *= inv * sigm(hi16(op.x)); o[dvt][2] *= inv * sigm(lo16(op.y)); o[dvt][3] *= inv * sigm(hi16(op.y));
        sum += o[dvt][0] + o[dvt][1] + o[dvt][2] + o[dvt][3];
    }
    sum += __shfl_xor(sum, 16);
    sum += __shfl_xor(sum, 32);
    const float mu = sum * (1.f / 256.f);
    float vs = 0.f;
#pragma unroll
    for (int dvt = 0; dvt < 16; ++dvt)
#pragma unroll
        for (int r = 0; r < 4; ++r) { const float d = o[dvt][r] - mu; vs += d * d; }
    vs += __shfl_xor(vs, 16);
    vs += __shfl_xor(vs, 32);
    const float rstd = rsqrtf(vs * (1.f / 256.f) + 1e-6f);
    const bf16_t* xcrow = (const bf16_t*)(p.ws + O_XC) + (size_t)(b * S + trow) * 1024;
    bf16_t* ymrow = (bf16_t*)(p.ws + O_YM) + (size_t)(b * S + trow) * 1024;
#pragma unroll
    for (int dv2 = 0; dv2 < 16; dv2 += 2) {
        uint2 ov[2];
#pragma unroll
        for (int q = 0; q < 2; ++q) {
            const int dvt = dv2 + q, c = h * 256 + dvt * 16 + fq * 4;
            const f32x4 ng = *(const f32x4*)(p.norm_g + c), sk = *(const f32x4*)(p.skip + c);
            const uint2 xc = *(const uint2*)(xcrow + c), mz = *(const uint2*)(Prow + C_MZ + c);
            const float y0 = ((o[dvt][0] - mu) * rstd * ng[0] + sk[0] * lo16(xc.x)) * silu(lo16(mz.x));
            const float y1 = ((o[dvt][1] - mu) * rstd * ng[1] + sk[1] * hi16(xc.x)) * silu(hi16(mz.x));
            const float y2 = ((o[dvt][2] - mu) * rstd * ng[2] + sk[2] * lo16(xc.y)) * silu(lo16(mz.y));
            const float y3 = ((o[dvt][3] - mu) * rstd * ng[3] + sk[3] * hi16(xc.y)) * silu(hi16(mz.y));
            ov[q].x = pk2(y0, y1); ov[q].y = pk2(y2, y3);
        }
        *(uint4*)(ymrow + h * 256 + (dv2 + (fq & 1)) * 16 + (fq >> 1) * 8) = pair16(ov[0], ov[1]);
    }
}


constexpr int CM_K = 16384, CM_VS = 272;
DEVI void cmp3_item(const Params& p, int item, char* lds) {
    const int thr_ = tidx();
    const int tile = item & 31, bg = item >> 5, b = bg >> 2, g = bg & 3;
    const int lane = thr_ & 63, wid = __builtin_amdgcn_readfirstlane(thr_ >> 6), fr = lane & 15, fq = lane >> 4;
    const int T0 = tile * 64, t0 = T0 + wid * 16, trow = t0 + fr, cur = tile;
    const float* KC = (const float*)(p.ws + O_KCF) + (size_t)bg * 127 * 64;
    const float* VC = (const float*)(p.ws + O_VCF) + (size_t)bg * 127 * 64;
    for (int i = 0; i < 32; ++i) {
        const int n = i * 4 + (thr_ >> 6), d = thr_ & 63;
        const float kv = n < 127 ? KC[n * 64 + d] : 0.f, vv = n < 127 ? VC[n * 64 + d] : 0.f;
        *(bf16_t*)(lds + (d >> 5) * 8192 + n * 64 + (d & 31) * 2) = f2bf(kv);
        *(bf16_t*)(lds + CM_K + d * CM_VS + n * 2) = f2bf(vv);
    }
    __syncthreads();
    const bf16_t* P = (const bf16_t*)(p.ws + O_P);
    const size_t tok = (size_t)b * S + trow;
    bf16x8 qf[4][2];
#pragma unroll
    for (int h = 0; h < 4; ++h) {
        const bf16_t* qp = P + tok * NPS + C_AQ + (g * 4 + h) * 64 + fq * 8;
        qf[h][0] = *(const bf16x8*)qp; qf[h][1] = *(const bf16x8*)(qp + 32);
    }
    const int nv = trow >= 31 ? ((trow - 31) >> 4) + 1 : 0;
    const int nvw = t0 + 15 >= 31 ? ((t0 + 15 - 31) >> 4) + 1 : 0;
    const int nchunk = (nvw + 31) >> 5;
    float m[4], l[4];
#pragma unroll
    for (int h = 0; h < 4; ++h) { m[h] = -1e30f; l[h] = 0.f; }
    for (int c = 0; c < nchunk; ++c) {
        bf16x8 kf[2][2];
#pragma unroll
        for (int stl = 0; stl < 2; ++stl)
#pragma unroll
            for (int ks = 0; ks < 2; ++ks) kf[stl][ks] = *(const bf16x8*)(lds + ks * 8192 + (c * 32 + stl * 16 + fr) * 64 + fq * 16);
        unsigned vm = 0;
#pragma unroll
        for (int e = 0; e < 8; ++e) { const int n = c * 32 + (e >> 2) * 16 + fq * 4 + (e & 3); if (n < nv) vm |= 1u << e; }
#pragma unroll
        for (int h = 0; h < 4; ++h) {
            f32x4 sa = {0.f, 0.f, 0.f, 0.f}, sb = {0.f, 0.f, 0.f, 0.f};
            sa = mma(kf[0][0], qf[h][0], sa); sa = mma(kf[0][1], qf[h][1], sa);
            sb = mma(kf[1][0], qf[h][0], sb); sb = mma(kf[1][1], qf[h][1], sb);
            float v[8];
#pragma unroll
            for (int r = 0; r < 4; ++r) { v[r] = sa[r] * 0.125f; v[4 + r] = sb[r] * 0.125f; }
            float mxv = -1e30f;
#pragma unroll
            for (int e = 0; e < 8; ++e) if ((vm >> e) & 1u) mxv = fmaxf(mxv, v[e]);
            mxv = fmaxf(mxv, __shfl_xor(mxv, 16));
            mxv = fmaxf(mxv, __shfl_xor(mxv, 32));
            const float mn = fmaxf(m[h], mxv);
            float ps = 0.f;
#pragma unroll
            for (int e = 0; e < 8; ++e) ps += ((vm >> e) & 1u) ? __expf(v[e] - mn) : 0.f;
            l[h] = l[h] * __expf(m[h] - mn) + ps;
            m[h] = mn;
        }
    }
    float linv[4];
#pragma unroll
    for (int h = 0; h < 4; ++h) {
        float lt = l[h];
        lt += __shfl_xor(lt, 16);
        lt += __shfl_xor(lt, 32);
        linv[h] = lt > 0.f ? 1.f / lt : 0.f;
    }
    f32x4 o[4][4];
#pragma unroll
    for (int h = 0; h < 4; ++h)
#pragma unroll
        for (int i = 0; i < 4; ++i) o[h][i] = (f32x4){0.f, 0.f, 0.f, 0.f};
    float own4[8], last[8];
#pragma unroll
    for (int k = 0; k < 8; ++k) { own4[k] = 0.f; last[k] = 0.f; }
#pragma unroll
    for (int c = 0; c < 4; ++c) {
        if (c < nchunk) {
            bf16x8 kf[2][2];
#pragma unroll
            for (int stl = 0; stl < 2; ++stl)
#pragma unroll
                for (int ks = 0; ks < 2; ++ks) kf[stl][ks] = *(const bf16x8*)(lds + ks * 8192 + (c * 32 + stl * 16 + fr) * 64 + fq * 16);
            bf16x8 vf[4];
#pragma unroll
            for (int dvt = 0; dvt < 4; ++dvt) {
                const char* vp = lds + CM_K + (dvt * 16 + fr) * CM_VS + c * 64 + fq * 8;
                vf[dvt] = join8(*(const uint2*)vp, *(const uint2*)(vp + 32));
            }
            unsigned vm = 0;
#pragma unroll
            for (int e = 0; e < 8; ++e) { const int n = c * 32 + (e >> 2) * 16 + fq * 4 + (e & 3); if (n < nv) vm |= 1u << e; }
#pragma unroll
            for (int h = 0; h < 4; ++h) {
                f32x4 sa = {0.f, 0.f, 0.f, 0.f}, sb = {0.f, 0.f, 0.f, 0.f};
                sa = mma(kf[0][0], qf[h][0], sa); sa = mma(kf[0][1], qf[h][1], sa);
                sb = mma(kf[1][0], qf[h][0], sb); sb = mma(kf[1][1], qf[h][1], sb);
                float v[8];
#pragma unroll
                for (int r = 0; r < 4; ++r) { v[r] = sa[r] * 0.125f; v[4 + r] = sb[r] * 0.125f; }
#pragma unroll
                for (int e = 0; e < 8; ++e) v[e] = ((vm >> e) & 1u) ? __expf(v[e] - m[h]) * linv[h] : 0.f;
                own4[2 * c] += (v[0] + v[1]) + (v[2] + v[3]); last[2 * c] += v[3];
                own4[2 * c + 1] += (v[4] + v[5]) + (v[6] + v[7]); last[2 * c + 1] += v[7];
                const bf16x8 pf = pack8(v);
#pragma unroll
                for (int dvt = 0; dvt < 4; ++dvt) o[h][dvt] = mma(vf[dvt], pf, o[h][dvt]);
            }
        }
    }
    bf16_t* OC = (bf16_t*)(p.ws + O_OC) + tok * 1024 + g * 256;
#pragma unroll
    for (int h = 0; h < 4; ++h)
#pragma unroll
        for (int dvt = 0; dvt < 4; dvt += 2) {
            uint2 x, y;
            x.x = pk2(o[h][dvt][0], o[h][dvt][1]); x.y = pk2(o[h][dvt][2], o[h][dvt][3]);
            y.x = pk2(o[h][dvt + 1][0], o[h][dvt + 1][1]); y.y = pk2(o[h][dvt + 1][2], o[h][dvt + 1][3]);
            *(uint4*)(OC + h * 64 + (dvt + (fq & 1)) * 16 + (fq >> 1) * 8) = pair16(x, y);
        }
    float sc[8];
    float prev = 0.f;
#pragma unroll
    for (int k = 0; k < 8; ++k) {
        const float rcv = __shfl(last[k], (lane + 48) & 63);
        const float carry = fq > 0 ? rcv : prev;
        prev = rcv;
        const int j = 4 * k + fq;
        const bool forced = j == 0 || j == cur || j == cur - 1;
        sc[k] = forced ? 1e30f : (j <= cur ? own4[k] + carry : -1e30f);
    }
    unsigned mask = 0u;
#pragma unroll 1
    for (int it = 0; it < 8; ++it) {
        float bv = sc[0];
        int bj = fq;
#pragma unroll
        for (int k = 1; k < 8; ++k) if (sc[k] > bv) { bv = sc[k]; bj = 4 * k + fq; }
#pragma unroll
        for (int off = 16; off <= 32; off <<= 1) {
            const float ov = __shfl_xor(bv, off);
            const int oj = __shfl_xor(bj, off);
            if (ov > bv || (ov == bv && oj < bj)) { bv = ov; bj = oj; }
        }
        mask |= 1u << bj;
#pragma unroll
        for (int k = 0; k < 8; ++k) if (4 * k + fq == bj) sc[k] = -4e30f;
    }
    if (fq == 0) ((unsigned*)(p.ws + O_SEL))[bg * S + trow] = mask & ((2u << cur) - 1u);
    __syncthreads();
}

constexpr int AT_K = 8192, AT_V = 9216, AT_STAGE = AT_K + AT_V;
template <bool SELB, int NH>
DEVI void nsa2_item(const Params& p, int tile, int bg, int h0, char* lds) {
    const int thr_ = tidx();
    const int b = bg >> 2, g = bg & 3;
    const int lane = thr_ & 63, wid = __builtin_amdgcn_readfirstlane(thr_ >> 6), fr = lane & 15, fq = lane >> 4;
    const int T0 = tile * 64, t0 = T0 + wid * 16, trow = t0 + fr, cur = tile;
    const bf16_t* P = (const bf16_t*)(p.ws + O_P);
    const size_t tok = (size_t)b * S + trow;
    bf16x8 qf[NH][2];
#pragma unroll
    for (int h = 0; h < NH; ++h) {
        const bf16_t* qp = P + tok * NPS + C_AQ + (g * 4 + h0 + h) * 64 + fq * 8;
        qf[h][0] = *(const bf16x8*)qp; qf[h][1] = *(const bf16x8*)(qp + 32);
    }
    unsigned rm = 0xffffffffu, wmask, gmask;
    if (SELB) {
        rm = ((const unsigned*)(p.ws + O_SEL))[bg * S + trow];
        unsigned un = rm;
        un |= __shfl_xor(un, 1); un |= __shfl_xor(un, 2); un |= __shfl_xor(un, 4); un |= __shfl_xor(un, 8);
        wmask = __builtin_amdgcn_readfirstlane(un) & ((2u << cur) - 1u);
        unsigned* lu = (unsigned*)(lds + 2 * AT_STAGE);
        if (lane == 0) lu[wid] = wmask;
        __syncthreads();
        gmask = lu[0] | lu[1] | lu[2] | lu[3];
        gmask = __builtin_amdgcn_readfirstlane(gmask);
    } else {
        const int lo = cur >= 8 ? cur - 8 : 0;
        gmask = ((2u << cur) - 1u) & ~((1u << lo) - 1u);
        const int wl = t0 - 511 > 0 ? (t0 - 511) >> 6 : 0;
        wmask = gmask & ~((1u << wl) - 1u);
    }
    const bf16_t* kg = P + (size_t)(b * S) * NPS + (SELB ? C_KS : C_KW) + g * 64;
    const bf16_t* vg = (const bf16_t*)(p.ws + (SELB ? O_VST : O_VWT)) + (size_t)(b * 256 + g * 64) * S;
    const int sc = thr_ & 7, sr = thr_ >> 3;
    uint4 rk0, rk1, rv0, rv1;
#define AT_GLOAD(jj)                                                                                   \
    {                                                                                                  \
        rk0 = *(const uint4*)(kg + (size_t)((jj) * 64 + sr) * NPS + sc * 8);                           \
        rk1 = *(const uint4*)(kg + (size_t)((jj) * 64 + sr + 32) * NPS + sc * 8);                      \
        rv0 = *(const uint4*)(vg + (size_t)(sr) * S + (jj) * 64 + sc * 8);                             \
        rv1 = *(const uint4*)(vg + (size_t)(sr + 32) * S + (jj) * 64 + sc * 8);                        \
    }
#define AT_LSTORE(stt)                                                                                 \
    {                                                                                                  \
        char* base_ = lds + (stt) * AT_STAGE;                                                          \
        *(uint4*)(base_ + (sc >> 2) * 4096 + (sr) * 64 + (sc & 3) * 16) = rk0;                         \
        *(uint4*)(base_ + (sc >> 2) * 4096 + (sr + 32) * 64 + (sc & 3) * 16) = rk1;                    \
        *(uint4*)(base_ + AT_K + (sr) * 144 + sc * 16) = rv0;                                          \
        *(uint4*)(base_ + AT_K + (sr + 32) * 144 + sc * 16) = rv1;                                     \
    }
    f32x4 o[NH][4];
    float m[NH], l[NH];
#pragma unroll
    for (int h = 0; h < NH; ++h) {
        m[h] = -1e30f; l[h] = 0.f;
#pragma unroll
        for (int i = 0; i < 4; ++i) o[h][i] = (f32x4){0.f, 0.f, 0.f, 0.f};
    }
    unsigned rem = gmask;
    int j = __ffs(rem) - 1;
    rem &= rem - 1;
    AT_GLOAD(j);
    AT_LSTORE(0);
    __syncthreads();
    int st = 0;
    while (true) {
        const int jn = rem ? __ffs(rem) - 1 : -1;
        rem &= rem - 1;
        if (jn >= 0) AT_GLOAD(jn);
        if ((wmask >> j) & 1u) {
            __builtin_amdgcn_s_setprio(1);
            const char* kb = lds + st * AT_STAGE;
            const char* vb = kb + AT_K;
            const bool rs = (rm >> j) & 1u;
#pragma unroll
            for (int c = 0; c < 2; ++c) {
                const int s0 = j * 64 + c * 32;
                bf16x8 kf[2][2];
#pragma unroll
                for (int stl = 0; stl < 2; ++stl)
#pragma unroll
                    for (int ks = 0; ks < 2; ++ks) kf[stl][ks] = *(const bf16x8*)(kb + ks * 4096 + (c * 32 + stl * 16 + fr) * 64 + fq * 16);
                bf16x8 vf[4];
#pragma unroll
                for (int dvt = 0; dvt < 4; ++dvt) {
                    const char* vp = vb + (dvt * 16 + fr) * 144 + c * 64 + fq * 8;
                    vf[dvt] = join8(*(const uint2*)vp, *(const uint2*)(vp + 32));
                }
                unsigned vm = 0;
#pragma unroll
                for (int e = 0; e < 8; ++e) {
                    const int s = s0 + (e >> 2) * 16 + fq * 4 + (e & 3);
                    if (rs && s <= trow && (SELB || s > trow - 512)) vm |= 1u << e;
                }
#pragma unroll
                for (int h = 0; h < NH; ++h) {
                    f32x4 sa = {0.f, 0.f, 0.f, 0.f}, sb = {0.f, 0.f, 0.f, 0.f};
                    sa = mma(kf[0][0], qf[h][0], sa); sa = mma(kf[0][1], qf[h][1], sa);
                    sb = mma(kf[1][0], qf[h][0], sb); sb = mma(kf[1][1], qf[h][1], sb);
                    constexpr float SC = 0.125f * 1.44269504f;
                    float v[8];
#pragma unroll
                    for (int r = 0; r < 4; ++r) { v[r] = sa[r]; v[4 + r] = sb[r]; }
                    float mxv = -1e30f;
#pragma unroll
                    for (int e = 0; e < 8; ++e) if ((vm >> e) & 1u) mxv = fmaxf(mxv, v[e]);
                    mxv = fmaxf(mxv, __shfl_xor(mxv, 16));
                    mxv = fmaxf(mxv, __shfl_xor(mxv, 32));
                    const float mn = fmaxf(m[h], mxv);
                    const float alpha = __builtin_amdgcn_exp2f((m[h] - mn) * SC);
                    m[h] = mn;
                    const float mb = -mn * SC;
                    float ps = 0.f;
#pragma unroll
                    for (int e = 0; e < 8; ++e) { v[e] = ((vm >> e) & 1u) ? __builtin_amdgcn_exp2f(fmaf(v[e], SC, mb)) : 0.f; ps += v[e]; }
                    l[h] = l[h] * alpha + ps;
                    const bf16x8 pf = pack8(v);
#pragma unroll
                    for (int dvt = 0; dvt < 4; ++dvt) { o[h][dvt] *= alpha; o[h][dvt] = mma(vf[dvt], pf, o[h][dvt]); }
                }
            }
            __builtin_amdgcn_s_setprio(0);
        }
        if (jn < 0) break;
        AT_LSTORE(st ^ 1);
        __syncthreads();
        st ^= 1;
        j = jn;
    }
    __syncthreads();
#pragma unroll
    for (int h = 0; h < NH; ++h) {
        const int hd = g * 4 + h0 + h;
        float lt = l[h];
        lt += __shfl_xor(lt, 16);
        lt += __shfl_xor(lt, 32);
        const float inv = 1.f / lt;
        if (!SELB) {
            bf16_t* OW = (bf16_t*)(p.ws + O_OW) + tok * 1024 + hd * 64;
#pragma unroll
            for (int dvt = 0; dvt < 4; dvt += 2) {
                uint2 x, y;
                x.x = pk2(o[h][dvt][0] * inv, o[h][dvt][1] * inv); x.y = pk2(o[h][dvt][2] * inv, o[h][dvt][3] * inv);
                y.x = pk2(o[h][dvt + 1][0] * inv, o[h][dvt + 1][1] * inv); y.y = pk2(o[h][dvt + 1][2] * inv, o[h][dvt + 1][3] * inv);
                *(uint4*)(OW + (dvt + (fq & 1)) * 16 + (fq >> 1) * 8) = pair16(x, y);
            }
        } else {
            const float* G = (const float*)(p.ws + O_G) + tok * 64 + 8 + hd * 3;
            const float g0 = sigm(G[0]), g1 = sigm(G[1]) * inv, g2 = sigm(G[2]);
            const bf16_t* OC = (const bf16_t*)(p.ws + O_OC) + tok * 1024 + hd * 64 + fq * 4;
            const bf16_t* OW = (const bf16_t*)(p.ws + O_OW) + tok * 1024 + hd * 64 + fq * 4;
            const bf16_t* AZ = P + tok * NPS + C_AZ + hd * 64 + fq * 4;
            bf16_t* YA = (bf16_t*)(p.ws + O_YA) + tok * 1024 + hd * 64 + fq * 4;
#pragma unroll
            for (int dv2 = 0; dv2 < 4; dv2 += 2) {
                uint2 ov[2];
#pragma unroll
                for (int q = 0; q < 2; ++q) {
                    const int dvt = dv2 + q;
                    const uint2 oc = *(const uint2*)(OC + dvt * 16), ow = *(const uint2*)(OW + dvt * 16), az = *(const uint2*)(AZ + dvt * 16);
                    const float y0 = (g0 * lo16(oc.x) + g1 * o[h][dvt][0] + g2 * lo16(ow.x)) * silu(lo16(az.x));
                    const float y1 = (g0 * hi16(oc.x) + g1 * o[h][dvt][1] + g2 * hi16(ow.x)) * silu(hi16(az.x));
                    const float y2 = (g0 * lo16(oc.y) + g1 * o[h][dvt][2] + g2 * lo16(ow.y)) * silu(lo16(az.y));
                    const float y3 = (g0 * hi16(oc.y) + g1 * o[h][dvt][3] + g2 * hi16(ow.y)) * silu(hi16(az.y));
                    ov[q].x = pk2(y0, y1); ov[q].y = pk2(y2, y3);
                }
                *(uint4*)(YA - fq * 4 + (dv2 + (fq & 1)) * 16 + (fq >> 1) * 8) = pair16(ov[0], ov[1]);
            }
        }
    }
}

DEVI void up_tile(const Params& p, int item, char* lds) {
    const int nt = item >> 5, mt = item & 31, m0 = mt * 256, n0 = nt * 64;
    const int tid = tidx(), lane = tid & 63, wid = tid >> 6, wr = wid >> 1, wc = wid & 1, fr = lane & 15, fq = lane >> 4;
    const bf16_t* P = (const bf16_t*)(p.ws + O_P);
    f32x4 acc[8][2], acc2[8][2];
#pragma unroll
    for (int i = 0; i < 8; ++i) { acc[i][0] = acc[i][1] = acc2[i][0] = acc2[i][1] = (f32x4){0.f, 0.f, 0.f, 0.f}; }
    gemm3_main<false, 2>(acc, lds, (const bf16_t*)(p.ws + O_YM), 1024, (const bf16_t*)(p.ws + O_WUM), 1024, 2047, m0, n0, 1024);
    gemm3_main<false, 2>(acc2, lds, (const bf16_t*)(p.ws + O_YA), 1024, (const bf16_t*)(p.ws + O_WUA), 1024, 2047, m0, n0, 1024);
    bf16_t* MG = (bf16_t*)(p.ws + O_MG);
#pragma unroll
    for (int mi = 0; mi < 8; ++mi) {
        const int row = m0 + wr * 128 + mi * 16 + fr;
        uint2 ov[2];
        const int pc = n0 + wc * 32 + (fq & 1) * 16 + (fq >> 1) * 8;
        const uint4 gm16 = *(const uint4*)(P + (size_t)row * NPS + C_GM + pc), ga16 = *(const uint4*)(P + (size_t)row * NPS + C_GA + pc);
        uint2 ta, tb;
        ta.x = gm16.x; ta.y = gm16.y; tb.x = gm16.z; tb.y = gm16.w;
        const uint4 gmu = pair16(ta, tb);
        ta.x = ga16.x; ta.y = ga16.y; tb.x = ga16.z; tb.y = ga16.w;
        const uint4 gau = pair16(ta, tb);
#pragma unroll
        for (int ni = 0; ni < 2; ++ni) {
            uint2 gm, ga;
            gm.x = ni ? gmu.z : gmu.x; gm.y = ni ? gmu.w : gmu.y; ga.x = ni ? gau.z : gau.x; ga.y = ni ? gau.w : gau.y;
            const float y0 = acc[mi][ni][0] * sigm(lo16(gm.x)) + acc2[mi][ni][0] * sigm(lo16(ga.x)), y1 = acc[mi][ni][1] * sigm(hi16(gm.x)) + acc2[mi][ni][1] * sigm(hi16(ga.x));
            const float y2 = acc[mi][ni][2] * sigm(lo16(gm.y)) + acc2[mi][ni][2] * sigm(lo16(ga.y)), y3 = acc[mi][ni][3] * sigm(hi16(gm.y)) + acc2[mi][ni][3] * sigm(hi16(ga.y));
            ov[ni].x = pk2(y0, y1); ov[ni].y = pk2(y2, y3);
        }
        *(uint4*)(MG + (size_t)row * DM + n0 + wc * 32 + (fq & 1) * 16 + (fq >> 1) * 8) = pair16(ov[0], ov[1]);
    }
}
DEVI void out_tile(const Params& p, int item, char* lds) {
    const int nt = item >> 5, mt = item & 31, m0 = mt * 256, n0 = nt * 128;
    const int tid = tidx(), lane = tid & 63, wid = tid >> 6, wr = wid >> 1, wc = wid & 1, fr = lane & 15, fq = lane >> 4;
    f32x4 acc[8][4];
    zero_acc2(acc);
    gemm3_main<false, 4>(acc, lds, (const bf16_t*)(p.ws + O_MG), DM, (const bf16_t*)(p.ws + O_WOUT), DM, 2047, m0, n0, DM);
    bf16_t* O = (bf16_t*)(p.ws + O_OUT);
#pragma unroll
    for (int mi = 0; mi < 8; ++mi)
#pragma unroll
        for (int ni = 0; ni < 4; ni += 2) {
            const int row = m0 + wr * 128 + mi * 16 + fr, col = n0 + wc * 64 + (ni + (fq & 1)) * 16 + (fq >> 1) * 8;
            uint2 x, y;
            x.x = pk2(acc[mi][ni][0], acc[mi][ni][1]); x.y = pk2(acc[mi][ni][2], acc[mi][ni][3]);
            y.x = pk2(acc[mi][ni + 1][0], acc[mi][ni + 1][1]); y.y = pk2(acc[mi][ni + 1][2], acc[mi][ni + 1][3]);
            *(uint4*)(O + (size_t)row * DM + col) = pair16(x, y);
        }
}
DEVI void final_rows(const Params& p, int item) {
    const int thr_ = tidx();
    const int lane = thr_ & 63, wid = thr_ >> 6;
    const int row = item * 4 + wid;
    const bf16_t* orow = (const bf16_t*)(p.ws + O_OUT) + (size_t)row * DM;
    const float* xr = p.x + (size_t)row * DM;
    f32x4 v[8];
    float ss = 0.f;
#pragma unroll
    for (int i = 0; i < 8; ++i) { const uint2 u = *(const uint2*)(orow + i * 256 + lane * 4); v[i] = (f32x4){lo16(u.x), hi16(u.x), lo16(u.y), hi16(u.y)}; ss += v[i][0] * v[i][0] + v[i][1] * v[i][1] + v[i][2] * v[i][2] + v[i][3] * v[i][3]; }
    ss = wave_sum(ss);
    const float rs = rsqrtf(ss * (1.f / DM) + 1e-6f);
    float* dr = p.out + (size_t)row * DM;
#pragma unroll
    for (int i = 0; i < 8; ++i) {
        const f32x4 g = *(const f32x4*)(p.post_g + i * 256 + lane * 4);
        const f32x4 xv = *(const f32x4*)(xr + i * 256 + lane * 4);
#if DBG == 0
        *(f32x4*)(dr + i * 256 + lane * 4) = xv + v[i] * rs * g;
#elif DBG == 1
        *(f32x4*)(dr + i * 256 + lane * 4) = xv;
#elif DBG == 9
        {
            const int cc = (i * 256 + lane * 4) & 1023;
            const uint2 u0 = *(const uint2*)((const bf16_t*)(p.ws + O_XC) + (size_t)row * 1024 + cc);
            const uint2 u1 = *(const uint2*)((const bf16_t*)(p.ws + O_QM) + (size_t)row * 1024 + cc);
            const uint2 u2 = *(const uint2*)((const bf16_t*)(p.ws + O_KM) + (size_t)row * 1024 + cc);
            const uint2 u3 = *(const uint2*)((const bf16_t*)(p.ws + O_VMT) + (size_t)row * 1024 + cc);
            const int fi = (row & 15) * 2048 + i * 256 + lane * 4;
            const f32x4 f0 = *(const f32x4*)((const float*)(p.ws + O_FA) + fi), f1 = *(const f32x4*)((const float*)(p.ws + O_FM) + fi), f2 = *(const f32x4*)((const float*)(p.ws + O_FL) + fi);
            f32x4 d = {lo16(u0.x) + lo16(u1.x) + lo16(u2.x) + lo16(u3.x), hi16(u0.x) + hi16(u1.x) + hi16(u2.x) + hi16(u3.x), lo16(u0.y) + lo16(u1.y) + lo16(u2.y) + lo16(u3.y), hi16(u0.y) + hi16(u1.y) + hi16(u2.y) + hi16(u3.y)};
            #if PSEL == 0
            d = (f32x4){lo16(u3.x), hi16(u3.x), lo16(u3.y), hi16(u3.y)};
            *(f32x4*)(dr + i * 256 + lane * 4) = xv + d;
#elif PSEL == 1
            d = (f32x4){lo16(u0.x), hi16(u0.x), lo16(u0.y), hi16(u0.y)};
            *(f32x4*)(dr + i * 256 + lane * 4) = xv + d;
#elif PSEL == 2
            *(f32x4*)(dr + i * 256 + lane * 4) = xv + f0 + f1 + f2;
#else
            *(f32x4*)(dr + i * 256 + lane * 4) = xv + d + f0 + f1 + f2;
#endif
        }
#else
        {
            const bf16_t* src = DBG == 2 ? (const bf16_t*)(p.ws + O_MG) + (size_t)row * DM : DBG == 3 ? (const bf16_t*)(p.ws + O_P) + (size_t)row * NPS + 2048
                              : DBG == 4 ? (const bf16_t*)(p.ws + O_YM) + (size_t)row * 1024 : DBG == 5 ? (const bf16_t*)(p.ws + O_YA) + (size_t)row * 1024
                              : DBG == 6 ? (const bf16_t*)(p.ws + O_P) + (size_t)row * NPS + 4096 : (const bf16_t*)(p.ws + O_P) + (size_t)row * NPS + 7680;
            const int cc = (i * 256 + lane * 4) & ((DBG == 4 || DBG == 5) ? 1023 : 2047);
            const uint2 u = *(const uint2*)(src + cc);
            f32x4 d = {lo16(u.x), hi16(u.x), lo16(u.y), hi16(u.y)};
            *(f32x4*)(dr + i * 256 + lane * 4) = xv + d;
        }
#endif
    }
}


__global__ void __launch_bounds__(256, 2) fwd_megakernel(Params p) {
    extern __shared__ __attribute__((aligned(16))) char lds[];
    const int G = gridDim.x, bid = blockIdx.x;
    if (threadIdx.x == 0) *(uint4*)(lds + LDS_MAIN) = make_uint4(0u, 0u, 0u, 0u);
    __syncthreads();
    XcdBarrier xb = xcd_barrier_post((unsigned*)(p.ws + O_BAR), (volatile LAS unsigned*)(lds + LDS_MAIN));
    if (p.ws == nullptr) cg::this_grid().sync();
    for (int rep = 0; rep < NREP(0); ++rep)
    for (int it = bid; it < 2048 + N_TTILES + 32; it += G) {
        if (it < N_TTILES) transpose_item(p, it, lds);
        else if (it < N_TTILES + 2048) rmsnorm_rows(p, it - N_TTILES);
        else bias_item(p, it - N_TTILES - 2048);
    }
    xcd_barrier(xb);
    for (int rep = 0; rep < NREP(1); ++rep)
    for (int it = bid; it < 32 * 93; it += G) inproj_tile(p, it, lds);
    if (G >= 128 && bid >= G - 64) {
        if (threadIdx.x == 0) {
            unsigned* cnt = (unsigned*)(p.ws + O_BAR);
            XB_SPIN(xb_ld(cnt) < 128u * NREP(1), cnt);
            __builtin_amdgcn_fence(__ATOMIC_ACQUIRE, "agent");
            asm volatile("s_waitcnt vmcnt(0)" ::: "memory");
        }
        __syncthreads();
        __builtin_amdgcn_fence(__ATOMIC_ACQUIRE, "agent");
        cmp1_tile(p, bid - (G - 64), lds);
    } else if (G < 128) {
        xcd_barrier(xb);
        for (int it = bid; it < 64; it += G) cmp1_tile(p, it, lds);
    }
    xcd_barrier(xb);
    for (int rep = 0; rep < NREP(2); ++rep)
    for (int it = bid; it < 16 + 512; it += G) {
        if (it < 16) scan_item(p, it, lds);
        else conv_item(p, it - 16);
    }
    xcd_barrier(xb);
    for (int rep = 0; rep < NREP(3); ++rep)
    for (int it = bid; it < 1024 + 32; it += G) {
        if (it < 32) cmp2_tile(p, it, lds);
        else qk_tile(p, it - 32, lds);
    }
    xcd_barrier(xb);
    for (int rep = 0; rep < NREP(4); ++rep) {
        for (int r2 = 0; r2 < NREP(8); ++r2)
        for (int it = bid; it < 512; it += G) mlstm2_item(p, it, lds);
        for (int r2 = 0; r2 < NREP(9); ++r2)
        if (bid >= (G >> 1)) for (int it = bid - (G >> 1); it < 512; it += G - (G >> 1)) cmp3_item(p, it, lds);
        for (int r2 = 0; r2 < NREP(10); ++r2)
        for (int it = bid; it < 512; it += G) nsa2_item<false, 4>(p, it >> 4, it & 15, 0, lds);
    }
    xcd_barrier(xb);
    for (int rep = 0; rep < NREP(5); ++rep)
    for (int it = bid; it < 1024; it += G) {
        const int idx = it & 511, hp = it >> 9;
        nsa2_item<true, 2>(p, hp ? (idx >> 4) : 31 - (idx >> 4), idx & 15, hp * 2, lds);
    }
    xcd_barrier(xb);
    for (int rep = 0; rep < NREP(6); ++rep)
    for (int it = bid; it < 1024; it += G) up_tile(p, it, lds);
    xcd_barrier(xb);
    for (int rep = 0; rep < NREP(7); ++rep)
    for (int it = bid; it < 512; it += G) out_tile(p, it, lds);
    xcd_barrier(xb);
    for (int rep = 0; rep < NREP(11); ++rep)
    for (int it = bid; it < 2048; it += G) final_rows(p, it);
}

extern "C" void kernel_launch(void* const* d_in, const int* in_sizes, int n_in, void* d_out, int out_size, void* d_ws, size_t ws_size,
                              hipStream_t stream) {
    static int grid_blocks = 0;
    if (!grid_blocks) {
        int dev = 0, cus = 0, per_cu = 0;
        hipGetDevice(&dev);
        hipDeviceGetAttribute(&cus, hipDeviceAttributeMultiprocessorCount, dev);
        hipFuncSetAttribute((const void*)fwd_megakernel, hipFuncAttributeMaxDynamicSharedMemorySize, LDS_BYTES);
        hipOccupancyMaxActiveBlocksPerMultiprocessor(&per_cu, fwd_megakernel, 256, LDS_BYTES);
        if (per_cu < 1) per_cu = 1;
        if (per_cu > 2) per_cu = 2;
        grid_blocks = cus * per_cu;
    }
    if (ws_size < O_END2) { fprintf(stderr, "workspace too small: %zu < %zu\n", ws_size, (size_t)O_END); return; }
    Params p{};
    const float** f = (const float**)&p;
    for (int i = 0; i < 21; ++i) f[i] = (const float*)d_in[i];
    p.out = (float*)d_out;
    p.ws = (char*)d_ws;
    hipMemsetAsync((char*)d_ws + O_BAR, 0, XCD_BAR_WORDS * 4, stream);
    void* args[] = {&p};
    hipError_t e = hipLaunchCooperativeKernel((void*)fwd_megakernel, dim3(grid_blocks), dim3(256), args, LDS_BYTES, stream);
    if (e != hipSuccess) fprintf(stderr, "cooperative launch failed: %s (grid %d)\n", hipGetErrorString(e), grid_blocks);
}
```

```cpp
#include <hip/hip_runtime.h>
#include <hip/hip_cooperative_groups.h>
#include <stdint.h>
#include <cstdio>
namespace cg = cooperative_groups;

typedef unsigned short bf16_t;
typedef short bf16x8 __attribute__((ext_vector_type(8)));
typedef float f32x4 __attribute__((ext_vector_type(4)));
#define DEVI __device__ __forceinline__

constexpr int T = 8192, S = 2048, DM = 2048;
constexpr int NP = 11904, NPS = 11776, DIN = 11832;
constexpr int C_MX = 0, C_MV = 1024, C_MO = 2048, C_MZ = 3072, C_AQ = 4096, C_KC = 5120, C_VC = 5376, C_KS = 5632,
              C_VS = 5888, C_KW = 6144, C_VW = 6400, C_AZ = 6656, C_GM = 7680, C_GA = 9728, C_GATE = 11776;
constexpr size_t O_R0 = 0;
constexpr size_t O_R1 = O_R0 + 33554432;
constexpr size_t O_P = O_R1 + 50331648;
constexpr size_t O_WUM = O_P + 192937984;
constexpr size_t O_WUA = O_WUM + 4194304;
constexpr size_t O_WOUT = O_WUA + 4194304;
constexpr size_t O_WQ = O_WOUT + 8388608;
constexpr size_t O_WK = O_WQ + 524288;
constexpr size_t O_W1K = O_WK + 524288;
constexpr size_t O_W1V = O_W1K + 1048576;
constexpr size_t O_W2K = O_W1V + 1048576;
constexpr size_t O_W2V = O_W2K + 32768;
constexpr size_t O_G = O_W2V + 32768;
constexpr size_t O_VMT = O_G + 2097152;
constexpr size_t O_VST = O_VMT + 16777216;
constexpr size_t O_VWT = O_VST + 4194304;
constexpr size_t O_HC = O_VWT + 4194304;
constexpr size_t O_KCF = O_HC + 2097152;
constexpr size_t O_VCF = O_KCF + 524288;
constexpr size_t O_B1P = O_VCF + 524288;
constexpr size_t O_FA = O_B1P + 32768;
constexpr size_t O_FM = O_FA + 131072;
constexpr size_t O_FL = O_FM + 131072;
constexpr size_t O_SEL = O_FL + 131072;
constexpr size_t O_YM = O_SEL + 131072;
constexpr size_t O_END = O_YM + 16777216;
constexpr size_t O_XC = O_R1, O_QM = O_R1 + 16777216, O_KM = O_R1 + 2 * 16777216, O_YA = O_QM;
constexpr size_t O_OC = O_R0, O_OW = O_R0 + 16777216, O_MG = O_R0, O_H = O_R0, O_WINT = O_R1, O_OUT = O_P;

constexpr int LDS_MAIN = 73728;
constexpr int LDS_BYTES = LDS_MAIN + 64;
constexpr size_t O_BAR = O_END;
constexpr size_t O_END2 = O_BAR + 16384;
#ifndef DBG
#define DBG 0
#endif
#ifndef REPM
#define REPM 0
#endif
#define NREP(k) (((REPM >> (k)) & 1) ? 2 : 1)
#ifndef DSTOP
#define DSTOP 9
#endif
#ifndef PSEL
#define PSEL 0
#endif

struct Params {
    const float *x, *pre_g, *w_in, *conv_w, *conv_b, *w_q, *w_k, *b_i, *b_f, *norm_g, *skip, *pe_k, *w1_k, *w2_k, *pe_v, *w1_v,
        *w2_v, *w_up_m, *w_up_a, *w_out, *post_g;
    float* out;
    char* ws;
};

DEVI int tidx() { int t = threadIdx.x; asm volatile("" : "+v"(t)); return t; }
DEVI float bf2f(bf16_t b) { return __uint_as_float(((unsigned)b) << 16); }
typedef __bf16 bf16v2_t __attribute__((ext_vector_type(2)));
typedef float f32v2_t __attribute__((ext_vector_type(2)));
DEVI unsigned pk2(float lo, float hi) {
    f32v2_t v = {lo, hi};
    bf16v2_t b = __builtin_convertvector(v, bf16v2_t);
    return __builtin_bit_cast(unsigned, b);
}
DEVI bf16_t f2bf(float f) { return (bf16_t)(pk2(f, 0.f) & 0xffffu); }
DEVI float lo16(unsigned u) { return __uint_as_float(u << 16); }
DEVI float hi16(unsigned u) { return __uint_as_float(u & 0xffff0000u); }
DEVI float sigm(float x) { return 1.f / (1.f + __expf(-x)); }
DEVI float silu(float x) { return x / (1.f + __expf(-x)); }
DEVI f32x4 mma(bf16x8 a, bf16x8 b, f32x4 c) { return __builtin_amdgcn_mfma_f32_16x16x32_bf16(a, b, c, 0, 0, 0); }
DEVI float rdlane(float v, int l) { return __uint_as_float(__builtin_amdgcn_readlane(__float_as_uint(v), l)); }
DEVI uint4 pair16(uint2 x, uint2 y) {
    const auto r0 = __builtin_amdgcn_permlane16_swap(x.x, y.x, false, false);
    const auto r1 = __builtin_amdgcn_permlane16_swap(x.y, y.y, false, false);
    return make_uint4(r0[0], r1[0], r0[1], r1[1]);
}
typedef unsigned u32x4_t __attribute__((ext_vector_type(4)));
DEVI void store_nt16(void* ptr, uint4 v) { u32x4_t x = {v.x, v.y, v.z, v.w}; __builtin_nontemporal_store(x, (u32x4_t*)ptr); }
DEVI float wave_max(float v) {
#pragma unroll
    for (int o = 32; o > 0; o >>= 1) v = fmaxf(v, __shfl_xor(v, o));
    return v;
}
DEVI float wave_sum(float v) {
#pragma unroll
    for (int o = 32; o > 0; o >>= 1) v += __shfl_xor(v, o);
    return v;
}
DEVI bf16x8 pack8(const float* v) {
    union { unsigned u[4]; bf16x8 b; } x;
    x.u[0] = pk2(v[0], v[1]); x.u[1] = pk2(v[2], v[3]); x.u[2] = pk2(v[4], v[5]); x.u[3] = pk2(v[6], v[7]);
    return x.b;
}
DEVI bf16x8 join8(uint2 a, uint2 b) {
    union { unsigned u[4]; bf16x8 v; } x;
    x.u[0] = a.x; x.u[1] = a.y; x.u[2] = b.x; x.u[3] = b.y;
    return x.v;
}

#define XB_TMO      128
#define XB_XCNT(j)  (256  + 64 * (j))
#define XB_XSUB(j)  (1280 + 64 * (j))
#define XB_XGEN(j)  (2304 + 64 * (j))
#define XB_TOP      3328
#define XB_TOPGEN   3392
#define XCD_BAR_WORDS 3456
#define XB_SPIN_CAP (1u << 18)
#define LAS __attribute__((address_space(3)))
DEVI unsigned xb_ld(unsigned* p) { return __hip_atomic_load(p, __ATOMIC_RELAXED, __HIP_MEMORY_SCOPE_AGENT); }
DEVI unsigned xb_add(unsigned* p, unsigned v) { return __hip_atomic_fetch_add(p, v, __ATOMIC_RELAXED, __HIP_MEMORY_SCOPE_AGENT); }
DEVI unsigned xb_xcc_id() { return (unsigned)__builtin_amdgcn_s_getreg((3 << 11) | 20) & 0xFu; }
#define XB_SPIN(cond, bar) do { unsigned _sp = 0; while (cond) { __builtin_amdgcn_s_sleep(1); \
    if ((++_sp & 255u) == 0u) { if (xb_ld(&(bar)[XB_TMO])) break; if (_sp > XB_SPIN_CAP) { atomicAdd(&(bar)[XB_TMO], 1u); break; } } } } while (0)
struct XcdBarrier { unsigned* bar; unsigned x; volatile LAS unsigned* st; };
DEVI XcdBarrier xcd_barrier_post(unsigned* bar, volatile LAS unsigned* st) {
    XcdBarrier b; b.bar = bar; b.x = xb_xcc_id(); b.st = st;
    if (threadIdx.x == 0) (void)xb_add(&bar[XB_XCNT(b.x)], 1u);
    return b;
}
DEVI void xcd_barrier_complete(unsigned* bar, unsigned x, unsigned& nloc, unsigned& nx) {
    const unsigned G = gridDim.x * gridDim.y * gridDim.z;
    unsigned sum, cnt, mine, sp = 0u;
    for (;;) {
        sum = 0u; cnt = 0u; mine = 0u;
#pragma unroll
        for (unsigned j = 0; j < 16; ++j) { const unsigned c = xb_ld(&bar[XB_XCNT(j)]); sum += c; cnt += (c > 0u) ? 1u : 0u; mine = (j == x) ? c : mine; }
        if (sum == G) break;
        __builtin_amdgcn_s_sleep(1);
        if ((++sp & 255u) == 0u) { if (xb_ld(&bar[XB_TMO])) break; if (sp > XB_SPIN_CAP) { atomicAdd(&bar[XB_TMO], 1u); break; } }
    }
    nloc = mine > 0u ? mine : 1u; nx = cnt > 0u ? cnt : 1u;
}
DEVI void xcd_barrier(const XcdBarrier& b) {
    asm volatile("s_waitcnt vmcnt(0)" ::: "memory");
    __syncthreads();
    if (threadIdx.x == 0) {
        unsigned* bar = b.bar;
        __builtin_amdgcn_s_waitcnt(0);
        unsigned nloc = b.st[0], nx = b.st[1];
        if (nloc == 0u) { xcd_barrier_complete(bar, b.x, nloc, nx); b.st[0] = nloc; b.st[1] = nx; }
        const unsigned old = xb_add(&bar[XB_XSUB(b.x)], 1u);
        const unsigned gen = old / nloc;
        if (old + 1u == (gen + 1u) * nloc) {
            __builtin_amdgcn_fence(__ATOMIC_RELEASE, "agent");
            asm volatile("s_waitcnt vmcnt(0)" ::: "memory");
            const unsigned og = xb_add(&bar[XB_TOP], 1u);
            const unsigned tg = og / nx;
            if (og + 1u == (tg + 1u) * nx) xb_add(&bar[XB_TOPGEN], 1u);
            else XB_SPIN(xb_ld(&bar[XB_TOPGEN]) == tg, bar);
            __builtin_amdgcn_fence(__ATOMIC_ACQUIRE, "agent");
            xb_add(&bar[XB_XGEN(b.x)], 1u);
            asm volatile("s_waitcnt vmcnt(0)" ::: "memory");
        } else {
            XB_SPIN(xb_ld(&bar[XB_XGEN(b.x)]) == gen, bar);
            __builtin_amdgcn_fence(__ATOMIC_ACQUIRE, "agent");
            asm volatile("s_waitcnt vmcnt(0)" ::: "memory");
        }
    }
    __syncthreads();
}
template <bool TR, int NI, class RB>
DEVI void gemm_main(f32x4 (&acc)[4][NI], char* lds, RB rowbase, size_t hi, const bf16_t* Bt, int ldb, int nBmax, int m0, int n0, int K) {
    const int tid = tidx(), lane = tid & 63, wid = tid >> 6, wr = wid >> 1, wc = wid & 1, fr = lane & 15, fq = lane >> 4;
    const int c = tid & 7, r0 = tid >> 3;
    const bf16_t* ab[4];
    const bf16_t* bb[NI];
#pragma unroll
    for (int i = 0; i < 4; ++i) ab[i] = rowbase(m0 + r0 + i * 32) + c * 8;
#pragma unroll
    for (int i = 0; i < NI; ++i) {
        int nr = n0 + r0 + i * 32;
        if (nr > nBmax) nr = nBmax;
        bb[i] = Bt + (size_t)nr * ldb + c * 8;
    }
    uint4 ra[4], rb[NI];
    const int nk = K >> 6;
    const int lw = (c >> 2) * 8192 + r0 * 64 + (c & 3) * 16;
#pragma unroll
    for (int i = 0; i < 4; ++i) ra[i] = *(const uint4*)(ab[i]);
#pragma unroll
    for (int i = 0; i < NI; ++i) rb[i] = *(const uint4*)(bb[i]);
#pragma unroll
    for (int i = 0; i < 4; ++i) *(uint4*)(lds + lw + i * 2048) = ra[i];
#pragma unroll
    for (int i = 0; i < NI; ++i) *(uint4*)(lds + 16384 + lw + i * 2048) = rb[i];
    __syncthreads();
    for (int kt = 0; kt < nk; ++kt) {
        const int buf = kt & 1;
        if (kt + 1 < nk) {
            const size_t ao = (size_t)(kt + 1) * hi;
            const int bo = (kt + 1) * 64;
#pragma unroll
            for (int i = 0; i < 4; ++i) ra[i] = *(const uint4*)(ab[i] + ao);
#pragma unroll
            for (int i = 0; i < NI; ++i) rb[i] = *(const uint4*)(bb[i] + bo);
        }
        const char* la = lds + buf * 32768;
        const char* lb = la + 16384;
#pragma unroll
        for (int kp = 0; kp < 2; ++kp) {
            bf16x8 af[4], bf[NI];
#pragma unroll
            for (int i = 0; i < 4; ++i) af[i] = *(const bf16x8*)(la + kp * 8192 + (wr * 64 + i * 16 + fr) * 64 + fq * 16);
#pragma unroll
            for (int i = 0; i < NI; ++i) bf[i] = *(const bf16x8*)(lb + kp * 8192 + (wc * NI * 16 + i * 16 + fr) * 64 + fq * 16);
#pragma unroll
            for (int mi = 0; mi < 4; ++mi)
#pragma unroll
                for (int ni = 0; ni < NI; ++ni) acc[mi][ni] = TR ? mma(af[mi], bf[ni], acc[mi][ni]) : mma(bf[ni], af[mi], acc[mi][ni]);
        }
        if (kt + 1 < nk) {
            char* lwp = lds + (buf ^ 1) * 32768 + lw;
#pragma unroll
            for (int i = 0; i < 4; ++i) *(uint4*)(lwp + i * 2048) = ra[i];
#pragma unroll
            for (int i = 0; i < NI; ++i) *(uint4*)(lwp + 16384 + i * 2048) = rb[i];
        }
        __syncthreads();
    }
}
template <int NI>
DEVI void zero_acc(f32x4 (&acc)[4][NI]) {
#pragma unroll
    for (int i = 0; i < 4; ++i)
#pragma unroll
        for (int j = 0; j < NI; ++j) acc[i][j] = (f32x4){0.f, 0.f, 0.f, 0.f};
}
struct RowLin {
    const bf16_t* A; size_t lda;
    DEVI const bf16_t* operator()(int r) const { return A + (size_t)r * lda; }
};


template <bool TR>
DEVI void gemm2_main(f32x4 (&acc)[8][4], char* lds, const bf16_t* A, size_t lda, const bf16_t* Bt, int ldb, int nBmax, int m0, int n0, int K) {
    const int tid = tidx(), lane = tid & 63, wid = tid >> 6, wr = wid >> 1, wc = wid & 1, fr = lane & 15, fq = lane >> 4;
    const int c = tid & 3, r0 = tid >> 2;
    const bf16_t* ap = A + (size_t)(m0 + r0) * lda + c * 8;
    const bf16_t* bp0; const bf16_t* bp1;
    { int nr = n0 + r0; if (nr > nBmax) nr = nBmax; bp0 = Bt + (size_t)nr * ldb + c * 8; nr = n0 + r0 + 64; if (nr > nBmax) nr = nBmax; bp1 = Bt + (size_t)nr * ldb + c * 8; }
    const size_t a64 = (size_t)64 * lda;
    uint4 ra0, ra1, ra2, ra3, rb0, rb1;
    const int nk = K >> 5;
    const int lw = r0 * 64 + c * 16;
#define G2_LOAD(ko)                                                                                       \
    { ra0 = *(const uint4*)(ap + (ko)); ra1 = *(const uint4*)(ap + a64 + (ko)); ra2 = *(const uint4*)(ap + 2 * a64 + (ko)); \
      ra3 = *(const uint4*)(ap + 3 * a64 + (ko)); rb0 = *(const uint4*)(bp0 + (ko)); rb1 = *(const uint4*)(bp1 + (ko)); }
#define G2_STORE(st_)                                                                                     \
    { char* b_ = lds + (st_) * 24576 + lw; *(uint4*)(b_) = ra0; *(uint4*)(b_ + 4096) = ra1; *(uint4*)(b_ + 8192) = ra2; \
      *(uint4*)(b_ + 12288) = ra3; *(uint4*)(b_ + 16384) = rb0; *(uint4*)(b_ + 16384 + 4096) = rb1; }
    G2_LOAD(0);
    G2_STORE(0);
    __syncthreads();
    for (int kt = 0; kt < nk; ++kt) {
        const int st = kt & 1;
        if (kt + 1 < nk) G2_LOAD((kt + 1) * 32);
        const char* la = lds + st * 24576 + (wr * 128 + fr) * 64 + fq * 16;
        const char* lb = lds + st * 24576 + 16384 + (wc * 64 + fr) * 64 + fq * 16;
        bf16x8 bf[4];
#pragma unroll
        for (int i = 0; i < 4; ++i) bf[i] = *(const bf16x8*)(lb + i * 1024);
#pragma unroll
        for (int mi = 0; mi < 8; ++mi) {
            const bf16x8 af = *(const bf16x8*)(la + mi * 1024);
#pragma unroll
            for (int ni = 0; ni < 4; ++ni) acc[mi][ni] = TR ? mma(af, bf[ni], acc[mi][ni]) : mma(bf[ni], af, acc[mi][ni]);
        }
        if (kt + 1 < nk) G2_STORE(st ^ 1);
        __syncthreads();
    }
}

#define RAW_BARRIER() do { asm volatile("s_waitcnt lgkmcnt(0)" ::: "memory"); __builtin_amdgcn_s_barrier(); } while (0)
template <bool TR, int NI>
DEVI void gemm3_main(f32x4 (&acc)[8][NI], char* lds, const bf16_t* A, size_t lda, const bf16_t* Bt, int ldb, int nBmax, int m0, int n0, int K) {
    const int tid = tidx(), lane = tid & 63, wid = __builtin_amdgcn_readfirstlane(tid >> 6), wr = wid >> 1, wc = wid & 1, fr = lane & 15, fq = lane >> 4;
    const int c = tid & 3, r0 = tid >> 2;
    const bf16_t* ap = A + (size_t)(m0 + r0) * lda + c * 8;
    const bf16_t* bp0; const bf16_t* bp1;
    { int nr = n0 + r0; if (nr > nBmax) nr = nBmax; bp0 = Bt + (size_t)nr * ldb + c * 8; nr = n0 + r0 + 64; if (nr > nBmax) nr = nBmax; bp1 = Bt + (size_t)nr * ldb + c * 8; }
    const size_t a64 = (size_t)64 * lda;
    const int nk = K >> 5;
#define G3_ISSUE(kt_, st_)                                                                                                   \
    { char* d_ = lds + (st_) * 24576 + wid * 1024; const int ko_ = (kt_) * 32;                                               \
      __builtin_amdgcn_global_load_lds((const unsigned*)(ap + ko_), (unsigned*)(d_), 16, 0, 0);                               \
      __builtin_amdgcn_global_load_lds((const unsigned*)(ap + a64 + ko_), (unsigned*)(d_ + 4096), 16, 0, 0);                  \
      __builtin_amdgcn_global_load_lds((const unsigned*)(ap + 2 * a64 + ko_), (unsigned*)(d_ + 8192), 16, 0, 0);              \
      __builtin_amdgcn_global_load_lds((const unsigned*)(ap + 3 * a64 + ko_), (unsigned*)(d_ + 12288), 16, 0, 0);             \
      __builtin_amdgcn_global_load_lds((const unsigned*)(bp0 + ko_), (unsigned*)(d_ + 16384), 16, 0, 0);                      \
      if (NI == 4) __builtin_amdgcn_global_load_lds((const unsigned*)(bp1 + ko_), (unsigned*)(d_ + 20480), 16, 0, 0); }
    G3_ISSUE(0, 0);
    G3_ISSUE(1, 1);
    int st = 0;
    for (int kt = 0; kt < nk; ++kt) {
        if (kt + 1 < nk) { if (NI == 4) asm volatile("s_waitcnt vmcnt(6)" ::: "memory"); else asm volatile("s_waitcnt vmcnt(5)" ::: "memory"); }
        else asm volatile("s_waitcnt vmcnt(0)" ::: "memory");
        RAW_BARRIER();
        if (kt + 2 < nk) { const int s2 = st >= 1 ? st - 1 : 2; G3_ISSUE(kt + 2, s2); }
        const char* la = lds + st * 24576 + (wr * 128 + fr) * 64 + fq * 16;
        const char* lb = lds + st * 24576 + 16384 + (wc * NI * 16 + fr) * 64 + fq * 16;
        bf16x8 bf[NI];
#pragma unroll
        for (int i = 0; i < NI; ++i) bf[i] = *(const bf16x8*)(lb + i * 1024);
        __builtin_amdgcn_s_setprio(1);
#pragma unroll
        for (int mi = 0; mi < 8; ++mi) {
            const bf16x8 af = *(const bf16x8*)(la + mi * 1024);
#pragma unroll
            for (int ni = 0; ni < NI; ++ni) acc[mi][ni] = TR ? mma(af, bf[ni], acc[mi][ni]) : mma(bf[ni], af, acc[mi][ni]);
        }
        __builtin_amdgcn_s_setprio(0);
        st = st == 2 ? 0 : st + 1;
    }
    RAW_BARRIER();
}
DEVI void zero_acc2(f32x4 (&acc)[8][4]) {
#pragma unroll
    for (int i = 0; i < 8; ++i)
#pragma unroll
        for (int j = 0; j < 4; ++j) acc[i][j] = (f32x4){0.f, 0.f, 0.f, 0.f};
}
DEVI void rmsnorm_rows(const Params& p, int item) {
    const int thr_ = tidx();
    const int lane = thr_ & 63, wid = thr_ >> 6;
    const int row = item * 4 + wid;
    const float* xr = p.x + (size_t)row * DM;
    f32x4 v[8];
    float ss = 0.f;
#pragma unroll
    for (int i = 0; i < 8; ++i) { v[i] = *(const f32x4*)(xr + (i >> 1) * 512 + lane * 8 + (i & 1) * 4); ss += v[i][0] * v[i][0] + v[i][1] * v[i][1] + v[i][2] * v[i][2] + v[i][3] * v[i][3]; }
    ss = wave_sum(ss);
    const float rs = rsqrtf(ss * (1.f / DM) + 1e-6f);
    bf16_t* hr = (bf16_t*)(p.ws + O_H) + (size_t)row * DM;
#pragma unroll
    for (int i = 0; i < 8; i += 2) {
        const f32x4 g0 = *(const f32x4*)(p.pre_g + (i >> 1) * 512 + lane * 8), g1 = *(const f32x4*)(p.pre_g + (i >> 1) * 512 + lane * 8 + 4);
        *(uint4*)(hr + (i >> 1) * 512 + lane * 8) = make_uint4(pk2(v[i][0] * rs * g0[0], v[i][1] * rs * g0[1]), pk2(v[i][2] * rs * g0[2], v[i][3] * rs * g0[3]),
                                                            pk2(v[i + 1][0] * rs * g1[0], v[i + 1][1] * rs * g1[1]), pk2(v[i + 1][2] * rs * g1[2], v[i + 1][3] * rs * g1[3]));
    }
}
struct TJob { const float* src; bf16_t* dst; int K, ld, width; };
DEVI bool tjob(const Params& p, int j, TJob& t) {
    char* ws = p.ws;
    bf16_t* wint = (bf16_t*)(ws + O_WINT);
    switch (j) {
        case 0: t = {p.w_in, wint, 2048, DIN, 4096}; return true;
        case 1: t = {p.w_in + 4104, wint + (size_t)4096 * 2048, 2048, DIN, 2560}; return true;
        case 2: t = {p.w_in + 6712, wint + (size_t)6656 * 2048, 2048, DIN, 5120}; return true;
        case 3: t = {p.w_in + 4096, wint + (size_t)11776 * 2048, 2048, DIN, 8}; return true;
        case 4: t = {p.w_in + 6664, wint + (size_t)11784 * 2048, 2048, DIN, 48}; return true;
        case 5: t = {nullptr, wint + (size_t)11832 * 2048, 2048, DIN, 72}; return true;
        case 6: t = {p.w_up_m, (bf16_t*)(ws + O_WUM), 1024, 2048, 2048}; return true;
        case 7: t = {p.w_up_a, (bf16_t*)(ws + O_WUA), 1024, 2048, 2048}; return true;
        case 8: t = {p.w_out, (bf16_t*)(ws + O_WOUT), 2048, 2048, 2048}; return true;
        case 9: case 10: case 11: case 12: t = {p.w_q + (j - 9) * 65536, (bf16_t*)(ws + O_WQ) + (j - 9) * 65536, 256, 256, 256}; return true;
        case 13: case 14: case 15: case 16: t = {p.w_k + (j - 13) * 65536, (bf16_t*)(ws + O_WK) + (j - 13) * 65536, 256, 256, 256}; return true;
        case 17: t = {p.w1_k, (bf16_t*)(ws + O_W1K), 2048, 256, 256}; return true;
        case 18: t = {p.w1_v, (bf16_t*)(ws + O_W1V), 2048, 256, 256}; return true;
        case 19: t = {p.w2_k, (bf16_t*)(ws + O_W2K), 256, 64, 64}; return true;
        case 20: t = {p.w2_v, (bf16_t*)(ws + O_W2V), 256, 64, 64}; return true;
        default: return false;
    }
}
constexpr int N_TJOBS = 21;
constexpr int N_TTILES = 4264;
DEVI void transpose_item(const Params& p, int item, char* lds) {
    const int thr_ = tidx();
    TJob t;
    int j = 0;
    for (; j < N_TJOBS; ++j) {
        tjob(p, j, t);
        const int cnt = (t.K >> 6) * ((t.width + 127) >> 7);
        if (item < cnt) break;
        item -= cnt;
    }
    if (j >= N_TJOBS) return;
    const int tk = t.K >> 6;
    const int kt = item % tk, nt = item / tk;
    const int lane = thr_ & 63, wid = thr_ >> 6, kg = lane >> 3, nc = lane & 7;
    const int k0 = kt * 64 + kg * 8, n = nt * 128 + wid * 32 + nc * 4;
    if (n >= t.width) return;
    f32x4 v[8];
    if (t.src) {
        const float* sp = t.src + (size_t)k0 * t.ld + n;
#pragma unroll
        for (int r = 0; r < 8; ++r) v[r] = *(const f32x4*)(sp + (size_t)r * t.ld);
    } else {
#pragma unroll
        for (int r = 0; r < 8; ++r) v[r] = (f32x4){0.f, 0.f, 0.f, 0.f};
    }
    bf16_t* d = t.dst + (size_t)n * t.K + k0;
#pragma unroll
    for (int jj = 0; jj < 4; ++jj)
        *(uint4*)(d + (size_t)jj * t.K) = make_uint4(pk2(v[0][jj], v[1][jj]), pk2(v[2][jj], v[3][jj]), pk2(v[4][jj], v[5][jj]), pk2(v[6][jj], v[7][jj]));
}
DEVI void bias_item(const Params& p, int item) {
    const int thr_ = tidx();
    const int kv = item >> 4, seg = item & 15, j = thr_;
    const float* pe = kv ? p.pe_v : p.pe_k;
    const float* w1 = kv ? p.w1_v : p.w1_k;
    float a = 0.f;
#pragma unroll 8
    for (int k = seg * 128; k < seg * 128 + 128; ++k) a += pe[k] * w1[(size_t)k * 256 + j];
    ((float*)(p.ws + O_B1P))[(kv * 16 + seg) * 256 + j] = a;
}

DEVI void inproj_tile(const Params& p, int item, char* lds) {
    const int ni_ = item >> 5, mt = item & 31;
    const int nt = ni_ < 4 ? 40 + ni_ : (ni_ < 44 ? ni_ - 4 : ni_);
    const int m0 = mt * 256, n0 = nt * 128;
    const bool tr = (nt >= 8 && nt < 16) || nt == 46 || nt == 47 || nt == 50 || nt == 51;
    const int tid = tidx(), lane = tid & 63, wid = tid >> 6, wr = wid >> 1, wc = wid & 1, fr = lane & 15, fq = lane >> 4;
    f32x4 acc[8][4];
    zero_acc2(acc);
    const bf16_t* A = (const bf16_t*)(p.ws + O_H);
    const bf16_t* Bt = (const bf16_t*)(p.ws + O_WINT);
    if (tr) {
        gemm3_main<true, 4>(acc, lds, A, DM, Bt, DM, NP - 1, m0, n0, DM);
        bf16_t* base; int cb, ncol;
        if (nt < 16) { base = (bf16_t*)(p.ws + O_VMT); cb = C_MV; ncol = 1024; }
        else if (nt < 48) { base = (bf16_t*)(p.ws + O_VST); cb = C_VS; ncol = 256; }
        else { base = (bf16_t*)(p.ws + O_VWT); cb = C_VW; ncol = 256; }
#pragma unroll
        for (int mi = 0; mi < 8; mi += 2)
#pragma unroll
            for (int ni = 0; ni < 4; ++ni) {
                const int row = m0 + wr * 128 + (mi + (fq & 1)) * 16 + (fq >> 1) * 8, col = n0 + wc * 64 + ni * 16 + fr - cb;
                const int b = row >> 11, s_ = row & 2047;
                uint2 x, y;
                x.x = pk2(acc[mi][ni][0], acc[mi][ni][1]); x.y = pk2(acc[mi][ni][2], acc[mi][ni][3]);
                y.x = pk2(acc[mi + 1][ni][0], acc[mi + 1][ni][1]); y.y = pk2(acc[mi + 1][ni][2], acc[mi + 1][ni][3]);
                store_nt16(base + ((size_t)(b * ncol + col)) * S + s_, pair16(x, y));
            }
    } else {
        gemm3_main<false, 4>(acc, lds, A, DM, Bt, DM, NP - 1, m0, n0, DM);
        if (n0 == C_GATE) {
            float* G = (float*)(p.ws + O_G);
#pragma unroll
            for (int mi = 0; mi < 8; ++mi)
#pragma unroll
                for (int ni = 0; ni < 4; ++ni) {
                    const int row = m0 + wr * 128 + mi * 16 + fr, cl = wc * 64 + ni * 16 + fq * 4;
                    if (cl < 56) *(f32x4*)(G + (size_t)row * 64 + cl) = acc[mi][ni];
                }
        } else {
            bf16_t* P = (bf16_t*)(p.ws + O_P);
#pragma unroll
            for (int mi = 0; mi < 8; ++mi)
#pragma unroll
                for (int ni = 0; ni < 4; ni += 2) {
                    const int row = m0 + wr * 128 + mi * 16 + fr, col = n0 + wc * 64 + (ni + (fq & 1)) * 16 + (fq >> 1) * 8;
                    uint2 x, y;
                    x.x = pk2(acc[mi][ni][0], acc[mi][ni][1]); x.y = pk2(acc[mi][ni][2], acc[mi][ni][3]);
                    y.x = pk2(acc[mi][ni + 1][0], acc[mi][ni + 1][1]); y.y = pk2(acc[mi][ni + 1][2], acc[mi][ni + 1][3]);
                    store_nt16(P + (size_t)row * NPS + col, pair16(x, y));
                }
        }
    }
    if (ni_ < 4) {
        asm volatile("s_waitcnt vmcnt(0)" ::: "memory");
        __syncthreads();
        if (threadIdx.x == 0) {
            __builtin_amdgcn_fence(__ATOMIC_RELEASE, "agent");
            asm volatile("s_waitcnt vmcnt(0)" ::: "memory");
            xb_add((unsigned*)(p.ws + O_BAR) + 0, 1u);
        }
    }
}

DEVI void conv_item(const Params& p, int item) {
    const int thr_ = tidx();
    const int tok0 = item * 16 + (thr_ >> 7) * 8, c = (thr_ & 127) * 8;
    const int s0 = tok0 & 2047;
    const bf16_t* P = (const bf16_t*)(p.ws + O_P);
    uint4 xr[11];
#pragma unroll
    for (int j = 0; j < 11; ++j) {
        xr[j] = make_uint4(0u, 0u, 0u, 0u);
        if (s0 + j - 3 >= 0) xr[j] = *(const uint4*)(P + (size_t)(tok0 + j - 3) * NPS + C_MX + c);
    }
    f32x4 w[4][2];
#pragma unroll
    for (int k = 0; k < 4; ++k) { w[k][0] = *(const f32x4*)(p.conv_w + k * 1024 + c); w[k][1] = *(const f32x4*)(p.conv_w + k * 1024 + c + 4); }
    const f32x4 b0 = *(const f32x4*)(p.conv_b + c), b1 = *(const f32x4*)(p.conv_b + c + 4);
#pragma unroll
    for (int t = 0; t < 8; ++t) {
        f32x4 a0 = b0, a1 = b1;
#pragma unroll
        for (int k = 0; k < 4; ++k) {
            const uint4 xv = xr[t + k];
            a0 += (f32x4){lo16(xv.x), hi16(xv.x), lo16(xv.y), hi16(xv.y)} * w[k][0];
            a1 += (f32x4){lo16(xv.z), hi16(xv.z), lo16(xv.w), hi16(xv.w)} * w[k][1];
        }
        *(uint4*)((bf16_t*)(p.ws + O_XC) + (size_t)(tok0 + t) * 1024 + c) =
            make_uint4(pk2(silu(a0[0]), silu(a0[1])), pk2(silu(a0[2]), silu(a0[3])), pk2(silu(a1[0]), silu(a1[1])), pk2(silu(a1[2]), silu(a1[3])));
    }
}
struct RowCmp {
    const bf16_t* Pc;
    DEVI const bf16_t* operator()(int r) const {
        if (r > 2031) r = 2031;
        const int bg = r / 127, n = r - bg * 127, b = bg >> 2, g = bg & 3;
        return Pc + (size_t)(b * S + 16 * n) * NPS + g * 64;
    }
};
DEVI void cmp1_tile(const Params& p, int item, char* lds) {
    const int kv = item >> 5, mt = (item >> 1) & 15, nt = item & 1;
    const int m0 = mt * 128, n0 = nt * 128;
    const int tid = tidx(), lane = tid & 63, wid = tid >> 6, wr = wid >> 1, wc = wid & 1, fr = lane & 15, fq = lane >> 4;
    f32x4 acc[4][4];
    zero_acc(acc);
    RowCmp rc{(const bf16_t*)(p.ws + O_P) + (kv ? C_VC : C_KC)};
    gemm_main<false, 4>(acc, lds, rc, (size_t)NPS, (const bf16_t*)(p.ws + (kv ? O_W1V : O_W1K)), 2048, 255, m0, n0, 2048);
    const float* bp = (const float*)(p.ws + O_B1P) + kv * 16 * 256;
    bf16_t* HC = (bf16_t*)(p.ws + O_HC) + (size_t)kv * 2048 * 256;
#pragma unroll
    for (int ni = 0; ni < 4; ++ni) {
        const int col = n0 + wc * 64 + ni * 16 + fq * 4;
        f32x4 bs = {0.f, 0.f, 0.f, 0.f};
        for (int sg = 0; sg < 16; ++sg) bs += *(const f32x4*)(bp + sg * 256 + col);
#pragma unroll
        for (int mi = 0; mi < 4; ++mi) {
            const int row = m0 + wr * 64 + mi * 16 + fr;
            const f32x4 v = acc[mi][ni] + bs;
            uint2 o; o.x = pk2(silu(v[0]), silu(v[1])); o.y = pk2(silu(v[2]), silu(v[3]));
            *(uint2*)(HC + (size_t)row * 256 + col) = o;
        }
    }
}
DEVI void scan_item(const Params& p, int item, char* lds) {
    const int thr_ = tidx();
    const int b = item >> 2, h = item & 3, tid = thr_;
    const float* G = (const float*)(p.ws + O_G);
    float* red = (float*)lds;
    const float bi = p.b_i[h], bfv = p.b_f[h];
    float ig[8], F[8];
    float run = 0.f;
#pragma unroll
    for (int i = 0; i < 8; ++i) {
        const size_t tok = (size_t)b * S + tid * 8 + i;
        ig[i] = G[tok * 64 + h] + bi;
        const float fg = G[tok * 64 + 4 + h] + bfv;
        const float lf = fminf(fg, 0.f) - log1pf(expf(-fabsf(fg)));
        run += lf;
        F[i] = run;
    }
    red[tid] = run;
    __syncthreads();
    float ex = 0.f;
    for (int j = 0; j < tid; ++j) ex += red[j];
    __syncthreads();
    float a[8], mx[8];
    float rm = -1e30f;
#pragma unroll
    for (int i = 0; i < 8; ++i) { F[i] += ex; a[i] = ig[i] - F[i]; rm = fmaxf(rm, a[i]); mx[i] = rm; }
    red[tid] = rm;
    __syncthreads();
    float em = -1e30f;
    for (int j = 0; j < tid; ++j) em = fmaxf(em, red[j]);
    __syncthreads();
    float* FA = (float*)(p.ws + O_FA) + item * S + tid * 8;
    float* FM = (float*)(p.ws + O_FM) + item * S + tid * 8;
    float* FL = (float*)(p.ws + O_FL) + item * S + tid * 8;
#pragma unroll
    for (int i = 0; i < 8; ++i) { const float m = fmaxf(mx[i], em); FA[i] = a[i]; FM[i] = m; FL[i] = F[i] + m; }
}

DEVI void qk_tile(const Params& p, int item, char* lds) {
    const int nt = item & 1, mt = (item >> 1) & 63, h = (item >> 7) & 3, qk = item >> 9;
    const int m0 = mt * 128, n0 = nt * 128;
    const int tid = tidx(), lane = tid & 63, wid = tid >> 6, wr = wid >> 1, wc = wid & 1, fr = lane & 15, fq = lane >> 4;
    f32x4 acc[4][4];
    zero_acc(acc);
    RowLin rl{(const bf16_t*)(p.ws + O_XC) + h * 256, (size_t)1024};
    gemm_main<false, 4>(acc, lds, rl, 64, (const bf16_t*)(p.ws + (qk ? O_WK : O_WQ)) + h * 65536, 256, 255, m0, n0, 256);
    bf16_t* O = (bf16_t*)(p.ws + (qk ? O_KM : O_QM));
    const float sc = qk ? 0.0625f : 1.f;
#pragma unroll
    for (int mi = 0; mi < 4; ++mi)
#pragma unroll
        for (int ni = 0; ni < 4; ni += 2) {
            const int row = m0 + wr * 64 + mi * 16 + fr, col = h * 256 + n0 + wc * 64 + (ni + (fq & 1)) * 16 + (fq >> 1) * 8;
            uint2 x, y;
            x.x = pk2(acc[mi][ni][0] * sc, acc[mi][ni][1] * sc); x.y = pk2(acc[mi][ni][2] * sc, acc[mi][ni][3] * sc);
            y.x = pk2(acc[mi][ni + 1][0] * sc, acc[mi][ni + 1][1] * sc); y.y = pk2(acc[mi][ni + 1][2] * sc, acc[mi][ni + 1][3] * sc);
            *(uint4*)(O + (size_t)row * 1024 + col) = pair16(x, y);
        }
}
DEVI void cmp2_tile(const Params& p, int item, char* lds) {
    const int kv = item >> 4, mt = item & 15, m0 = mt * 128;
    const int tid = tidx(), lane = tid & 63, wid = tid >> 6, wr = wid >> 1, wc = wid & 1, fr = lane & 15, fq = lane >> 4;
    f32x4 acc[4][4];
    zero_acc(acc);
    RowLin rl{(const bf16_t*)(p.ws + O_HC) + (size_t)kv * 2048 * 256, (size_t)256};
    gemm_main<false, 4>(acc, lds, rl, 64, (const bf16_t*)(p.ws + (kv ? O_W2V : O_W2K)), 256, 63, m0, 0, 256);
    float* O = (float*)(p.ws + (kv ? O_VCF : O_KCF));
    if (wc == 0) {
#pragma unroll
        for (int mi = 0; mi < 4; ++mi)
#pragma unroll
            for (int ni = 0; ni < 4; ++ni) {
                const int row = m0 + wr * 64 + mi * 16 + fr, col = ni * 16 + fq * 4;
                if (row < 2032) *(f32x4*)(O + (size_t)row * 64 + col) = acc[mi][ni];
            }
    }
}

DEVI void mlstm_item(const Params& p, int item) {
    const int thr_ = tidx();
    const int qb = 31 - (item >> 4), bh = item & 15, b = bh >> 2, h = bh & 3;
    const int lane = thr_ & 63, wid = __builtin_amdgcn_readfirstlane(thr_ >> 6), fr = lane & 15, fq = lane >> 4;
    const int t0 = qb * 64 + wid * 16, trow = t0 + fr;
    const bf16_t* Qm = (const bf16_t*)(p.ws + O_QM);
    const bf16_t* Km = (const bf16_t*)(p.ws + O_KM);
    const bf16_t* VmT = (const bf16_t*)(p.ws + O_VMT);
    const float* fa = (const float*)(p.ws + O_FA) + bh * S;
    const float mx = ((const float*)(p.ws + O_FM))[bh * S + trow];
    bf16x8 qf[8];
    {
        const bf16_t* qrow = Qm + (size_t)(b * S + trow) * 1024 + h * 256 + fq * 8;
#pragma unroll
        for (int ks = 0; ks < 8; ++ks) qf[ks] = *(const bf16x8*)(qrow + ks * 32);
    }
    f32x4 o[16];
#pragma unroll
    for (int i = 0; i < 16; ++i) o[i] = (f32x4){0.f, 0.f, 0.f, 0.f};
    float den = 0.f;
    const bf16_t* kbase = Km + (size_t)(b * S + fr) * 1024 + h * 256 + fq * 8;
    const bf16_t* vbase = VmT + ((size_t)(b * 1024 + h * 256 + fr)) * S + fq * 4;
    for (int s0 = 0; s0 < t0 + 16; s0 += 32) {
        f32x4 sa = {0.f, 0.f, 0.f, 0.f}, sb = {0.f, 0.f, 0.f, 0.f};
        const bf16_t* k0 = kbase + (size_t)s0 * 1024;
        const bf16_t* k1 = k0 + 16 * 1024;
#pragma unroll
        for (int ks = 0; ks < 8; ++ks) {
            sa = mma(*(const bf16x8*)(k0 + ks * 32), qf[ks], sa);
            sb = mma(*(const bf16x8*)(k1 + ks * 32), qf[ks], sb);
            if (ks == 3) __builtin_amdgcn_sched_barrier(0);
        }
        __builtin_amdgcn_sched_barrier(0);
        const f32x4 a0 = *(const f32x4*)(fa + s0 + fq * 4), a1 = *(const f32x4*)(fa + s0 + 16 + fq * 4);
        float pv[8];
#pragma unroll
        for (int r = 0; r < 4; ++r) {
            const int s = s0 + fq * 4 + r;
            const float w0 = (s <= trow) ? __expf(a0[r] - mx) : 0.f;
            const float w1 = (s + 16 <= trow) ? __expf(a1[r] - mx) : 0.f;
            pv[r] = sa[r] * w0; pv[4 + r] = sb[r] * w1;
            den += pv[r] + pv[4 + r];
        }
        const bf16x8 pf = pack8(pv);
#pragma unroll
        for (int dvt = 0; dvt < 16; ++dvt) {
            const bf16_t* vp = vbase + (size_t)(dvt * 16) * S + s0;
            const bf16x8 vf = join8(*(const uint2*)vp, *(const uint2*)(vp + 16));
            o[dvt] = mma(vf, pf, o[dvt]);
            if ((dvt & 3) == 3) __builtin_amdgcn_sched_barrier(0);
        }
    }
    den += __shfl_xor(den, 16);
    den += __shfl_xor(den, 32);
    const float lower = __expf(-((const float*)(p.ws + O_FL))[bh * S + trow]);
    const float inv = 1.f / fmaxf(fabsf(den), lower);
    const bf16_t* Prow = (const bf16_t*)(p.ws + O_P) + (size_t)(b * S + trow) * NPS;
    float sum = 0.f;
#pragma unroll
    for (int dvt = 0; dvt < 16; ++dvt) {
        const int c = h * 256 + dvt * 16 + fq * 4;
        const uint2 op = *(const uint2*)(Prow + C_MO + c);
        o[dvt][0] *= inv * sigm(lo16(op.x)); o[dvt][1] *= inv * sigm(hi16(op.x)); o[dvt][2] *= inv * sigm(lo16(op.y)); o[dvt][3] *= inv * sigm(hi16(op.y));
        sum += o[dvt][0] + o[dvt][1] + o[dvt][2] + o[dvt][3];
    }
    sum += __shfl_xor(sum, 16);
    sum += __shfl_xor(sum, 32);
    const float mu = sum * (1.f / 256.f);
    float vs = 0.f;
#pragma unroll
    for (int dvt = 0; dvt < 16; ++dvt)
#pragma unroll
        for (int r = 0; r < 4; ++r) { const float d = o[dvt][r] - mu; vs += d * d; }
    vs += __shfl_xor(vs, 16);
    vs += __shfl_xor(vs, 32);
    const float rstd = rsqrtf(vs * (1.f / 256.f) + 1e-6f);
    const bf16_t* xcrow = (const bf16_t*)(p.ws + O_XC) + (size_t)(b * S + trow) * 1024;
    bf16_t* ymrow = (bf16_t*)(p.ws + O_YM) + (size_t)(b * S + trow) * 1024;
#pragma unroll
    for (int dvt = 0; dvt < 16; ++dvt) {
        const int c = h * 256 + dvt * 16 + fq * 4;
        const f32x4 ng = *(const f32x4*)(p.norm_g + c), sk = *(const f32x4*)(p.skip + c);
        const uint2 xc = *(const uint2*)(xcrow + c), mz = *(const uint2*)(Prow + C_MZ + c);
        const float y0 = ((o[dvt][0] - mu) * rstd * ng[0] + sk[0] * lo16(xc.x)) * silu(lo16(mz.x));
        const float y1 = ((o[dvt][1] - mu) * rstd * ng[1] + sk[1] * hi16(xc.x)) * silu(hi16(mz.x));
        const float y2 = ((o[dvt][2] - mu) * rstd * ng[2] + sk[2] * lo16(xc.y)) * silu(lo16(mz.y));
        const float y3 = ((o[dvt][3] - mu) * rstd * ng[3] + sk[3] * hi16(xc.y)) * silu(hi16(mz.y));
        uint2 ov; ov.x = pk2(y0, y1); ov.y = pk2(y2, y3);
        *(uint2*)(ymrow + c) = ov;
    }
}

DEVI void cmp_item(const Params& p, int item, char* lds) {
    const int thr_ = tidx();
    const int tt = item & 31, bg = item >> 5, b = bg >> 2, g = bg & 3;
    const int lane = thr_ & 63, wid = __builtin_amdgcn_readfirstlane(thr_ >> 6);
    float* kcs = (float*)lds;
    float* psum = (float*)(lds + 33280) + wid * 128;
    const float* KC = (const float*)(p.ws + O_KCF) + (size_t)bg * 127 * 64;
    const float* VC = (const float*)(p.ws + O_VCF) + (size_t)bg * 127 * 64;
    for (int i = thr_; i < 127 * 64; i += 256) kcs[(i >> 6) * 65 + (i & 63)] = KC[i];
    __syncthreads();
    const bf16_t* P = (const bf16_t*)(p.ws + O_P);
    bf16_t* OC = (bf16_t*)(p.ws + O_OC);
    unsigned* SEL = (unsigned*)(p.ws + O_SEL);
#pragma unroll 1
    for (int i = 0; i < 16; ++i) {
        const int t = tt * 64 + wid * 16 + i;
        const size_t tok = (size_t)b * S + t;
        const int nvalid = t >= 31 ? ((t - 31) >> 4) + 1 : 0;
        unsigned mask = 1u;
        if (nvalid == 0) {
#pragma unroll
            for (int h = 0; h < 4; ++h) OC[tok * 1024 + (g * 4 + h) * 64 + lane] = 0;
        } else {
            float qh[4];
#pragma unroll
            for (int h = 0; h < 4; ++h) qh[h] = bf2f(P[tok * NPS + C_AQ + (g * 4 + h) * 64 + lane]) * 0.125f;
            float s0[4] = {0.f, 0.f, 0.f, 0.f}, s1[4] = {0.f, 0.f, 0.f, 0.f};
            const int n1 = lane + 64 > 126 ? 126 : lane + 64;
            const float* k0p = kcs + lane * 65;
            const float* k1p = kcs + n1 * 65;
#pragma unroll
            for (int d = 0; d < 64; ++d) {
                const float k0 = k0p[d], k1 = k1p[d];
#pragma unroll
                for (int h = 0; h < 4; ++h) { const float qd = rdlane(qh[h], d); s0[h] += qd * k0; s1[h] += qd * k1; }
            }
            const bool v0 = lane < nvalid, v1 = lane + 64 < nvalid;
            float p0[4], p1[4];
#pragma unroll
            for (int h = 0; h < 4; ++h) {
                const float mxv = wave_max(fmaxf(v0 ? s0[h] : -1e30f, v1 ? s1[h] : -1e30f));
                const float e0 = v0 ? __expf(s0[h] - mxv) : 0.f, e1 = v1 ? __expf(s1[h] - mxv) : 0.f;
                const float sm = wave_sum(e0 + e1);
                const float is = 1.f / sm;
                p0[h] = e0 * is; p1[h] = e1 * is;
            }
            float oc[4] = {0.f, 0.f, 0.f, 0.f};
            const int na = nvalid < 64 ? nvalid : 64;
            for (int n = 0; n < na; ++n) {
                const float vv = VC[n * 64 + lane];
#pragma unroll
                for (int h = 0; h < 4; ++h) oc[h] += rdlane(p0[h], n) * vv;
            }
            for (int n = 64; n < nvalid; ++n) {
                const float vv = VC[n * 64 + lane];
#pragma unroll
                for (int h = 0; h < 4; ++h) oc[h] += rdlane(p1[h], n - 64) * vv;
            }
#pragma unroll
            for (int h = 0; h < 4; ++h) OC[tok * 1024 + (g * 4 + h) * 64 + lane] = f2bf(oc[h]);
            psum[lane] = p0[0] + p0[1] + p0[2] + p0[3];
            psum[lane + 64] = (lane + 64 < 127) ? (p1[0] + p1[1] + p1[2] + p1[3]) : 0.f;
            __builtin_amdgcn_wave_barrier();
            float sc = -3e30f;
            const int cur = t >> 6;
            if (lane < 32) {
                float imp = 0.f;
#pragma unroll
                for (int k = -1; k < 4; ++k) { const int n = 4 * lane + k; if (n >= 0) imp += psum[n]; }
                const bool forced = lane == 0 || lane == cur || lane == cur - 1;
                sc = forced ? 1e30f : (lane <= cur ? imp : -1e30f);
            }
            __builtin_amdgcn_wave_barrier();
            mask = 0u;
#pragma unroll 1
            for (int it = 0; it < 8; ++it) {
                const float mv = wave_max(sc);
                const unsigned long long bal = __ballot(sc == mv);
                const int win = __ffsll((long long)bal) - 1;
                mask |= 1u << win;
                if (lane == win) sc = -4e30f;
            }
        }
        if (lane == 0) SEL[bg * S + t] = mask;
    }
    __syncthreads();
}

DEVI void attn_chunk(f32x4 (&o)[4], float& m, float& l, bf16x8 q0, bf16x8 q1, const bf16_t* kp, const bf16_t* vp, unsigned vm) {
    f32x4 sa = {0.f, 0.f, 0.f, 0.f}, sb = {0.f, 0.f, 0.f, 0.f};
    sa = mma(*(const bf16x8*)(kp), q0, sa);
    sa = mma(*(const bf16x8*)(kp + 32), q1, sa);
    sb = mma(*(const bf16x8*)(kp + (size_t)16 * NPS), q0, sb);
    sb = mma(*(const bf16x8*)(kp + (size_t)16 * NPS + 32), q1, sb);
    float v[8];
#pragma unroll
    for (int r = 0; r < 4; ++r) { v[r] = sa[r] * 0.125f; v[4 + r] = sb[r] * 0.125f; }
    float mxv = -1e30f;
#pragma unroll
    for (int e = 0; e < 8; ++e) if ((vm >> e) & 1u) mxv = fmaxf(mxv, v[e]);
    mxv = fmaxf(mxv, __shfl_xor(mxv, 16));
    mxv = fmaxf(mxv, __shfl_xor(mxv, 32));
    const float mn = fmaxf(m, mxv);
    const float alpha = __expf(m - mn);
    m = mn;
    float ps = 0.f;
#pragma unroll
    for (int e = 0; e < 8; ++e) { v[e] = ((vm >> e) & 1u) ? __expf(v[e] - mn) : 0.f; ps += v[e]; }
    l = l * alpha + ps;
    const bf16x8 pf = pack8(v);
#pragma unroll
    for (int dvt = 0; dvt < 4; ++dvt) {
        o[dvt] *= alpha;
        const bf16_t* vq = vp + (size_t)(dvt * 16) * S;
        const bf16x8 vf = join8(*(const uint2*)vq, *(const uint2*)(vq + 16));
        o[dvt] = mma(vf, pf, o[dvt]);
    }
}
template <bool SELB>
DEVI void nsa_item(const Params& p, int item) {
    const int thr_ = tidx();
    const int tile = item & 127, bg = item >> 7, b = bg >> 2, g = bg & 3;
    const int lane = thr_ & 63, wid = __builtin_amdgcn_readfirstlane(thr_ >> 6), fr = lane & 15, fq = lane >> 4;
    const int hd = g * 4 + wid, t0 = tile * 16, trow = t0 + fr;
    const bf16_t* P = (const bf16_t*)(p.ws + O_P);
    const size_t tok = (size_t)b * S + trow;
    const bf16_t* qp = P + tok * NPS + C_AQ + hd * 64 + fq * 8;
    const bf16x8 q0 = *(const bf16x8*)qp, q1 = *(const bf16x8*)(qp + 32);
    const bf16_t* kb = P + (size_t)(b * S + fr) * NPS + (SELB ? C_KS : C_KW) + g * 64 + fq * 8;
    const bf16_t* vb = (const bf16_t*)(p.ws + (SELB ? O_VST : O_VWT)) + (size_t)(b * 256 + g * 64 + fr) * S + fq * 4;
    f32x4 o[4];
#pragma unroll
    for (int i = 0; i < 4; ++i) o[i] = (f32x4){0.f, 0.f, 0.f, 0.f};
    float m = -1e30f, l = 0.f;
    if (!SELB) {
        int lo = t0 - 511;
        if (lo < 0) lo = 0;
        for (int s0 = lo & ~31; s0 < t0 + 16; s0 += 32) {
            unsigned vm = 0;
#pragma unroll
            for (int e = 0; e < 8; ++e) { const int s = s0 + (e >> 2) * 16 + fq * 4 + (e & 3); if (s <= trow && s > trow - 512) vm |= 1u << e; }
            attn_chunk(o, m, l, q0, q1, kb + (size_t)s0 * NPS, vb + s0, vm);
        }
    } else {
        const unsigned rm = ((const unsigned*)(p.ws + O_SEL))[bg * S + trow];
        unsigned un = rm;
        un |= __shfl_xor(un, 1); un |= __shfl_xor(un, 2); un |= __shfl_xor(un, 4); un |= __shfl_xor(un, 8);
        un = __builtin_amdgcn_readfirstlane(un);
        const int cur = t0 >> 6;
        for (int j = 0; j <= cur; ++j) {
            if (!((un >> j) & 1u)) continue;
            const bool rs = (rm >> j) & 1u;
#pragma unroll
            for (int hf = 0; hf < 2; ++hf) {
                const int s0 = j * 64 + hf * 32;
                unsigned vm = 0;
#pragma unroll
                for (int e = 0; e < 8; ++e) { const int s = s0 + (e >> 2) * 16 + fq * 4 + (e & 3); if (rs && s <= trow) vm |= 1u << e; }
                attn_chunk(o, m, l, q0, q1, kb + (size_t)s0 * NPS, vb + s0, vm);
            }
        }
    }
    l += __shfl_xor(l, 16);
    l += __shfl_xor(l, 32);
    const float inv = 1.f / l;
    if (!SELB) {
        bf16_t* OW = (bf16_t*)(p.ws + O_OW) + tok * 1024 + hd * 64 + fq * 4;
#pragma unroll
        for (int dvt = 0; dvt < 4; ++dvt) {
            uint2 ov; ov.x = pk2(o[dvt][0] * inv, o[dvt][1] * inv); ov.y = pk2(o[dvt][2] * inv, o[dvt][3] * inv);
            *(uint2*)(OW + dvt * 16) = ov;
        }
    } else {
        const float* G = (const float*)(p.ws + O_G) + tok * 64 + 8 + hd * 3;
        const float g0 = sigm(G[0]), g1 = sigm(G[1]) * inv, g2 = sigm(G[2]);
        const bf16_t* OC = (const bf16_t*)(p.ws + O_OC) + tok * 1024 + hd * 64 + fq * 4;
        const bf16_t* OW = (const bf16_t*)(p.ws + O_OW) + tok * 1024 + hd * 64 + fq * 4;
        const bf16_t* AZ = P + tok * NPS + C_AZ + hd * 64 + fq * 4;
        bf16_t* YA = (bf16_t*)(p.ws + O_YA) + tok * 1024 + hd * 64 + fq * 4;
#pragma unroll
        for (int dvt = 0; dvt < 4; ++dvt) {
            const uint2 oc = *(const uint2*)(OC + dvt * 16), ow = *(const uint2*)(OW + dvt * 16), az = *(const uint2*)(AZ + dvt * 16);
            const float y0 = (g0 * lo16(oc.x) + g1 * o[dvt][0] + g2 * lo16(ow.x)) * silu(lo16(az.x));
            const float y1 = (g0 * hi16(oc.x) + g1 * o[dvt][1] + g2 * hi16(ow.x)) * silu(hi16(az.x));
            const float y2 = (g0 * lo16(oc.y) + g1 * o[dvt][2] + g2 * lo16(ow.y)) * silu(lo16(az.y));
            const float y3 = (g0 * hi16(oc.y) + g1 * o[dvt][3] + g2 * hi16(ow.y)) * silu(hi16(az.y));
            uint2 ov; ov.x = pk2(y0, y1); ov.y = pk2(y2, y3);
            *(uint2*)(YA + dvt * 16) = ov;
        }
    }
}


constexpr int ML_K = 16384, ML_V = 20480, ML_STAGE = ML_K + ML_V;
DEVI void mlstm2_item(const Params& p, int item, char* lds) {
    const int thr_ = tidx();
    const int half = item >> 8, idx = item & 255;
    const int qb = half ? (idx >> 4) : 31 - (idx >> 4), bh = idx & 15, b = bh >> 2, h = bh & 3;
    const int lane = thr_ & 63, wid = __builtin_amdgcn_readfirstlane(thr_ >> 6), fr = lane & 15, fq = lane >> 4;
    const int T0 = qb * 64, t0 = T0 + wid * 16, trow = t0 + fr;
    const bf16_t* Km = (const bf16_t*)(p.ws + O_KM) + (size_t)(b * S) * 1024 + h * 256;
    const bf16_t* VmT = (const bf16_t*)(p.ws + O_VMT) + (size_t)(b * 1024 + h * 256) * S;
    const float* fa = (const float*)(p.ws + O_FA) + bh * S;
    const float mx = ((const float*)(p.ws + O_FM))[bh * S + trow];
    bf16x8 qf[8];
    {
        const bf16_t* qrow = (const bf16_t*)(p.ws + O_QM) + (size_t)(b * S + trow) * 1024 + h * 256 + fq * 8;
#pragma unroll
        for (int ks = 0; ks < 8; ++ks) qf[ks] = *(const bf16x8*)(qrow + ks * 32);
    }
    f32x4 o[16];
#pragma unroll
    for (int i = 0; i < 16; ++i) o[i] = (f32x4){0.f, 0.f, 0.f, 0.f};
    float den = 0.f;
    const int kr = thr_ >> 5, kc = thr_ & 31, vr = thr_ >> 2, vc = thr_ & 3;
    uint4 rk0, rk1, rk2, rk3, rv0, rv1, rv2, rv3;
#define ML_GLOAD(s0_)                                                                      \
    {                                                                                      \
        const bf16_t* kp_ = Km + (size_t)((s0_) + kr) * 1024 + kc * 8;                     \
        rk0 = *(const uint4*)(kp_); rk1 = *(const uint4*)(kp_ + 8 * 1024);                 \
        rk2 = *(const uint4*)(kp_ + 16 * 1024); rk3 = *(const uint4*)(kp_ + 24 * 1024);    \
        const bf16_t* vp_ = VmT + (size_t)vr * S + (s0_) + vc * 8;                         \
        rv0 = *(const uint4*)(vp_); rv1 = *(const uint4*)(vp_ + (size_t)64 * S);           \
        rv2 = *(const uint4*)(vp_ + (size_t)128 * S); rv3 = *(const uint4*)(vp_ + (size_t)192 * S); \
    }
#define ML_LSTORE(st_)                                                                     \
    {                                                                                      \
        char* kb_ = lds + (st_) * ML_STAGE + (kc >> 2) * 2048 + kr * 64 + (kc & 3) * 16;   \
        *(uint4*)(kb_) = rk0; *(uint4*)(kb_ + 8 * 64) = rk1; *(uint4*)(kb_ + 16 * 64) = rk2; *(uint4*)(kb_ + 24 * 64) = rk3; \
        char* vb_ = lds + (st_) * ML_STAGE + ML_K + vr * 80 + vc * 16;                     \
        *(uint4*)(vb_) = rv0; *(uint4*)(vb_ + 64 * 80) = rv1; *(uint4*)(vb_ + 128 * 80) = rv2; *(uint4*)(vb_ + 192 * 80) = rv3; \
    }
    const int nch = 2 * qb + 2;
    ML_GLOAD(0);
    ML_LSTORE(0);
    __syncthreads();
    for (int ci = 0; ci < nch; ++ci) {
        const int s0 = ci * 32, st = ci & 1;
        if (ci + 1 < nch) ML_GLOAD(s0 + 32);
        if (s0 < t0 + 16) {
            __builtin_amdgcn_s_setprio(1);
            const char* kb = lds + st * ML_STAGE;
            const char* vb = kb + ML_K;
            const f32x4 a0 = *(const f32x4*)(fa + s0 + fq * 4), a1 = *(const f32x4*)(fa + s0 + 16 + fq * 4);
            f32x4 sa = {0.f, 0.f, 0.f, 0.f}, sb = {0.f, 0.f, 0.f, 0.f};
#pragma unroll
            for (int ks = 0; ks < 8; ++ks) {
                sa = mma(*(const bf16x8*)(kb + ks * 2048 + fr * 64 + fq * 16), qf[ks], sa);
                sb = mma(*(const bf16x8*)(kb + ks * 2048 + (16 + fr) * 64 + fq * 16), qf[ks], sb);
            }
            float pv[8];
#pragma unroll
            for (int r = 0; r < 4; ++r) {
                const int s = s0 + fq * 4 + r;
                const float w0 = (s <= trow) ? __expf(a0[r] - mx) : 0.f;
                const float w1 = (s + 16 <= trow) ? __expf(a1[r] - mx) : 0.f;
                pv[r] = sa[r] * w0; pv[4 + r] = sb[r] * w1;
                den += pv[r] + pv[4 + r];
            }
            const bf16x8 pf = pack8(pv);
#pragma unroll
            for (int dvt = 0; dvt < 16; ++dvt) {
                const char* vp = vb + (dvt * 16 + fr) * 80 + fq * 8;
                const bf16x8 vf = join8(*(const uint2*)vp, *(const uint2*)(vp + 32));
                o[dvt] = mma(vf, pf, o[dvt]);
            }
            __builtin_amdgcn_s_setprio(0);
        }
        if (ci + 1 < nch) ML_LSTORE(st ^ 1);
        __syncthreads();
    }
    den += __shfl_xor(den, 16);
    den += __shfl_xor(den, 32);
    const float lower = __expf(-((const float*)(p.ws + O_FL))[bh * S + trow]);
    const float inv = 1.f / fmaxf(fabsf(den), lower);
    const bf16_t* Prow = (const bf16_t*)(p.ws + O_P) + (size_t)(b * S + trow) * NPS;
    float sum = 0.f;
#pragma unroll
    for (int dvt = 0; dvt < 16; ++dvt) {
        const int c = h * 256 + dvt * 16 + fq * 4;
        const uint2 op = *(const uint2*)(Prow + C_MO + c);
        o[dvt][0] *= inv * sigm(lo16(op.x)); o[dvt][1] *= inv * sigm(hi16(op.x)); o[dvt][2] *= inv * sigm(lo16(op.y)); o[dvt][3] *= inv * sigm(hi16(op.y));
        sum += o[dvt][0] + o[dvt][1] + o[dvt][2] + o[dvt][3];
    }
    sum += __shfl_xor(sum, 16);
    sum += __shfl_xor(sum, 32);
    const float mu = sum * (1.f / 256.f);
    float vs = 0.f;
#pragma unroll
    for (int dvt = 0; dvt < 16; ++dvt)
#pragma unroll
        for (int r = 0; r < 4; ++r) { const float d = o[dvt][r] - mu; vs += d * d; }
    vs += __shfl_xor(vs, 16);
    vs += __shfl_xor(vs, 32);
    const float rstd = rsqrtf(vs * (1.f / 256.f) + 1e-6f);
    const bf16_t* xcrow = (const bf16_t*)(p.ws + O_XC) + (size_t)(b * S + trow) * 1024;
    bf16_t* ymrow = (bf16_t*)(p.ws + O_YM) + (size_t)(b * S + trow) * 1024;
#pragma unroll
    for (int dv2 = 0; dv2 < 16; dv2 += 2) {
        uint2 ov[2];
#pragma unroll
        for (int q = 0; q < 2; ++q) {
            const int dvt = dv2 + q, c = h * 256 + dvt * 16 + fq * 4;
            const f32x4 ng = *(const f32x4*)(p.norm_g + c), sk = *(const f32x4*)(p.skip + c);
            const uint2 xc = *(const uint2*)(xcrow + c), mz = *(const uint2*)(Prow + C_MZ + c);
            const float y0 = ((o[dvt][0] - mu) * rstd * ng[0] + sk[0] * lo16(xc.x)) * silu(lo16(mz.x));
            const float y1 = ((o[dvt][1] - mu) * rstd * ng[1] + sk[1] * hi16(xc.x)) * silu(hi16(mz.x));
            const float y2 = ((o[dvt][2] - mu) * rstd * ng[2] + sk[2] * lo16(xc.y)) * silu(lo16(mz.y));
            const float y3 = ((o[dvt][3] - mu) * rstd * ng[3] + sk[3] * hi16(xc.y)) * silu(hi16(mz.y));
            ov[q].x = pk2(y0, y1); ov[q].y = pk2(y2, y3);
        }
        *(uint4*)(ymrow + h * 256 + (dv2 + (fq & 1)) * 16 + (fq >> 1) * 8) = pair16(ov[0], ov[1]);
    }
}


constexpr int CM_K = 16384, CM_VS = 272;
DEVI void cmp3_item(const Params& p, int item, char* lds) {
    const int thr_ = tidx();
    const int tile = item & 31, bg = item >> 5, b = bg >> 2, g = bg & 3;
    const int lane = thr_ & 63, wid = __builtin_amdgcn_readfirstlane(thr_ >> 6), fr = lane & 15, fq = lane >> 4;
    const int T0 = tile * 64, t0 = T0 + wid * 16, trow = t0 + fr, cur = tile;
    const float* KC = (const float*)(p.ws + O_KCF) + (size_t)bg * 127 * 64;
    const float* VC = (const float*)(p.ws + O_VCF) + (size_t)bg * 127 * 64;
    for (int i = 0; i < 32; ++i) {
        const int n = i * 4 + (thr_ >> 6), d = thr_ & 63;
        const float kv = n < 127 ? KC[n * 64 + d] : 0.f, vv = n < 127 ? VC[n * 64 + d] : 0.f;
        *(bf16_t*)(lds + (d >> 5) * 8192 + n * 64 + (d & 31) * 2) = f2bf(kv);
        *(bf16_t*)(lds + CM_K + d * CM_VS + n * 2) = f2bf(vv);
    }
    __syncthreads();
    const bf16_t* P = (const bf16_t*)(p.ws + O_P);
    const size_t tok = (size_t)b * S + trow;
    bf16x8 qf[4][2];
#pragma unroll
    for (int h = 0; h < 4; ++h) {
        const bf16_t* qp = P + tok * NPS + C_AQ + (g * 4 + h) * 64 + fq * 8;
        qf[h][0] = *(const bf16x8*)qp; qf[h][1] = *(const bf16x8*)(qp + 32);
    }
    const int nv = trow >= 31 ? ((trow - 31) >> 4) + 1 : 0;
    const int nvw = t0 + 15 >= 31 ? ((t0 + 15 - 31) >> 4) + 1 : 0;
    const int nchunk = (nvw + 31) >> 5;
    float m[4], l[4];
#pragma unroll
    for (int h = 0; h < 4; ++h) { m[h] = -1e30f; l[h] = 0.f; }
    for (int c = 0; c < nchunk; ++c) {
        bf16x8 kf[2][2];
#pragma unroll
        for (int stl = 0; stl < 2; ++stl)
#pragma unroll
            for (int ks = 0; ks < 2; ++ks) kf[stl][ks] = *(const bf16x8*)(lds + ks * 8192 + (c * 32 + stl * 16 + fr) * 64 + fq * 16);
        unsigned vm = 0;
#pragma unroll
        for (int e = 0; e < 8; ++e) { const int n = c * 32 + (e >> 2) * 16 + fq * 4 + (e & 3); if (n < nv) vm |= 1u << e; }
#pragma unroll
        for (int h = 0; h < 4; ++h) {
            f32x4 sa = {0.f, 0.f, 0.f, 0.f}, sb = {0.f, 0.f, 0.f, 0.f};
            sa = mma(kf[0][0], qf[h][0], sa); sa = mma(kf[0][1], qf[h][1], sa);
            sb = mma(kf[1][0], qf[h][0], sb); sb = mma(kf[1][1], qf[h][1], sb);
            float v[8];
#pragma unroll
            for (int r = 0; r < 4; ++r) { v[r] = sa[r] * 0.125f; v[4 + r] = sb[r] * 0.125f; }
            float mxv = -1e30f;
#pragma unroll
            for (int e = 0; e < 8; ++e) if ((vm >> e) & 1u) mxv = fmaxf(mxv, v[e]);
            mxv = fmaxf(mxv, __shfl_xor(mxv, 16));
            mxv = fmaxf(mxv, __shfl_xor(mxv, 32));
            const float mn = fmaxf(m[h], mxv);
            float ps = 0.f;
#pragma unroll
            for (int e = 0; e < 8; ++e) ps += ((vm >> e) & 1u) ? __expf(v[e] - mn) : 0.f;
            l[h] = l[h] * __expf(m[h] - mn) + ps;
            m[h] = mn;
        }
    }
    float linv[4];
#pragma unroll
    for (int h = 0; h < 4; ++h) {
        float lt = l[h];
        lt += __shfl_xor(lt, 16);
        lt += __shfl_xor(lt, 32);
        linv[h] = lt > 0.f ? 1.f / lt : 0.f;
    }
    f32x4 o[4][4];
#pragma unroll
    for (int h = 0; h < 4; ++h)
#pragma unroll
        for (int i = 0; i < 4; ++i) o[h][i] = (f32x4){0.f, 0.f, 0.f, 0.f};
    float own4[8], last[8];
#pragma unroll
    for (int k = 0; k < 8; ++k) { own4[k] = 0.f; last[k] = 0.f; }
#pragma unroll
    for (int c = 0; c < 4; ++c) {
        if (c < nchunk) {
            bf16x8 kf[2][2];
#pragma unroll
            for (int stl = 0; stl < 2; ++stl)
#pragma unroll
                for (int ks = 0; ks < 2; ++ks) kf[stl][ks] = *(const bf16x8*)(lds + ks * 8192 + (c * 32 + stl * 16 + fr) * 64 + fq * 16);
            bf16x8 vf[4];
#pragma unroll
            for (int dvt = 0; dvt < 4; ++dvt) {
                const char* vp = lds + CM_K + (dvt * 16 + fr) * CM_VS + c * 64 + fq * 8;
                vf[dvt] = join8(*(const uint2*)vp, *(const uint2*)(vp + 32));
            }
            unsigned vm = 0;
#pragma unroll
            for (int e = 0; e < 8; ++e) { const int n = c * 32 + (e >> 2) * 16 + fq * 4 + (e & 3); if (n < nv) vm |= 1u << e; }
#pragma unroll
            for (int h = 0; h < 4; ++h) {
                f32x4 sa = {0.f, 0.f, 0.f, 0.f}, sb = {0.f, 0.f, 0.f, 0.f};
                sa = mma(kf[0][0], qf[h][0], sa); sa = mma(kf[0][1], qf[h][1], sa);
                sb = mma(kf[1][0], qf[h][0], sb); sb = mma(kf[1][1], qf[h][1], sb);
                float v[8];
#pragma unroll
                for (int r = 0; r < 4; ++r) { v[r] = sa[r] * 0.125f; v[4 + r] = sb[r] * 0.125f; }
#pragma unroll
                for (int e = 0; e < 8; ++e) v[e] = ((vm >> e) & 1u) ? __expf(v[e] - m[h]) * linv[h] : 0.f;
                own4[2 * c] += (v[0] + v[1]) + (v[2] + v[3]); last[2 * c] += v[3];
                own4[2 * c + 1] += (v[4] + v[5]) + (v[6] + v[7]); last[2 * c + 1] += v[7];
                const bf16x8 pf = pack8(v);
#pragma unroll
                for (int dvt = 0; dvt < 4; ++dvt) o[h][dvt] = mma(vf[dvt], pf, o[h][dvt]);
            }
        }
    }
    bf16_t* OC = (bf16_t*)(p.ws + O_OC) + tok * 1024 + g * 256;
#pragma unroll
    for (int h = 0; h < 4; ++h)
#pragma unroll
        for (int dvt = 0; dvt < 4; dvt += 2) {
            uint2 x, y;
            x.x = pk2(o[h][dvt][0], o[h][dvt][1]); x.y = pk2(o[h][dvt][2], o[h][dvt][3]);
            y.x = pk2(o[h][dvt + 1][0], o[h][dvt + 1][1]); y.y = pk2(o[h][dvt + 1][2], o[h][dvt + 1][3]);
            *(uint4*)(OC + h * 64 + (dvt + (fq & 1)) * 16 + (fq >> 1) * 8) = pair16(x, y);
        }
    float sc[8];
    float prev = 0.f;
#pragma unroll
    for (int k = 0; k < 8; ++k) {
        const float rcv = __shfl(last[k], (lane + 48) & 63);
        const float carry = fq > 0 ? rcv : prev;
        prev = rcv;
        const int j = 4 * k + fq;
        const bool forced = j == 0 || j == cur || j == cur - 1;
        sc[k] = forced ? 1e30f : (j <= cur ? own4[k] + carry : -1e30f);
    }
    unsigned mask = 0u;
#pragma unroll 1
    for (int it = 0; it < 8; ++it) {
        float bv = sc[0];
        int bj = fq;
#pragma unroll
        for (int k = 1; k < 8; ++k) if (sc[k] > bv) { bv = sc[k]; bj = 4 * k + fq; }
#pragma unroll
        for (int off = 16; off <= 32; off <<= 1) {
            const float ov = __shfl_xor(bv, off);
            const int oj = __shfl_xor(bj, off);
            if (ov > bv || (ov == bv && oj < bj)) { bv = ov; bj = oj; }
        }
        mask |= 1u << bj;
#pragma unroll
        for (int k = 0; k < 8; ++k) if (4 * k + fq == bj) sc[k] = -4e30f;
    }
    if (fq == 0) ((unsigned*)(p.ws + O_SEL))[bg * S + trow] = mask & ((2u << cur) - 1u);
    __syncthreads();
}

constexpr int AT_K = 8192, AT_V = 9216, AT_STAGE = AT_K + AT_V;
template <bool SELB, int NH>
DEVI void nsa2_item(const Params& p, int tile, int bg, int h0, char* lds) {
    const int thr_ = tidx();
    const int b = bg >> 2, g = bg & 3;
    const int lane = thr_ & 63, wid = __builtin_amdgcn_readfirstlane(thr_ >> 6), fr = lane & 15, fq = lane >> 4;
    const int T0 = tile * 64, t0 = T0 + wid * 16, trow = t0 + fr, cur = tile;
    const bf16_t* P = (const bf16_t*)(p.ws + O_P);
    const size_t tok = (size_t)b * S + trow;
    bf16x8 qf[NH][2];
#pragma unroll
    for (int h = 0; h < NH; ++h) {
        const bf16_t* qp = P + tok * NPS + C_AQ + (g * 4 + h0 + h) * 64 + fq * 8;
        qf[h][0] = *(const bf16x8*)qp; qf[h][1] = *(const bf16x8*)(qp + 32);
    }
    unsigned rm = 0xffffffffu, wmask, gmask;
    if (SELB) {
        rm = ((const unsigned*)(p.ws + O_SEL))[bg * S + trow];
        unsigned un = rm;
        un |= __shfl_xor(un, 1); un |= __shfl_xor(un, 2); un |= __shfl_xor(un, 4); un |= __shfl_xor(un, 8);
        wmask = __builtin_amdgcn_readfirstlane(un) & ((2u << cur) - 1u);
        unsigned* lu = (unsigned*)(lds + 2 * AT_STAGE);
        if (lane == 0) lu[wid] = wmask;
        __syncthreads();
        gmask = lu[0] | lu[1] | lu[2] | lu[3];
        gmask = __builtin_amdgcn_readfirstlane(gmask);
    } else {
        const int lo = cur >= 8 ? cur - 8 : 0;
        gmask = ((2u << cur) - 1u) & ~((1u << lo) - 1u);
        const int wl = t0 - 511 > 0 ? (t0 - 511) >> 6 : 0;
        wmask = gmask & ~((1u << wl) - 1u);
    }
    const bf16_t* kg = P + (size_t)(b * S) * NPS + (SELB ? C_KS : C_KW) + g * 64;
    const bf16_t* vg = (const bf16_t*)(p.ws + (SELB ? O_VST : O_VWT)) + (size_t)(b * 256 + g * 64) * S;
    const int sc = thr_ & 7, sr = thr_ >> 3;
    uint4 rk0, rk1, rv0, rv1;
#define AT_GLOAD(jj)                                                                                   \
    {                                                                                                  \
        rk0 = *(const uint4*)(kg + (size_t)((jj) * 64 + sr) * NPS + sc * 8);                           \
        rk1 = *(const uint4*)(kg + (size_t)((jj) * 64 + sr + 32) * NPS + sc * 8);                      \
        rv0 = *(const uint4*)(vg + (size_t)(sr) * S + (jj) * 64 + sc * 8);                             \
        rv1 = *(const uint4*)(vg + (size_t)(sr + 32) * S + (jj) * 64 + sc * 8);                        \
    }
#define AT_LSTORE(stt)                                                                                 \
    {                                                                                                  \
        char* base_ = lds + (stt) * AT_STAGE;                                                          \
        *(uint4*)(base_ + (sc >> 2) * 4096 + (sr) * 64 + (sc & 3) * 16) = rk0;                         \
        *(uint4*)(base_ + (sc >> 2) * 4096 + (sr + 32) * 64 + (sc & 3) * 16) = rk1;                    \
        *(uint4*)(base_ + AT_K + (sr) * 144 + sc * 16) = rv0;                                          \
        *(uint4*)(base_ + AT_K + (sr + 32) * 144 + sc * 16) = rv1;                                     \
    }
    f32x4 o[NH][4];
    float m[NH], l[NH];
#pragma unroll
    for (int h = 0; h < NH; ++h) {
        m[h] = -1e30f; l[h] = 0.f;
#pragma unroll
        for (int i = 0; i < 4; ++i) o[h][i] = (f32x4){0.f, 0.f, 0.f, 0.f};
    }
    unsigned rem = gmask;
    int j = __ffs(rem) - 1;
    rem &= rem - 1;
    AT_GLOAD(j);
    AT_LSTORE(0);
    __syncthreads();
    int st = 0;
    while (true) {
        const int jn = rem ? __ffs(rem) - 1 : -1;
        rem &= rem - 1;
        if (jn >= 0) AT_GLOAD(jn);
        if ((wmask >> j) & 1u) {
            __builtin_amdgcn_s_setprio(1);
            const char* kb = lds + st * AT_STAGE;
            const char* vb = kb + AT_K;
            const bool rs = (rm >> j) & 1u;
#pragma unroll
            for (int c = 0; c < 2; ++c) {
                const int s0 = j * 64 + c * 32;
                bf16x8 kf[2][2];
#pragma unroll
                for (int stl = 0; stl < 2; ++stl)
#pragma unroll
                    for (int ks = 0; ks < 2; ++ks) kf[stl][ks] = *(const bf16x8*)(kb + ks * 4096 + (c * 32 + stl * 16 + fr) * 64 + fq * 16);
                bf16x8 vf[4];
#pragma unroll
                for (int dvt = 0; dvt < 4; ++dvt) {
                    const char* vp = vb + (dvt * 16 + fr) * 144 + c * 64 + fq * 8;
                    vf[dvt] = join8(*(const uint2*)vp, *(const uint2*)(vp + 32));
                }
                unsigned vm = 0;
#pragma unroll
                for (int e = 0; e < 8; ++e) {
                    const int s = s0 + (e >> 2) * 16 + fq * 4 + (e & 3);
                    if (rs && s <= trow && (SELB || s > trow - 512)) vm |= 1u << e;
                }
#pragma unroll
                for (int h = 0; h < NH; ++h) {
                    f32x4 sa = {0.f, 0.f, 0.f, 0.f}, sb = {0.f, 0.f, 0.f, 0.f};
                    sa = mma(kf[0][0], qf[h][0], sa); sa = mma(kf[0][1], qf[h][1], sa);
                    sb = mma(kf[1][0], qf[h][0], sb); sb = mma(kf[1][1], qf[h][1], sb);
                    constexpr float SC = 0.125f * 1.44269504f;
                    float v[8];
#pragma unroll
                    for (int r = 0; r < 4; ++r) { v[r] = sa[r]; v[4 + r] = sb[r]; }
                    float mxv = -1e30f;
#pragma unroll
                    for (int e = 0; e < 8; ++e) if ((vm >> e) & 1u) mxv = fmaxf(mxv, v[e]);
                    mxv = fmaxf(mxv, __shfl_xor(mxv, 16));
                    mxv = fmaxf(mxv, __shfl_xor(mxv, 32));
                    const float mn = fmaxf(m[h], mxv);
                    const float alpha = __builtin_amdgcn_exp2f((m[h] - mn) * SC);
                    m[h] = mn;
                    const float mb = -mn * SC;
                    float ps = 0.f;
#pragma unroll
                    for (int e = 0; e < 8; ++e) { v[e] = ((vm >> e) & 1u) ? __builtin_amdgcn_exp2f(fmaf(v[e], SC, mb)) : 0.f; ps += v[e]; }
                    l[h] = l[h] * alpha + ps;
                    const bf16x8 pf = pack8(v);
#pragma unroll
                    for (int dvt = 0; dvt < 4; ++dvt) { o[h][dvt] *= alpha; o[h][dvt] = mma(vf[dvt], pf, o[h][dvt]); }
                }
            }
            __builtin_amdgcn_s_setprio(0);
        }
        if (jn < 0) break;
        AT_LSTORE(st ^ 1);
        __syncthreads();
        st ^= 1;
        j = jn;
    }
    __syncthreads();
#pragma unroll
    for (int h = 0; h < NH; ++h) {
        const int hd = g * 4 + h0 + h;
        float lt = l[h];
        lt += __shfl_xor(lt, 16);
        lt += __shfl_xor(lt, 32);
        const float inv = 1.f / lt;
        if (!SELB) {
            bf16_t* OW = (bf16_t*)(p.ws + O_OW) + tok * 1024 + hd * 64;
#pragma unroll
            for (int dvt = 0; dvt < 4; dvt += 2) {
                uint2 x, y;
                x.x = pk2(o[h][dvt][0] * inv, o[h][dvt][1] * inv); x.y = pk2(o[h][dvt][2] * inv, o[h][dvt][3] * inv);
                y.x = pk2(o[h][dvt + 1][0] * inv, o[h][dvt + 1][1] * inv); y.y = pk2(o[h][dvt + 1][2] * inv, o[h][dvt + 1][3] * inv);
                *(uint4*)(OW + (dvt + (fq & 1)) * 16 + (fq >> 1) * 8) = pair16(x, y);
            }
        } else {
            const float* G = (const float*)(p.ws + O_G) + tok * 64 + 8 + hd * 3;
            const float g0 = sigm(G[0]), g1 = sigm(G[1]) * inv, g2 = sigm(G[2]);
            const bf16_t* OC = (const bf16_t*)(p.ws + O_OC) + tok * 1024 + hd * 64 + fq * 4;
            const bf16_t* OW = (const bf16_t*)(p.ws + O_OW) + tok * 1024 + hd * 64 + fq * 4;
            const bf16_t* AZ = P + tok * NPS + C_AZ + hd * 64 + fq * 4;
            bf16_t* YA = (bf16_t*)(p.ws + O_YA) + tok * 1024 + hd * 64 + fq * 4;
#pragma unroll
            for (int dv2 = 0; dv2 < 4; dv2 += 2) {
                uint2 ov[2];
#pragma unroll
                for (int q = 0; q < 2; ++q) {
                    const int dvt = dv2 + q;
                    const uint2 oc = *(const uint2*)(OC + dvt * 16), ow = *(const uint2*)(OW + dvt * 16), az = *(const uint2*)(AZ + dvt * 16);
                    const float y0 = (g0 * lo16(oc.x) + g1 * o[h][dvt][0] + g2 * lo16(ow.x)) * silu(lo16(az.x));
                    const float y1 = (g0 * hi16(oc.x) + g1 * o[h][dvt][1] + g2 * hi16(ow.x)) * silu(hi16(az.x));
                    const float y2 = (g0 * lo16(oc.y) + g1 * o[h][dvt][2] + g2 * lo16(ow.y)) * silu(lo16(az.y));
                    const float y3 = (g0 * hi16(oc.y) + g1 * o[h][dvt][3] + g2 * hi16(ow.y)) * silu(hi16(az.y));
                    ov[q].x = pk2(y0, y1); ov[q].y = pk2(y2, y3);
                }
                *(uint4*)(YA - fq * 4 + (dv2 + (fq & 1)) * 16 + (fq >> 1) * 8) = pair16(ov[0], ov[1]);
            }
        }
    }
}

DEVI void up_tile(const Params& p, int item, char* lds) {
    const int nt = item >> 5, mt = item & 31, m0 = mt * 256, n0 = nt * 64;
    const int tid = tidx(), lane = tid & 63, wid = tid >> 6, wr = wid >> 1, wc = wid & 1, fr = lane & 15, fq = lane >> 4;
    const bf16_t* P = (const bf16_t*)(p.ws + O_P);
    f32x4 acc[8][2], acc2[8][2];
#pragma unroll
    for (int i = 0; i < 8; ++i) { acc[i][0] = acc[i][1] = acc2[i][0] = acc2[i][1] = (f32x4){0.f, 0.f, 0.f, 0.f}; }
    gemm3_main<false, 2>(acc, lds, (const bf16_t*)(p.ws + O_YM), 1024, (const bf16_t*)(p.ws + O_WUM), 1024, 2047, m0, n0, 1024);
    gemm3_main<false, 2>(acc2, lds, (const bf16_t*)(p.ws + O_YA), 1024, (const bf16_t*)(p.ws + O_WUA), 1024, 2047, m0, n0, 1024);
    bf16_t* MG = (bf16_t*)(p.ws + O_MG);
#pragma unroll
    for (int mi = 0; mi < 8; ++mi) {
        const int row = m0 + wr * 128 + mi * 16 + fr;
        uint2 ov[2];
        const int pc = n0 + wc * 32 + (fq & 1) * 16 + (fq >> 1) * 8;
        const uint4 gm16 = *(const uint4*)(P + (size_t)row * NPS + C_GM + pc), ga16 = *(const uint4*)(P + (size_t)row * NPS + C_GA + pc);
        uint2 ta, tb;
        ta.x = gm16.x; ta.y = gm16.y; tb.x = gm16.z; tb.y = gm16.w;
        const uint4 gmu = pair16(ta, tb);
        ta.x = ga16.x; ta.y = ga16.y; tb.x = ga16.z; tb.y = ga16.w;
        const uint4 gau = pair16(ta, tb);
#pragma unroll
        for (int ni = 0; ni < 2; ++ni) {
            uint2 gm, ga;
            gm.x = ni ? gmu.z : gmu.x; gm.y = ni ? gmu.w : gmu.y; ga.x = ni ? gau.z : gau.x; ga.y = ni ? gau.w : gau.y;
            const float y0 = acc[mi][ni][0] * sigm(lo16(gm.x)) + acc2[mi][ni][0] * sigm(lo16(ga.x)), y1 = acc[mi][ni][1] * sigm(hi16(gm.x)) + acc2[mi][ni][1] * sigm(hi16(ga.x));
            const float y2 = acc[mi][ni][2] * sigm(lo16(gm.y)) + acc2[mi][ni][2] * sigm(lo16(ga.y)), y3 = acc[mi][ni][3] * sigm(hi16(gm.y)) + acc2[mi][ni][3] * sigm(hi16(ga.y));
            ov[ni].x = pk2(y0, y1); ov[ni].y = pk2(y2, y3);
        }
        *(uint4*)(MG + (size_t)row * DM + n0 + wc * 32 + (fq & 1) * 16 + (fq >> 1) * 8) = pair16(ov[0], ov[1]);
    }
}
DEVI void out_tile(const Params& p, int item, char* lds) {
    const int nt = item >> 5, mt = item & 31, m0 = mt * 256, n0 = nt * 128;
    const int tid = tidx(), lane = tid & 63, wid = tid >> 6, wr = wid >> 1, wc = wid & 1, fr = lane & 15, fq = lane >> 4;
    f32x4 acc[8][4];
    zero_acc2(acc);
    gemm3_main<false, 4>(acc, lds, (const bf16_t*)(p.ws + O_MG), DM, (const bf16_t*)(p.ws + O_WOUT), DM, 2047, m0, n0, DM);
    bf16_t* O = (bf16_t*)(p.ws + O_OUT);
#pragma unroll
    for (int mi = 0; mi < 8; ++mi)
#pragma unroll
        for (int ni = 0; ni < 4; ni += 2) {
            const int row = m0 + wr * 128 + mi * 16 + fr, col = n0 + wc * 64 + (ni + (fq & 1)) * 16 + (fq >> 1) * 8;
            uint2 x, y;
            x.x = pk2(acc[mi][ni][0], acc[mi][ni][1]); x.y = pk2(acc[mi][ni][2], acc[mi][ni][3]);
            y.x = pk2(acc[mi][ni + 1][0], acc[mi][ni + 1][1]); y.y = pk2(acc[mi][ni + 1][2], acc[mi][ni + 1][3]);
            *(uint4*)(O + (size_t)row * DM + col) = pair16(x, y);
        }
}
DEVI void final_rows(const Params& p, int item) {
    const int thr_ = tidx();
    const int lane = thr_ & 63, wid = thr_ >> 6;
    const int row = item * 4 + wid;
    const bf16_t* orow = (const bf16_t*)(p.ws + O_OUT) + (size_t)row * DM;
    const float* xr = p.x + (size_t)row * DM;
    f32x4 v[8];
    float ss = 0.f;
#pragma unroll
    for (int i = 0; i < 8; ++i) { const uint2 u = *(const uint2*)(orow + i * 256 + lane * 4); v[i] = (f32x4){lo16(u.x), hi16(u.x), lo16(u.y), hi16(u.y)}; ss += v[i][0] * v[i][0] + v[i][1] * v[i][1] + v[i][2] * v[i][2] + v[i][3] * v[i][3]; }
    ss = wave_sum(ss);
    const float rs = rsqrtf(ss * (1.f / DM) + 1e-6f);
    float* dr = p.out + (size_t)row * DM;
#pragma unroll
    for (int i = 0; i < 8; ++i) {
        const f32x4 g = *(const f32x4*)(p.post_g + i * 256 + lane * 4);
        const f32x4 xv = *(const f32x4*)(xr + i * 256 + lane * 4);
#if DBG == 0
        *(f32x4*)(dr + i * 256 + lane * 4) = xv + v[i] * rs * g;
#elif DBG == 1
        *(f32x4*)(dr + i * 256 + lane * 4) = xv;
#elif DBG == 9
        {
            const int cc = (i * 256 + lane * 4) & 1023;
            const uint2 u0 = *(const uint2*)((const bf16_t*)(p.ws + O_XC) + (size_t)row * 1024 + cc);
            const uint2 u1 = *(const uint2*)((const bf16_t*)(p.ws + O_QM) + (size_t)row * 1024 + cc);
            const uint2 u2 = *(const uint2*)((const bf16_t*)(p.ws + O_KM) + (size_t)row * 1024 + cc);
            const uint2 u3 = *(const uint2*)((const bf16_t*)(p.ws + O_VMT) + (size_t)row * 1024 + cc);
            const int fi = (row & 15) * 2048 + i * 256 + lane * 4;
            const f32x4 f0 = *(const f32x4*)((const float*)(p.ws + O_FA) + fi), f1 = *(const f32x4*)((const float*)(p.ws + O_FM) + fi), f2 = *(const f32x4*)((const float*)(p.ws + O_FL) + fi);
            f32x4 d = {lo16(u0.x) + lo16(u1.x) + lo16(u2.x) + lo16(u3.x), hi16(u0.x) + hi16(u1.x) + hi16(u2.x) + hi16(u3.x), lo16(u0.y) + lo16(u1.y) + lo16(u2.y) + lo16(u3.y), hi16(u0.y) + hi16(u1.y) + hi16(u2.y) + hi16(u3.y)};
            #if PSEL == 0
            d = (f32x4){lo16(u3.x), hi16(u3.x), lo16(u3.y), hi16(u3.y)};
            *(f32x4*)(dr + i * 256 + lane * 4) = xv + d;
#elif PSEL == 1
            d = (f32x4){lo16(u0.x), hi16(u0.x), lo16(u0.y), hi16(u0.y)};
            *(f32x4*)(dr + i * 256 + lane * 4) = xv + d;
#elif PSEL == 2
            *(f32x4*)(dr + i * 256 + lane * 4) = xv + f0 + f1 + f2;
#else
            *(f32x4*)(dr + i * 256 + lane * 4) = xv + d + f0 + f1 + f2;
#endif
        }
#else
        {
            const bf16_t* src = DBG == 2 ? (const bf16_t*)(p.ws + O_MG) + (size_t)row * DM : DBG == 3 ? (const bf16_t*)(p.ws + O_P) + (size_t)row * NPS + 2048
                              : DBG == 4 ? (const bf16_t*)(p.ws + O_YM) + (size_t)row * 1024 : DBG == 5 ? (const bf16_t*)(p.ws + O_YA) + (size_t)row * 1024
                              : DBG == 6 ? (const bf16_t*)(p.ws + O_P) + (size_t)row * NPS + 4096 : (const bf16_t*)(p.ws + O_P) + (size_t)row * NPS + 7680;
            const int cc = (i * 256 + lane * 4) & ((DBG == 4 || DBG == 5) ? 1023 : 2047);
            const uint2 u = *(const uint2*)(src + cc);
            f32x4 d = {lo16(u.x), hi16(u.x), lo16(u.y), hi16(u.y)};
            *(f32x4*)(dr + i * 256 + lane * 4) = xv + d;
        }
#endif
    }
}


__global__ void __launch_bounds__(256, 2) fwd_megakernel(Params p) {
    extern __shared__ __attribute__((aligned(16))) char lds[];
    const int G = gridDim.x, bid = blockIdx.x;
    if (threadIdx.x == 0) *(uint4*)(lds + LDS_MAIN) = make_uint4(0u, 0u, 0u, 0u);
    __syncthreads();
    XcdBarrier xb = xcd_barrier_post((unsigned*)(p.ws + O_BAR), (volatile LAS unsigned*)(lds + LDS_MAIN));
    if (p.ws == nullptr) cg::this_grid().sync();
    for (int rep = 0; rep < NREP(0); ++rep)
    for (int it = bid; it < 2048 + N_TTILES + 32; it += G) {
        if (it < N_TTILES) transpose_item(p, it, lds);
        else if (it < N_TTILES + 2048) rmsnorm_rows(p, it - N_TTILES);
        else bias_item(p, it - N_TTILES - 2048);
    }
    xcd_barrier(xb);
    for (int rep = 0; rep < NREP(1); ++rep)
    for (int it = bid; it < 32 * 93; it += G) inproj_tile(p, it, lds);
    if (G >= 128 && bid >= G - 64) {
        if (threadIdx.x == 0) {
            unsigned* cnt = (unsigned*)(p.ws + O_BAR);
            XB_SPIN(xb_ld(cnt) < 128u * NREP(1), cnt);
            __builtin_amdgcn_fence(__ATOMIC_ACQUIRE, "agent");
            asm volatile("s_waitcnt vmcnt(0)" ::: "memory");
        }
        __syncthreads();
        __builtin_amdgcn_fence(__ATOMIC_ACQUIRE, "agent");
        cmp1_tile(p, bid - (G - 64), lds);
    } else if (G < 128) {
        xcd_barrier(xb);
        for (int it = bid; it < 64; it += G) cmp1_tile(p, it, lds);
    }
    xcd_barrier(xb);
    for (int rep = 0; rep < NREP(2); ++rep)
    for (int it = bid; it < 16 + 512; it += G) {
        if (it < 16) scan_item(p, it, lds);
        else conv_item(p, it - 16);
    }
    xcd_barrier(xb);
    for (int rep = 0; rep < NREP(3); ++rep)
    for (int it = bid; it < 1024 + 32; it += G) {
        if (it < 32) cmp2_tile(p, it, lds);
        else qk_tile(p, it - 32, lds);
    }
    xcd_barrier(xb);
    for (int rep = 0; rep < NREP(4); ++rep) {
        for (int r2 = 0; r2 < NREP(8); ++r2)
        for (int it = bid; it < 512; it += G) mlstm2_item(p, it, lds);
        for (int r2 = 0; r2 < NREP(9); ++r2)
        if (bid >= (G >> 1)) for (int it = bid - (G >> 1); it < 512; it += G - (G >> 1)) cmp3_item(p, (it & 15) * 32 + (it >> 4), lds);
        for (int r2 = 0; r2 < NREP(10); ++r2)
        for (int it = bid; it < 512; it += G) nsa2_item<false, 4>(p, it >> 4, it & 15, 0, lds);
    }
    xcd_barrier(xb);
    for (int rep = 0; rep < NREP(5); ++rep)
    for (int it = bid; it < 1024; it += G) {
        const int idx = it & 511, hp = it >> 9;
        nsa2_item<true, 2>(p, hp ? (idx >> 4) : 31 - (idx >> 4), idx & 15, hp * 2, lds);
    }
    xcd_barrier(xb);
    for (int rep = 0; rep < NREP(6); ++rep)
    for (int it = bid; it < 1024; it += G) up_tile(p, it, lds);
    xcd_barrier(xb);
    for (int rep = 0; rep < NREP(7); ++rep)
    for (int it = bid; it < 512; it += G) out_tile(p, it, lds);
    xcd_barrier(xb);
    for (int rep = 0; rep < NREP(11); ++rep)
    for (int it = bid; it < 2048; it += G) final_rows(p, it);
}

extern "C" void kernel_launch(void* const* d_in, const int* in_sizes, int n_in, void* d_out, int out_size, void* d_ws, size_t ws_size,
                              hipStream_t stream) {
    static int grid_blocks = 0;
    if (!grid_blocks) {
        int dev = 0, cus = 0, per_cu = 0;
        hipGetDevice(&dev);
        hipDeviceGetAttribute(&cus, hipDeviceAttributeMultiprocessorCount, dev);
        hipFuncSetAttribute((const void*)fwd_megakernel, hipFuncAttributeMaxDynamicSharedMemorySize, LDS_BYTES);
        hipOccupancyMaxActiveBlocksPerMultiprocessor(&per_cu, fwd_megakernel, 256, LDS_BYTES);
        if (per_cu < 1) per_cu = 1;
        if (per_cu > 2) per_cu = 2;
        grid_blocks = cus * per_cu;
    }
    if (ws_size < O_END2) { fprintf(stderr, "workspace too small: %zu < %zu\n", ws_size, (size_t)O_END); return; }
    Params p{};
    const float** f = (const float**)&p;
    for (int i = 0; i < 21; ++i) f[i] = (const float*)d_in[i];
    p.out = (float*)d_out;
    p.ws = (char*)d_ws;
    hipMemsetAsync((char*)d_ws + O_BAR, 0, XCD_BAR_WORDS * 4, stream);
    void* args[] = {&p};
    hipError_t e = hipLaunchCooperativeKernel((void*)fwd_megakernel, dim3(grid_blocks), dim3(256), args, LDS_BYTES, stream);
    if (e != hipSuccess) fprintf(stderr, "cooperative launch failed: %s (grid %d)\n", hipGetErrorString(e), grid_blocks);
}
```
